# Optimizing an MI355X kernel written in HIP

```python
import math
import jax
import jax.numpy as jnp
from jax import lax
import numpy as np

D_MODEL = 2048
BATCH = 1
SEQ = 16384
DEPTH = 4

S5_GROUP = 16
S5_W = 3 * D_MODEL // 8
S5_GROUPS = S5_W // S5_GROUP
S5_STATE = 64
S5_CHUNK = 128
S5_DT_MIN = 0.001
S5_DT_MAX = 0.1
RWKV_HEAD = 64
RWKV_W = 5 * D_MODEL // 16
RWKV_HEADS = RWKV_W // RWKV_HEAD
RWKV_DECAY_LORA = 96
RWKV_AAA_LORA = 128
RWKV_MV_LORA = 64
RWKV_GATE_LORA = 256
RWKV_COLS = 3 * RWKV_W + RWKV_DECAY_LORA + RWKV_AAA_LORA + RWKV_GATE_LORA
RWKV_LNX_EPS = 64e-5
GLA_DV = 128
GLA_DK = 64
GLA_V = 5 * D_MODEL // 16
GLA_HEADS = GLA_V // GLA_DV
GLA_K = GLA_HEADS * GLA_DK
GLA_LORA = 16
GLA_TAU = 16.0
GLA_CHUNK = 64
GLA_COLS = 2 * GLA_K + 2 * GLA_V + GLA_LORA
N_BRANCH = 3
GATE_COLS = N_BRANCH * D_MODEL
IN_COLS = S5_W + RWKV_COLS + GLA_COLS + GATE_COLS
MIX_W = S5_W + RWKV_W + GLA_V
D_FF = 4 * D_MODEL
NORM_EPS = 1e-6

kernel_name = "hybrid_s5_rwkv7_gla_gated_trunk"


def rmsnorm(x, g):
    xf = x.astype(jnp.float32)
    y = xf * lax.rsqrt(jnp.mean(xf * xf, axis=-1, keepdims=True) + NORM_EPS)
    return (y * g.astype(jnp.float32)).astype(x.dtype)


def token_shift(z, mu):
    prev = jnp.pad(z, ((0, 0), (1, 0), (0, 0)))[:, :-1]
    return z + (prev - z) * mu


def s5_branch(xa, lam_re, lam_im, log_step, b_re, b_im, c_re, c_im, d, glu_w, glu_b):
    bsz, length, _ = xa.shape
    f32 = jnp.float32
    xf = xa.astype(f32)
    lam = lax.complex(jnp.minimum(lam_re.astype(f32), -1e-4), lam_im.astype(f32))
    dt = jnp.exp(log_step.astype(f32))[:, None]
    lam_dt = lam * dt
    lam_bar = jnp.exp(lam_dt)
    b_mat = lax.complex(b_re.astype(f32), b_im.astype(f32))
    b_bar = ((lam_bar - 1.0) / lam)[..., None] * b_mat
    c_mat = lax.complex(c_re.astype(f32), c_im.astype(f32))
    n_chunks = length // S5_CHUNK
    u = xf.reshape(bsz, n_chunks, S5_CHUNK, S5_GROUPS, S5_GROUP).transpose(1, 0, 2, 3, 4)
    pows = jnp.exp(lam_dt[None] * jnp.arange(1, S5_CHUNK + 1, dtype=f32)[:, None, None])

    def binop(e1, e2):
        a1, b1 = e1
        a2, b2 = e2
        return a1 * a2, a2 * b1 + b2

    def step(s, u_c):
        bu = jnp.einsum('bcgi,gpi->bcgp', u_c.astype(jnp.complex64), b_bar)
        a = jnp.broadcast_to(lam_bar, bu.shape)
        _, local = lax.associative_scan(binop, (a, bu), axis=1)
        states = local + pows[None] * s[:, None]
        y = jnp.einsum('bcgp,gip->bcgi', states, c_mat).real
        return states[:, -1], y

    s0 = jnp.zeros((bsz, S5_GROUPS, S5_STATE), jnp.complex64)
    _, ys = lax.scan(step, s0, u)
    y = ys.transpose(1, 0, 2, 3, 4).reshape(bsz, length, S5_W) + d.astype(f32) * xf
    y = jax.nn.gelu(y)
    y = y * jax.nn.sigmoid(y @ glu_w.astype(f32) + glu_b.astype(f32))
    return y.astype(xa.dtype)


def rwkv7_branch(z, mu, w_lora, w0, a_lora, a0, g_lora, k_k, k_a, r_k, lnx_w, lnx_b,
                 v_first, v_gate):
    bsz, length, _ = z.shape
    f32 = jnp.float32
    hh, nn = RWKV_HEADS, RWKV_HEAD
    zs = token_shift(z, mu).astype(f32)
    o1 = 3 * RWKV_W
    r, k, v, w_in, a_in, g_in = jnp.split(
        zs, [RWKV_W, 2 * RWKV_W, o1, o1 + RWKV_DECAY_LORA, o1 + RWKV_DECAY_LORA + RWKV_AAA_LORA], axis=-1)
    w = -jax.nn.softplus(-(w0.astype(f32) + jnp.tanh(w_in) @ w_lora.astype(f32))) - 0.5
    decay = jnp.exp(-jnp.exp(w))
    a = jax.nn.sigmoid(a0.astype(f32) + a_in @ a_lora.astype(f32))
    g = jax.nn.sigmoid(g_in) @ g_lora.astype(f32)
    if v_gate is not None:
        v = v + (v_first - v) * v_gate.astype(f32)
    kk = (k * k_k.astype(f32)).reshape(bsz, length, hh, nn)
    kk = kk * lax.rsqrt(jnp.maximum(jnp.sum(kk * kk, axis=-1, keepdims=True), 1e-24))
    k = k * (1.0 + (a - 1.0) * k_a.astype(f32))

    def heads(t):
        return t.reshape(bsz, length, hh, nn)

    rh, kh, vh, ah, wh = heads(r), heads(k), heads(v), heads(a), heads(decay)

    def tm(t):
        return t.transpose(1, 0, 2, 3)

    def step(s, inp):
        r_t, w_t, k_t, v_t, aa_t, bb_t = inp
        sa = jnp.einsum('bhvk,bhk->bhv', s, aa_t)
        s = s * w_t[:, :, None, :] + sa[..., None] * bb_t[:, :, None, :] + v_t[..., None] * k_t[:, :, None, :]
        return s, jnp.einsum('bhvk,bhk->bhv', s, r_t)

    s0 = jnp.zeros((bsz, hh, nn, nn), f32)
    _, ys = lax.scan(step, s0, (tm(rh), tm(wh), tm(kh), tm(vh), tm(-kk), tm(kk * ah)))
    y = ys.transpose(1, 0, 2, 3)
    mean = jnp.mean(y, axis=-1, keepdims=True)
    var = jnp.mean(jnp.square(y - mean), axis=-1, keepdims=True)
    y = ((y - mean) * lax.rsqrt(var + RWKV_LNX_EPS)).reshape(bsz, length, RWKV_W)
    y = y * lnx_w.astype(f32) + lnx_b.astype(f32)
    bonus = jnp.sum(rh * kh * r_k.astype(f32).reshape(hh, nn), axis=-1, keepdims=True) * vh
    y = (y + bonus.reshape(bsz, length, RWKV_W)) * g
    return y.astype(z.dtype), v


def gla_branch(z, alpha_lora, alpha_bias, norm_g):
    bsz, length, _ = z.shape
    f32 = jnp.float32
    zf = z.astype(f32)
    q, k, v, g, a_in = jnp.split(zf, [GLA_K, 2 * GLA_K, 2 * GLA_K + GLA_V, 2 * GLA_K + 2 * GLA_V], axis=-1)
    log_a = jax.nn.log_sigmoid(a_in @ alpha_lora.astype(f32) + alpha_bias.astype(f32)) / GLA_TAU
    n_chunks = length // GLA_CHUNK

    def heads(t, dh):
        return t.reshape(bsz, n_chunks, GLA_CHUNK, GLA_HEADS, dh).transpose(1, 0, 3, 2, 4)

    qh = heads(q * (GLA_DK ** -0.5), GLA_DK)
    kh, lh, vh = heads(k, GLA_DK), heads(log_a, GLA_DK), heads(v, GLA_DV)
    causal = jnp.tril(jnp.ones((GLA_CHUNK, GLA_CHUNK), dtype=bool))[:, :, None]

    def step(s, inp):
        q_c, k_c, v_c, l_c = inp
        b = jnp.cumsum(l_c, axis=2)
        inter = jnp.einsum('bhtk,bhkv->bhtv', q_c * jnp.exp(b), s)
        diff = b[:, :, :, None, :] - b[:, :, None, :, :]
        dec = jnp.exp(jnp.where(causal, diff, -jnp.inf))
        att = jnp.einsum('bhtk,bhsk,bhtsk->bhts', q_c, k_c, dec)
        intra = jnp.einsum('bhts,bhsv->bhtv', att, v_c)
        b_last = b[:, :, -1:, :]
        s = s * jnp.exp(b_last[:, :, 0, :])[..., None] + jnp.einsum(
            'bhsk,bhsv->bhkv', k_c * jnp.exp(b_last - b), v_c)
        return s, inter + intra

    s0 = jnp.zeros((bsz, GLA_HEADS, GLA_DK, GLA_DV), f32)
    _, os_ = lax.scan(step, s0, (qh, kh, vh, lh))
    o = os_.transpose(1, 0, 3, 2, 4).reshape(bsz, length, GLA_HEADS, GLA_DV)
    o = o * lax.rsqrt(jnp.mean(o * o, axis=-1, keepdims=True) + NORM_EPS)
    o = o.reshape(bsz, length, GLA_V) * norm_g.astype(f32) * jax.nn.silu(g)
    return o.astype(z.dtype)


def setup_inputs(seed: int = 0) -> dict:
    key = jax.random.key(seed)
    ks = iter(jax.random.split(key, 64))
    f32 = jnp.float32

    def nrm(shape, scale):
        return jax.random.normal(next(ks), shape, f32) * scale

    def unif(shape, lo, hi):
        return jax.random.uniform(next(ks), shape, f32, lo, hi)

    d = D_MODEL
    x = nrm((BATCH, SEQ, d), 1.0)
    norm_mix = 1.0 + nrm((DEPTH, d), 0.02)
    w_in = nrm((DEPTH, d, IN_COLS), d ** -0.5)
    gate_bias = nrm((DEPTH, GATE_COLS), 0.1)
    n_state = jnp.arange(S5_STATE, dtype=f32)
    s5_lambda_re = -0.5 + nrm((DEPTH, S5_GROUPS, S5_STATE), 0.01)
    s5_lambda_im = math.pi * n_state + nrm((DEPTH, S5_GROUPS, S5_STATE), 0.01)
    s5_log_step = unif((DEPTH, S5_GROUPS), math.log(S5_DT_MIN), math.log(S5_DT_MAX))
    s5_b_re = nrm((DEPTH, S5_GROUPS, S5_STATE, S5_GROUP), (2 * S5_GROUP) ** -0.5)
    s5_b_im = nrm((DEPTH, S5_GROUPS, S5_STATE, S5_GROUP), (2 * S5_GROUP) ** -0.5)
    s5_c_re = nrm((DEPTH, S5_GROUPS, S5_GROUP, S5_STATE), S5_STATE ** -0.5)
    s5_c_im = nrm((DEPTH, S5_GROUPS, S5_GROUP, S5_STATE), S5_STATE ** -0.5)
    s5_d = nrm((DEPTH, S5_W), 1.0)
    s5_glu_w = nrm((DEPTH, S5_W, S5_W), S5_W ** -0.5)
    s5_glu_b = nrm((DEPTH, S5_W), 0.02)
    rwkv_mu = unif((DEPTH, RWKV_COLS), 0.0, 1.0)
    rwkv_w_lora = nrm((DEPTH, RWKV_DECAY_LORA, RWKV_W), 0.5 * RWKV_DECAY_LORA ** -0.5)
    ratio = jnp.arange(DEPTH, dtype=f32) / max(DEPTH - 1, 1)
    nch = jnp.arange(RWKV_W, dtype=f32) / (RWKV_W - 1)
    decay_speed = -7.0 + 5.0 * nch[None, :] ** (0.85 + jnp.sqrt(ratio)[:, None])
    rwkv_w0 = decay_speed + 0.5 + nrm((DEPTH, RWKV_W), 0.05)
    rwkv_a_lora = nrm((DEPTH, RWKV_AAA_LORA, RWKV_W), 0.5 * RWKV_AAA_LORA ** -0.5)
    rwkv_a0 = nrm((DEPTH, RWKV_W), 0.1)
    rwkv_g_lora = nrm((DEPTH, RWKV_GATE_LORA, RWKV_W), RWKV_GATE_LORA ** -0.5)
    rwkv_k_k = 0.85 + nrm((DEPTH, RWKV_W), 0.02)
    rwkv_k_a = 1.0 + nrm((DEPTH, RWKV_W), 0.02)
    rwkv_r_k = -0.04 + nrm((DEPTH, RWKV_W), 0.02)
    rwkv_lnx_w = 1.0 + nrm((DEPTH, RWKV_W), 0.02)
    rwkv_lnx_b = nrm((DEPTH, RWKV_W), 0.02)
    rwkv_vres_a = nrm((DEPTH - 1, d, RWKV_MV_LORA), d ** -0.5)
    rwkv_vres_mu = unif((DEPTH - 1, RWKV_MV_LORA), 0.0, 1.0)
    rwkv_vres_b = nrm((DEPTH - 1, RWKV_MV_LORA, RWKV_W), RWKV_MV_LORA ** -0.5)
    rwkv_vres_bias = 1.0 + nrm((DEPTH - 1, RWKV_W), 0.1)
    gla_alpha_lora = nrm((DEPTH, GLA_LORA, GLA_K), GLA_LORA ** -0.5)
    gla_alpha_bias = nrm((DEPTH, GLA_K), 0.1)
    gla_norm_g = 1.0 + nrm((DEPTH, GLA_V), 0.02)
    w_up = jnp.concatenate([nrm((DEPTH, S5_W, d), S5_W ** -0.5),
                            nrm((DEPTH, RWKV_W, d), RWKV_W ** -0.5),
                            nrm((DEPTH, GLA_V, d), GLA_V ** -0.5)], axis=1)
    w_out = nrm((DEPTH, d, d), d ** -0.5)
    norm_mlp = 1.0 + nrm((DEPTH, d), 0.02)
    mlp_w1 = nrm((DEPTH, d, D_FF), d ** -0.5)
    mlp_w2 = nrm((DEPTH, D_FF, d), D_FF ** -0.5)
    final_norm = 1.0 + nrm((d,), 0.02)
    return {"x": x, "norm_mix": norm_mix, "w_in": w_in, "gate_bias": gate_bias,
            "s5_lambda_re": s5_lambda_re, "s5_lambda_im": s5_lambda_im, "s5_log_step": s5_log_step,
            "s5_b_re": s5_b_re, "s5_b_im": s5_b_im, "s5_c_re": s5_c_re, "s5_c_im": s5_c_im,
            "s5_d": s5_d, "s5_glu_w": s5_glu_w, "s5_glu_b": s5_glu_b,
            "rwkv_mu": rwkv_mu, "rwkv_w_lora": rwkv_w_lora, "rwkv_w0": rwkv_w0,
            "rwkv_a_lora": rwkv_a_lora, "rwkv_a0": rwkv_a0, "rwkv_g_lora": rwkv_g_lora,
            "rwkv_k_k": rwkv_k_k, "rwkv_k_a": rwkv_k_a, "rwkv_r_k": rwkv_r_k,
            "rwkv_lnx_w": rwkv_lnx_w, "rwkv_lnx_b": rwkv_lnx_b,
            "rwkv_vres_a": rwkv_vres_a, "rwkv_vres_mu": rwkv_vres_mu, "rwkv_vres_b": rwkv_vres_b,
            "rwkv_vres_bias": rwkv_vres_bias,
            "gla_alpha_lora": gla_alpha_lora, "gla_alpha_bias": gla_alpha_bias, "gla_norm_g": gla_norm_g,
            "w_up": w_up, "w_out": w_out, "norm_mlp": norm_mlp, "mlp_w1": mlp_w1, "mlp_w2": mlp_w2,
            "final_norm": final_norm}


def reference(x, norm_mix, w_in, gate_bias,
              s5_lambda_re, s5_lambda_im, s5_log_step, s5_b_re, s5_b_im, s5_c_re, s5_c_im,
              s5_d, s5_glu_w, s5_glu_b,
              rwkv_mu, rwkv_w_lora, rwkv_w0, rwkv_a_lora, rwkv_a0, rwkv_g_lora,
              rwkv_k_k, rwkv_k_a, rwkv_r_k, rwkv_lnx_w, rwkv_lnx_b,
              rwkv_vres_a, rwkv_vres_mu, rwkv_vres_b, rwkv_vres_bias,
              gla_alpha_lora, gla_alpha_bias, gla_norm_g,
              w_up, w_out, norm_mlp, mlp_w1, mlp_w2, final_norm):
    o_rw = S5_W
    o_gla = o_rw + RWKV_COLS
    o_gate = o_gla + GLA_COLS
    r_b = S5_W
    r_c = S5_W + RWKV_W
    v_first = None
    for l in range(DEPTH):
        u = rmsnorm(x, norm_mix[l])
        z = u @ w_in[l]
        y_a = s5_branch(z[..., :o_rw], s5_lambda_re[l], s5_lambda_im[l], s5_log_step[l],
                        s5_b_re[l], s5_b_im[l], s5_c_re[l], s5_c_im[l], s5_d[l],
                        s5_glu_w[l], s5_glu_b[l])
        if l == 0:
            v_gate = None
        else:
            v_gate = jax.nn.sigmoid(rwkv_vres_bias[l - 1] + token_shift(
                u @ rwkv_vres_a[l - 1], rwkv_vres_mu[l - 1]) @ rwkv_vres_b[l - 1])
        y_b, v_l = rwkv7_branch(z[..., o_rw:o_gla], rwkv_mu[l], rwkv_w_lora[l], rwkv_w0[l],
                                rwkv_a_lora[l], rwkv_a0[l], rwkv_g_lora[l], rwkv_k_k[l],
                                rwkv_k_a[l], rwkv_r_k[l], rwkv_lnx_w[l], rwkv_lnx_b[l],
                                v_first, v_gate)
        if l == 0:
            v_first = v_l
        y_c = gla_branch(z[..., o_gla:o_gate], gla_alpha_lora[l], gla_alpha_bias[l], gla_norm_g[l])
        gates = jax.nn.sigmoid(z[..., o_gate:] + gate_bias[l])
        g_a, g_b, g_c = jnp.split(gates, N_BRANCH, axis=-1)
        wu = w_up[l]
        merged = (g_a * (y_a @ wu[:r_b]) + g_b * (y_b @ wu[r_b:r_c]) + g_c * (y_c @ wu[r_c:]))
        x = x + merged @ w_out[l]
        h = rmsnorm(x, norm_mlp[l])
        x = x + jnp.square(jax.nn.relu(h @ mlp_w1[l])) @ mlp_w2[l]
    return rmsnorm(x, final_norm)
```

```cpp
#include <hip/hip_runtime.h>
#include <cstdio>
#include <cstdint>

#define GAS __attribute__((address_space(1)))
#define LAS __attribute__((address_space(3)))
typedef unsigned short bf16;
typedef short bf16x8 __attribute__((ext_vector_type(8)));
typedef float f32x4 __attribute__((ext_vector_type(4)));
typedef float f32x2 __attribute__((ext_vector_type(2)));
typedef unsigned u32x4 __attribute__((ext_vector_type(4)));
typedef unsigned u32x2 __attribute__((ext_vector_type(2)));
typedef __bf16 bf16x2_t __attribute__((ext_vector_type(2)));
#define DI __device__ __forceinline__

constexpr int M = 16384, D = 2048, DEPTH = 4, DFF = 8192;
constexpr int S5W = 768, S5G = 48, S5P = 64;
constexpr int RW = 640, RH = 10, RN = 64, RWCOLS = 2400;
constexpr int GV = 640, GH = 5, GK = 320, GDK = 64, GDV = 128;
constexpr int INCOLS = 11248, ZP = 11520;
constexpr int ZC_R = 768, ZC_K = 1408, ZC_V = 2048, ZC_WIN = 2688, ZC_AIN = 2784, ZC_GIN = 2912;
constexpr int ZC_GQ = 3168, ZC_GKK = 3488, ZC_GV = 3808, ZC_GG = 4448, ZC_GA = 5088, ZC_GATE = 5104, ZC_VRES = 11248;
constexpr float NORM_EPS = 1e-6f;

DI unsigned pk2(float lo, float hi) { f32x2 v = {lo, hi}; bf16x2_t r = __builtin_convertvector(v, bf16x2_t); return __builtin_bit_cast(unsigned, r); }
DI float bflo(unsigned u) { return __builtin_bit_cast(float, u << 16); }
DI float bfhi(unsigned u) { return __builtin_bit_cast(float, u & 0xffff0000u); }
DI float bf2f(bf16 b) { return __builtin_bit_cast(float, ((unsigned)b) << 16); }
DI void unpack8(const u32x4 v, float (&f)[8]) { f[0] = bflo(v.x); f[1] = bfhi(v.x); f[2] = bflo(v.y); f[3] = bfhi(v.y); f[4] = bflo(v.z); f[5] = bfhi(v.z); f[6] = bflo(v.w); f[7] = bfhi(v.w); }
DI u32x4 pack8(const float (&f)[8]) { u32x4 o; o.x = pk2(f[0], f[1]); o.y = pk2(f[2], f[3]); o.z = pk2(f[4], f[5]); o.w = pk2(f[6], f[7]); return o; }
DI float sigmoidf_(float x) { return __builtin_amdgcn_rcpf(1.f + __expf(-x)); }
DI float softplusf_(float x) { return fmaxf(x, 0.f) + __logf(1.f + __expf(-fabsf(x))); }
DI float wave_sum(float v) {
    v += __builtin_bit_cast(float, __builtin_amdgcn_update_dpp(0, __builtin_bit_cast(int, v), 0xB1, 0xF, 0xF, true));
    v += __builtin_bit_cast(float, __builtin_amdgcn_update_dpp(0, __builtin_bit_cast(int, v), 0x4E, 0xF, 0xF, true));
    v += __builtin_bit_cast(float, __builtin_amdgcn_update_dpp(0, __builtin_bit_cast(int, v), 0x141, 0xF, 0xF, true));
    v += __builtin_bit_cast(float, __builtin_amdgcn_update_dpp(0, __builtin_bit_cast(int, v), 0x140, 0xF, 0xF, true));
    const int iv = __builtin_bit_cast(int, v);
    const float a0 = __builtin_bit_cast(float, __builtin_amdgcn_readlane(iv, 0)), a1 = __builtin_bit_cast(float, __builtin_amdgcn_readlane(iv, 16)),
                a2 = __builtin_bit_cast(float, __builtin_amdgcn_readlane(iv, 32)), a3 = __builtin_bit_cast(float, __builtin_amdgcn_readlane(iv, 48));
    return (a0 + a1) + (a2 + a3);
}
DI float sum8(float v) { v += __builtin_bit_cast(float, __builtin_amdgcn_update_dpp(0, __builtin_bit_cast(int, v), 0xB1, 0xF, 0xF, true));
                         v += __builtin_bit_cast(float, __builtin_amdgcn_update_dpp(0, __builtin_bit_cast(int, v), 0x4E, 0xF, 0xF, true));
                         v += __builtin_bit_cast(float, __builtin_amdgcn_update_dpp(0, __builtin_bit_cast(int, v), 0x141, 0xF, 0xF, true)); return v; }
#define LDS_WAIT() asm volatile("s_waitcnt lgkmcnt(0)" ::: "memory")
#define VM_WAIT() asm volatile("s_waitcnt vmcnt(0)" ::: "memory")

DI int lane_id_fresh() { int l; asm volatile("v_mbcnt_lo_u32_b32 %0, -1, 0\n\tv_mbcnt_hi_u32_b32 %0, -1, %0" : "=v"(l)); return l; }
#define XB_TMO      128
#define XB_XCNT(j)  (256  + 64 * (j))
#define XB_XSUB(j)  (1280 + 64 * (j))
#define XB_XGEN(j)  (2304 + 64 * (j))
#define XB_TOP      3328
#define XB_TOPGEN   3392
#define XCD_BAR_WORDS 3456
#define XB_SPIN_CAP (1u << 20)
__device__ __forceinline__ unsigned xb_ld(unsigned* p)              { return __hip_atomic_load(p, __ATOMIC_RELAXED, __HIP_MEMORY_SCOPE_AGENT); }
__device__ __forceinline__ unsigned xb_add(unsigned* p, unsigned v) { return __hip_atomic_fetch_add(p, v, __ATOMIC_RELAXED, __HIP_MEMORY_SCOPE_AGENT); }
__device__ __forceinline__ unsigned xb_xcc_id() { return (unsigned)__builtin_amdgcn_s_getreg((3 << 11) | 20) & 0xFu; }
#define XB_SPIN(cond, bar) do { unsigned _sp = 0; while (cond) { __builtin_amdgcn_s_sleep(1); \
    if ((++_sp & 255u) == 0u) { if (xb_ld(&(bar)[XB_TMO])) break; if (_sp > XB_SPIN_CAP) { atomicAdd(&(bar)[XB_TMO], 1u); break; } } } } while (0)
struct XcdBarrier { unsigned* bar; unsigned x; volatile LAS unsigned* st; unsigned w0; };
__device__ __forceinline__ XcdBarrier xcd_barrier_post(unsigned* bar, volatile LAS unsigned* st, unsigned w0) {
    XcdBarrier b; b.bar = bar; b.x = xb_xcc_id(); b.st = st; b.w0 = w0;
    if (w0 && lane_id_fresh() == 0) (void)xb_add(&bar[XB_XCNT(b.x)], 1u);
    return b;
}
__device__ __forceinline__ void xcd_barrier_complete(unsigned* bar, unsigned x, unsigned& nloc, unsigned& nx) {
    const unsigned G = gridDim.x * gridDim.y * gridDim.z;
    unsigned sum, cnt, mine, sp = 0u;
    for (;;) {
        sum = 0u; cnt = 0u; mine = 0u;
#pragma unroll
        for (unsigned j = 0; j < 16; ++j) { const unsigned c = xb_ld(&bar[XB_XCNT(j)]); sum += c; cnt += (c > 0u) ? 1u : 0u; mine = (j == x) ? c : mine; }
        if (sum == G) break;
        __builtin_amdgcn_s_sleep(1);
        if ((++sp & 255u) == 0u) { if (xb_ld(&bar[XB_TMO])) break; if (sp > XB_SPIN_CAP) { atomicAdd(&bar[XB_TMO], 1u); break; } }
    }
    nloc = mine > 0u ? mine : 1u; nx = cnt > 0u ? cnt : 1u;
}
__device__ __forceinline__ void xcd_barrier(const XcdBarrier& b) {
    asm volatile("s_waitcnt vmcnt(0)" ::: "memory");
    __syncthreads();
    if (b.w0 && lane_id_fresh() == 0) {
        unsigned* bar = b.bar;
        __builtin_amdgcn_s_waitcnt(0);
        unsigned nloc = b.st[0], nx = b.st[1];
        if (nloc == 0u) { xcd_barrier_complete(bar, b.x, nloc, nx); b.st[0] = nloc; b.st[1] = nx; }
        const unsigned old = xb_add(&bar[XB_XSUB(b.x)], 1u);
        const unsigned gen = old / nloc;
        if (old + 1u == (gen + 1u) * nloc) {
            __builtin_amdgcn_fence(__ATOMIC_RELEASE, "agent");
            asm volatile("s_waitcnt vmcnt(0)" ::: "memory");
            const unsigned og = xb_add(&bar[XB_TOP], 1u);
            const unsigned tg = og / nx;
            if (og + 1u == (tg + 1u) * nx) xb_add(&bar[XB_TOPGEN], 1u);
            else XB_SPIN(xb_ld(&bar[XB_TOPGEN]) == tg, bar);
            __builtin_amdgcn_fence(__ATOMIC_ACQUIRE, "agent");
            xb_add(&bar[XB_XGEN(b.x)], 1u);
            asm volatile("s_waitcnt vmcnt(0)" ::: "memory");
        } else {
            XB_SPIN(xb_ld(&bar[XB_XGEN(b.x)]) == gen, bar);
            __builtin_amdgcn_fence(__ATOMIC_ACQUIRE, "agent");
            asm volatile("s_waitcnt vmcnt(0)" ::: "memory");
        }
    }
    __syncthreads();
}
constexpr int BM = 256, BK = 64, HALF = 128, HTB = HALF * BK * 2, STAGE_BYTES = 8 * HTB;
DI int lds_byte(int r, int c) { const int st = (r >> 4) * 2 + (c >> 5), rr = r & 15, cc = c & 31, ob = rr * 64 + cc * 2; return st * 1024 + (ob ^ (((ob >> 9) & 1) << 5)); }
DI void stage_rc(int b, int& R, int& C) { const int st = b / 1024, sb = b % 1024, swz = sb ^ (((sb >> 9) & 1) << 5); R = (st >> 1) * 16 + swz / 64; C = (st & 1) * 32 + (swz % 64) / 2; }
DI int perm32(int rho) { const int n = rho >> 4, i = rho & 15; return 8 * (i >> 2) + 4 * n + (i & 3); }
struct Unit { int pm, pn, seg; };
struct TileOrder {
    int nM, nN, nwg;
    DI void init(int nM_, int nN_) { nM = nM_; nN = nN_; nwg = nM_ * nN_; }
    DI void map(int L, int& pm, int& pn) const {
        int wgid = L; { const int q = nwg / 8, r = nwg % 8, xcd = wgid % 8, off = wgid / 8; wgid = (xcd < r ? xcd * (q + 1) : r * (q + 1) + (xcd - r) * q) + off; }
        const int nig = 8 * nN, gid = wgid / nig, fm = gid * 8, gsz = (nM - fm) < 8 ? (nM - fm) : 8;
        pm = fm + ((wgid % nig) % gsz); pn = (wgid % nig) / gsz;
    }
};
struct SchedPlain {
    TileOrder T; int G, c, nt; const char* A; const char* B; size_t ta, tb;
    DI void init(const bf16* A_, int lda, const bf16* B_, int ldb, int nM, int nN, int K, int G_, int c_) { T.init(nM, nN); G = G_; c = c_; nt = K / BK; A = (const char*)A_; B = (const char*)B_; ta = (size_t)BM * lda * 2; tb = (size_t)BM * ldb * 2; }
    DI bool next(int i, Unit& u) const { const long L = (long)i * G + c; if (L >= T.nwg) return false; T.map((int)L, u.pm, u.pn); u.seg = 0; return true; }
    DI const char* aptr(const Unit& u) const { return A + (size_t)u.pm * ta; }
    DI const char* bptr(const Unit& u) const { return B + (size_t)u.pn * tb; }
    DI int ntiles(const Unit&) const { return nt; }
};
struct SchedSeg3 {
    TileOrder T; int G, c; const char* A; const char* B; size_t ta, tb;
    DI void init(const bf16* A_, int lda, const bf16* B_, int ldb, int nM, int nN, int G_, int c_) { T.init(nM, nN); G = G_; c = c_; A = (const char*)A_; B = (const char*)B_; ta = (size_t)BM * lda * 2; tb = (size_t)BM * ldb * 2; }
    DI bool next(int i, Unit& u) const { const int ti = i / 3; const long L = (long)ti * G + c; if (L >= T.nwg) return false; T.map((int)L, u.pm, u.pn); u.seg = i - 3 * ti; return true; }
    DI int kofs(int seg) const { return seg == 0 ? 0 : (seg == 1 ? 768 : 1408); }
    DI const char* aptr(const Unit& u) const { return A + (size_t)u.pm * ta + (size_t)kofs(u.seg) * 2; }
    DI const char* bptr(const Unit& u) const { return B + (size_t)u.pn * tb + (size_t)kofs(u.seg) * 2; }
    DI int ntiles(const Unit& u) const { return u.seg == 0 ? 12 : 10; }
};

template <class Epi, class Sched>
DI void gemm_phase(LAS unsigned char* lds, const int wv, const int lda, const int ldb, const Sched& S, const Epi& E) {
    int tid_ = wv * 64 + lane_id_fresh(); asm volatile("" : "+v"(tid_));
    const int tid = tid_, wid = __builtin_amdgcn_readfirstlane(tid >> 6), lane = tid & 63, wr = wid >> 2, wc = wid & 3, fr = lane & 15, fq = lane >> 4;
    unsigned voffA[2], voffB[2];
#pragma unroll
    for (int i = 0; i < 2; ++i) { int R, C; stage_rc(tid * 16 + i * 8192, R, C); const int Rb = Epi::PERM ? ((R & ~31) + perm32(R & 31)) : R;
        voffA[i] = (unsigned)(R * lda + C) * 2u; voffB[i] = (unsigned)(Rb * ldb + C) * 2u; }
    const size_t kstep = (size_t)(BK * 2);
    const size_t hstepA = (size_t)HALF * lda * 2, hstepB = (size_t)HALF * ldb * 2;
    const unsigned ldsw = (unsigned)wid * 1024u;
    const int aoff = lds_byte(wr * 64 + fr, fq * 8), boff = lds_byte(wc * 32 + fr, fq * 8);
#define PG8_SA(b, h) (((b) * 2 + (h)) * HTB)
#define PG8_SB(b, h) ((4 + (b) * 2 + (h)) * HTB)
#define PG8_STAGE(bufoff, gbase, voff) do { _Pragma("unroll") for (int _i = 0; _i < 2; ++_i) \
        __builtin_amdgcn_global_load_lds((const unsigned*)((const char*)(gbase) + (voff)[_i]), (LAS unsigned*)(lds + (bufoff) + ldsw + _i * 8192), 16, 0, 0); } while (0)
#define PG8_LDA(dst, b, h) do { _Pragma("unroll") for (int m = 0; m < 4; ++m) _Pragma("unroll") for (int k = 0; k < 2; ++k) dst[m][k] = *(const LAS bf16x8*)(lds + PG8_SA(b, h) + aoff + m * 2048 + k * 1024); } while (0)
#define PG8_LDB(dst, b, h) do { _Pragma("unroll") for (int n = 0; n < 2; ++n) _Pragma("unroll") for (int k = 0; k < 2; ++k) dst[n][k] = *(const LAS bf16x8*)(lds + PG8_SB(b, h) + boff + n * 2048 + k * 1024); } while (0)
#define PG8_MMA(ai, bj, At, Bt) do { __builtin_amdgcn_s_setprio(1); _Pragma("unroll") for (int m = 0; m < 4; ++m) _Pragma("unroll") for (int n = 0; n < 2; ++n) _Pragma("unroll") for (int k = 0; k < 2; ++k) \
        acc[ai][bj][m][n] = __builtin_amdgcn_mfma_f32_16x16x32_bf16(Bt[n][k], At[m][k], acc[ai][bj][m][n], 0, 0, 0); __builtin_amdgcn_s_setprio(0); } while (0)
#define PG8_WAIT_V(n) asm volatile("s_waitcnt vmcnt(" #n ")" ::: "memory")
#define PG8_WAIT_L(n) asm volatile("s_waitcnt lgkmcnt(" #n ")" ::: "memory")
#define PG8_BAR __builtin_amdgcn_s_barrier()
#define PG8_SCHED __builtin_amdgcn_sched_barrier(0)
    Unit cur, nxt; int ui = 0;
    if (!S.next(0, cur)) return;
    f32x4 acc[2][2][4][2];
#pragma unroll
    for (int a = 0; a < 2; ++a)
#pragma unroll
        for (int b = 0; b < 2; ++b)
#pragma unroll
            for (int m = 0; m < 4; ++m)
#pragma unroll
                for (int n = 0; n < 2; ++n) acc[a][b][m][n] = (f32x4){0.f, 0.f, 0.f, 0.f};
    bf16x8 At[4][2], B0[2][2], B1[2][2];
    const char* cA = S.aptr(cur); const char* cB = S.bptr(cur); int nt = S.ntiles(cur);
    PG8_STAGE(PG8_SB(0, 0), cB, voffB); PG8_STAGE(PG8_SB(0, 1), cB + hstepB, voffB); PG8_STAGE(PG8_SA(0, 0), cA, voffA); PG8_STAGE(PG8_SA(0, 1), cA + hstepA, voffA);
    if (wr == 1) PG8_BAR;
    PG8_WAIT_V(2); PG8_BAR;
    PG8_STAGE(PG8_SB(1, 0), cB + kstep, voffB); PG8_STAGE(PG8_SA(1, 0), cA + kstep, voffA); PG8_STAGE(PG8_SB(1, 1), cB + hstepB + kstep, voffB);
    PG8_WAIT_V(6); PG8_BAR;
    for (;;) {
        const bool has_next = S.next(ui + 1, nxt);
        const char* nA = has_next ? S.aptr(nxt) : cA; const char* nB = has_next ? S.bptr(nxt) : cB;
        for (int t = 0; t < nt; t += 2) {
            const bool last = (t == nt - 2);
            const char* a1 = cA + (size_t)(t + 1) * kstep;
            const char* a2 = last ? nA : cA + (size_t)(t + 2) * kstep; const char* b2 = last ? nB : cB + (size_t)(t + 2) * kstep;
            const char* a3 = a2 + kstep; const char* b3 = b2 + kstep;
            PG8_LDB(B0, 0, 0); PG8_LDB(B1, 0, 1); PG8_SCHED; PG8_LDA(At, 0, 0); PG8_STAGE(PG8_SA(1, 1), a1 + hstepA, voffA);
            PG8_WAIT_V(8); PG8_WAIT_L(0); PG8_BAR; PG8_MMA(0, 0, At, B0); PG8_MMA(0, 1, At, B1); PG8_BAR; PG8_SCHED;
            PG8_LDA(At, 0, 1); PG8_STAGE(PG8_SB(0, 0), b2, voffB); PG8_STAGE(PG8_SB(0, 1), b2 + hstepB, voffB); PG8_STAGE(PG8_SA(0, 0), a2, voffA);
            PG8_WAIT_V(8); PG8_WAIT_L(0); PG8_BAR; PG8_MMA(1, 0, At, B0); PG8_MMA(1, 1, At, B1); PG8_BAR; PG8_SCHED;
            PG8_LDB(B0, 1, 0); PG8_LDB(B1, 1, 1); PG8_SCHED; PG8_LDA(At, 1, 0); PG8_STAGE(PG8_SA(0, 1), a2 + hstepA, voffA);
            PG8_WAIT_V(8); PG8_WAIT_L(0); PG8_BAR; PG8_MMA(0, 0, At, B0); PG8_MMA(0, 1, At, B1); PG8_BAR; PG8_SCHED;
            PG8_LDA(At, 1, 1); PG8_STAGE(PG8_SB(1, 0), b3, voffB); PG8_STAGE(PG8_SB(1, 1), b3 + hstepB, voffB); PG8_STAGE(PG8_SA(1, 0), a3, voffA);
            PG8_WAIT_V(8); PG8_WAIT_L(0); PG8_BAR; PG8_MMA(1, 0, At, B0); PG8_MMA(1, 1, At, B1); PG8_BAR; PG8_SCHED;
        }
        if (wr == 0) PG8_BAR;
        const bool clr = E(acc, cur, wr, wc, fr, fq);
        if (!has_next) break;
        if (clr) {
#pragma unroll
            for (int a = 0; a < 2; ++a)
#pragma unroll
                for (int b = 0; b < 2; ++b)
#pragma unroll
                    for (int m = 0; m < 4; ++m)
#pragma unroll
                        for (int n = 0; n < 2; ++n) acc[a][b][m][n] = (f32x4){0.f, 0.f, 0.f, 0.f};
        }
        cur = nxt; cA = nA; cB = nB; nt = S.ntiles(cur); ++ui;
        if (wr == 1) PG8_BAR;
    }
    PG8_WAIT_V(0);
    PG8_BAR;
#undef PG8_SA
#undef PG8_SB
#undef PG8_STAGE
#undef PG8_LDA
#undef PG8_LDB
#undef PG8_MMA
#undef PG8_WAIT_V
#undef PG8_WAIT_L
#undef PG8_BAR
#undef PG8_SCHED
}

typedef f32x4 AccT[2][2][4][2];
struct EpiInproj {
    static constexpr bool PERM = true;
    bf16* Z; const float* gbias; bf16* ZS5; const LAS float* rs;
    DI bool operator()(AccT& acc, const Unit& u, int wr, int wc, int fr, int fq) const {
        const int row0 = u.pm * BM + wr * 64 + fr, col0 = u.pn * BM + wc * 32 + 8 * fq;
        float rsv[2][4];
#pragma unroll
        for (int ai = 0; ai < 2; ++ai)
#pragma unroll
            for (int m = 0; m < 4; ++m) rsv[ai][m] = rs[row0 + ai * HALF + m * 16];
#pragma unroll
        for (int bj = 0; bj < 2; ++bj) {
            const int col = col0 + bj * HALF; const bool gate = (col >= ZC_GATE) && (col < ZC_VRES); const bool s5c = col < S5W;
            f32x4 b0 = {0.f, 0.f, 0.f, 0.f}, b1 = b0;
            if (gate) { b0 = *(const GAS f32x4*)(gbias + (col - ZC_GATE)); b1 = *(const GAS f32x4*)(gbias + (col - ZC_GATE) + 4); }
#pragma unroll
            for (int ai = 0; ai < 2; ++ai)
#pragma unroll
                for (int m = 0; m < 4; ++m) {
                    f32x4 v0 = acc[ai][bj][m][0] * rsv[ai][m], v1 = acc[ai][bj][m][1] * rsv[ai][m];
                    if (gate) { v0 += b0; v1 += b1;
#pragma unroll
                        for (int e = 0; e < 4; ++e) { v0[e] = sigmoidf_(v0[e]); v1[e] = sigmoidf_(v1[e]); } }
                    u32x4 w; w.x = pk2(v0[0], v0[1]); w.y = pk2(v0[2], v0[3]); w.z = pk2(v1[0], v1[1]); w.w = pk2(v1[2], v1[3]);
                    if (s5c) *(GAS u32x4*)(ZS5 + ((size_t)(col >> 4) * M + (row0 + ai * HALF + m * 16)) * 16 + (col & 8)) = w;
                    else *(GAS u32x4*)(Z + (size_t)(row0 + ai * HALF + m * 16) * ZP + col) = w;
                }
        }
        return true;
    }
};
struct EpiGlu {
    static constexpr bool PERM = true;
    const bf16* ypre; bf16* ycat; const float* gb;
    DI bool operator()(AccT& acc, const Unit& u, int wr, int wc, int fr, int fq) const {
        const int row0 = u.pm * BM + wr * 64 + fr, col0 = u.pn * BM + wc * 32 + 8 * fq;
        f32x4 b0[2], b1[2];
#pragma unroll
        for (int bj = 0; bj < 2; ++bj) { b0[bj] = *(const GAS f32x4*)(gb + col0 + bj * HALF); b1[bj] = *(const GAS f32x4*)(gb + col0 + bj * HALF + 4); }
#pragma unroll
        for (int ai = 0; ai < 2; ++ai) {
            u32x4 yv[2][4];
#pragma unroll
            for (int bj = 0; bj < 2; ++bj)
#pragma unroll
                for (int m = 0; m < 4; ++m) yv[bj][m] = *(const GAS u32x4*)(ypre + (size_t)(row0 + ai * HALF + m * 16) * S5W + col0 + bj * HALF);
            __builtin_amdgcn_sched_barrier(0);
#pragma unroll
            for (int bj = 0; bj < 2; ++bj)
#pragma unroll
                for (int m = 0; m < 4; ++m) { float y[8]; unpack8(yv[bj][m], y);
                    const f32x4 v0 = acc[ai][bj][m][0] + b0[bj], v1 = acc[ai][bj][m][1] + b1[bj];
                    float o[8];
#pragma unroll
                    for (int e = 0; e < 4; ++e) { o[e] = y[e] * sigmoidf_(v0[e]); o[4 + e] = y[4 + e] * sigmoidf_(v1[e]); }
                    *(GAS u32x4*)(ycat + (size_t)(row0 + ai * HALF + m * 16) * D + col0 + bj * HALF) = pack8(o); }
            __builtin_amdgcn_sched_barrier(0);
        }
        return true;
    }
};
struct EpiMerged {
    static constexpr bool PERM = true;
    const bf16* Z; bf16* out;
    DI bool operator()(AccT& acc, const Unit& u, int wr, int wc, int fr, int fq) const {
        const int row0 = u.pm * BM + wr * 64 + fr, col0 = u.pn * BM + wc * 32 + 8 * fq;
        const int seg = u.seg;
#pragma unroll
        for (int ai = 0; ai < 2; ++ai) {
            u32x4 ga[2][4], gb[2][4];
#pragma unroll
            for (int bj = 0; bj < 2; ++bj)
#pragma unroll
                for (int m = 0; m < 4; ++m) { const bf16* zr = Z + (size_t)(row0 + ai * HALF + m * 16) * ZP + ZC_GATE + col0 + bj * HALF;
                    ga[bj][m] = *(const GAS u32x4*)(zr + seg * D); gb[bj][m] = *(const GAS u32x4*)(zr + (seg < 2 ? seg + 1 : seg) * D); }
            __builtin_amdgcn_sched_barrier(0);
#pragma unroll
            for (int bj = 0; bj < 2; ++bj)
#pragma unroll
                for (int m = 0; m < 4; ++m) {
                    float g0[8], g1[8], s[8]; unpack8(ga[bj][m], g0); unpack8(gb[bj][m], g1);
#pragma unroll
                    for (int e = 0; e < 8; ++e) { const float a = fmaxf(g0[e], 1e-20f); s[e] = (seg < 2) ? a * __builtin_amdgcn_rcpf(fmaxf(g1[e], 1e-20f)) : a; }
                    f32x4 v0 = acc[ai][bj][m][0], v1 = acc[ai][bj][m][1];
#pragma unroll
                    for (int e = 0; e < 4; ++e) { v0[e] *= s[e]; v1[e] *= s[4 + e]; }
                    acc[ai][bj][m][0] = v0; acc[ai][bj][m][1] = v1;
                    if (seg == 2) { u32x4 w; w.x = pk2(v0[0], v0[1]); w.y = pk2(v0[2], v0[3]); w.z = pk2(v1[0], v1[1]); w.w = pk2(v1[2], v1[3]);
                        *(GAS u32x4*)(out + (size_t)(row0 + ai * HALF + m * 16) * D + col0 + bj * HALF) = w; } }
            __builtin_amdgcn_sched_barrier(0);
        }
        return seg == 2;
    }
};
constexpr int XP = D;
struct EpiResid {
    static constexpr bool PERM = true;
    const bf16* xb; bf16* xo; float* ssq;
    DI bool operator()(AccT& acc, const Unit& u, int wr, int wc, int fr, int fq) const {
        const int row0 = u.pm * BM + wr * 64 + fr, col0 = u.pn * BM + wc * 32 + 8 * fq;
        float ps[2][4];
#pragma unroll
        for (int ai = 0; ai < 2; ++ai) {
            u32x4 xv[4][2];
#pragma unroll
            for (int m = 0; m < 4; ++m) { const bf16* rowp = xb + (size_t)(row0 + ai * HALF + m * 16) * XP + col0;
#pragma unroll
                for (int bj = 0; bj < 2; ++bj) xv[m][bj] = *(const GAS u32x4*)(rowp + bj * HALF); }
            __builtin_amdgcn_sched_barrier(0);
#pragma unroll
            for (int m = 0; m < 4; ++m) { bf16* rowp = xo + (size_t)(row0 + ai * HALF + m * 16) * XP + col0; float s = 0.f;
#pragma unroll
                for (int bj = 0; bj < 2; ++bj) { const u32x4 x = xv[m][bj]; const f32x4 a0 = acc[ai][bj][m][0], a1 = acc[ai][bj][m][1];
                    const float y0 = bflo(x.x) + a0[0], y1 = bfhi(x.x) + a0[1], y2 = bflo(x.y) + a0[2], y3 = bfhi(x.y) + a0[3], y4 = bflo(x.z) + a1[0], y5 = bfhi(x.z) + a1[1], y6 = bflo(x.w) + a1[2], y7 = bfhi(x.w) + a1[3];
                    s += (y0 * y0 + y1 * y1) + (y2 * y2 + y3 * y3) + (y4 * y4 + y5 * y5) + (y6 * y6 + y7 * y7);
                    u32x4 w; w.x = pk2(y0, y1); w.y = pk2(y2, y3); w.z = pk2(y4, y5); w.w = pk2(y6, y7);
                    *(GAS u32x4*)(rowp + bj * HALF) = w; }
                ps[ai][m] = s; }
            __builtin_amdgcn_sched_barrier(0);
        }
        { int a16 = ((fr + 16 * fq) ^ 16) << 2, a32 = ((fr + 16 * fq) ^ 32) << 2;
#pragma unroll
          for (int ai = 0; ai < 2; ++ai)
#pragma unroll
              for (int m = 0; m < 4; ++m) { float s = ps[ai][m];
                  s += __builtin_bit_cast(float, __builtin_amdgcn_ds_bpermute(a16, __builtin_bit_cast(int, s)));
                  s += __builtin_bit_cast(float, __builtin_amdgcn_ds_bpermute(a32, __builtin_bit_cast(int, s)));
                  if (fq == 0) ssq[(size_t)(row0 + ai * HALF + m * 16) * 32 + u.pn * 4 + wc] = s; } }
        return true;
    }
};
struct EpiRelu2 {
    static constexpr bool PERM = true;
    bf16* out; const LAS float* rs;
    DI bool operator()(AccT& acc, const Unit& u, int wr, int wc, int fr, int fq) const {
        const int row0 = u.pm * BM + wr * 64 + fr, col0 = u.pn * BM + wc * 32 + 8 * fq;
#pragma unroll
        for (int ai = 0; ai < 2; ++ai)
#pragma unroll
            for (int m = 0; m < 4; ++m) { bf16* rowp = out + (size_t)(row0 + ai * HALF + m * 16) * DFF + col0; const float rsv = rs[row0 + ai * HALF + m * 16];
#pragma unroll
                for (int bj = 0; bj < 2; ++bj) { f32x4 v0 = acc[ai][bj][m][0] * rsv, v1 = acc[ai][bj][m][1] * rsv;
#pragma unroll
                    for (int e = 0; e < 4; ++e) { const float a = fmaxf(v0[e], 0.f), b = fmaxf(v1[e], 0.f); v0[e] = a * a; v1[e] = b * b; }
                    u32x4 w; w.x = pk2(v0[0], v0[1]); w.y = pk2(v0[2], v0[3]); w.z = pk2(v1[0], v1[1]); w.w = pk2(v1[2], v1[3]);
                    *(GAS u32x4*)(rowp + bj * HALF) = w; } }
        return true;
    }
};
constexpr size_t MiB = 1u << 20;
constexpr size_t WS_CTL = 0, CTL_ZERO_BYTES = 1 * MiB;
constexpr size_t SZ_WIN = (size_t)ZP * D * 2, SZ_WSQ = (size_t)D * D * 2, SZ_W1 = (size_t)DFF * D * 2, SZ_GLU = (size_t)S5W * S5W * 2;
constexpr size_t SZ_WL = (size_t)RW * 96 * 2, SZ_AL = (size_t)RW * 128 * 2, SZ_GL = (size_t)RW * 256 * 2, SZ_VB = (size_t)RW * 64 * 2;
constexpr size_t LW_WIN = 0, LW_WUP = LW_WIN + SZ_WIN, LW_WOUT = LW_WUP + SZ_WSQ, LW_W1 = LW_WOUT + SZ_WSQ, LW_W2 = LW_W1 + SZ_W1, LW_GLU = LW_W2 + SZ_W1,
                 LW_WL = LW_GLU + SZ_GLU, LW_AL = LW_WL + SZ_WL, LW_GL = LW_AL + SZ_AL, LW_VB = LW_GL + SZ_GL, LW_SIZE = LW_VB + SZ_VB;
constexpr size_t WS_W = 1 * MiB;
constexpr size_t WS_R1 = WS_W + DEPTH * LW_SIZE;
constexpr size_t SZ_R1 = (size_t)M * D * 2;
constexpr size_t WS_R2 = WS_R1 + SZ_R1;
constexpr size_t SZ_R2 = (size_t)M * ZP * 2;
constexpr size_t WS_R3 = WS_R2 + SZ_R2;
constexpr size_t WS_R5 = WS_R3 + SZ_R1;
constexpr size_t SZ_HT = (size_t)RH * M * 64 * 4;
constexpr size_t SZ_HB = (size_t)RH * M * 64 * 2;
constexpr size_t WS_R4 = WS_R5 + SZ_HT;
constexpr size_t WS_LW = WS_R4 + 6 * SZ_HB, WS_BC = WS_LW + SZ_HT;
constexpr size_t WS_ALG = WS_R4;
constexpr size_t WS_S5TA = WS_R4 + 3 * SZ_HB;
constexpr size_t WS_S5XA = WS_LW;
constexpr int NCH = M / 64;
constexpr size_t CK_PL = 0, CK_RP = 8192, CK_Q = 16384, CK_O0 = 24576, CK_H = 40960, CK_GC = 49152, CK_SIZE = 49408;
constexpr size_t WS_CK = WS_BC + (size_t)RH * M * 4;
constexpr size_t WS_GK = WS_CK + (size_t)NCH * RH * CK_SIZE;
constexpr size_t WS_ZS5 = WS_GK + (size_t)NCH * GH * 49408;
constexpr size_t WS_END = WS_ZS5 + (size_t)M * S5W * 2;
constexpr size_t WS_GQK = WS_R4 + SZ_HB;
constexpr size_t WS_GVP = WS_LW + 4 * MiB;
static_assert((size_t)NCH * GH * 16384 <= SZ_HB && 4 * MiB + (size_t)NCH * GH * 16384 <= SZ_HT && (size_t)48 * 16 * 128 * 4 * 2 <= 4 * MiB, "gla images");
constexpr size_t WS_SSQ = WS_GVP + (size_t)NCH * GH * 16384;
static_assert(WS_SSQ + (size_t)M * 32 * 4 <= WS_LW + SZ_HT, "ssq");
static_assert(WS_END <= 1474297856ull, "workspace map exceeds 4 x largest input");
static_assert((size_t)M * RW * 4 + (size_t)M * S5W * 2 <= SZ_R1 && (size_t)M * DFF * 2 <= SZ_R2, "overlays");
constexpr int CW_BAR = 4096;
constexpr size_t WS_PRM = WS_CTL + 131072;
static_assert(131072 + (size_t)DEPTH * RH * 576 * 4 <= CTL_ZERO_BYTES, "prm");

constexpr int LDS_BYTES = 155648;
constexpr int MISC_OFF = LDS_BYTES - 512;

struct Args { const float* in[38]; float* out; unsigned char* ws; int lo, hi; };

#define CAS __attribute__((address_space(4)))
struct Frame {
    LAS unsigned char* lds; int tid, lane, wave, G, bid;
    unsigned char* ws; float* out;
};
DI Frame make_frame(LAS unsigned char* lds, const CAS Args*& ap, const int wv) {
    Frame F; F.lds = lds;
    int tid = wv * 64 + lane_id_fresh(); asm volatile("" : "+v"(tid));
    int bid = blockIdx.x, G = gridDim.x; asm volatile("" : "+s"(bid), "+s"(G));
    const CAS Args* p = (const CAS Args*)__builtin_amdgcn_kernarg_segment_ptr(); asm volatile("" : "+s"(p));
    F.tid = tid; F.lane = tid & 63; F.wave = wv; F.G = G; F.bid = bid;
    F.ws = p->ws; F.out = p->out; ap = p; return F;
}
DI unsigned char* lw(const Frame& F, int l, size_t off) { return F.ws + WS_W + (size_t)l * LW_SIZE + off; }

DI void transpose_item(const float* W, int K, int N, bf16* WT, int ldt, int row_off, LAS float* scr, int item, int lane, const float* kscale = nullptr, int frag_nk = 0) {
    const int nblk = (N + 31) / 32, kb = item / nblk, nb = item % nblk, k0 = 64 * kb, n0 = 32 * nb;
    const int lr = lane >> 3, c4 = (lane & 7) * 4; const bool nok = (n0 + c4) < N;
    f32x4 v[8];
#pragma unroll
    for (int i = 0; i < 8; ++i) { const int row = lr + 8 * i; const bool ok = nok && (k0 + row) < K; v[i] = ok ? *(const GAS f32x4*)(W + (size_t)(k0 + row) * N + n0 + c4) : (f32x4){0.f, 0.f, 0.f, 0.f}; }
    if (kscale) { float ks[8];
#pragma unroll
        for (int i = 0; i < 8; ++i) ks[i] = kscale[(k0 + lr + 8 * i) < K ? (k0 + lr + 8 * i) : 0];
#pragma unroll
        for (int i = 0; i < 8; ++i) v[i] = v[i] * ks[i]; }
    __builtin_amdgcn_sched_barrier(0);
#pragma unroll
    for (int i = 0; i < 8; ++i) { LAS float* d = scr + (lr + 8 * i) * 33 + c4; d[0] = v[i][0]; d[1] = v[i][1]; d[2] = v[i][2]; d[3] = v[i][3]; }
    LDS_WAIT(); asm volatile("" ::: "memory");
    const int c = lane & 7;
    u32x4 o[4];
#pragma unroll
    for (int j = 0; j < 4; ++j) { const int n = (lane >> 3) + 8 * j; const LAS float* s = scr + (8 * c) * 33 + n;
        o[j].x = pk2(s[0 * 33], s[1 * 33]); o[j].y = pk2(s[2 * 33], s[3 * 33]); o[j].z = pk2(s[4 * 33], s[5 * 33]); o[j].w = pk2(s[6 * 33], s[7 * 33]); }
#pragma unroll
    for (int j = 0; j < 4; ++j) { const int n = (lane >> 3) + 8 * j; if ((n0 + n) < N && (k0 + 8 * c) < K) {
            if (frag_nk) { const int nn = n0 + n, kk = k0 + 8 * c; *(GAS u32x4*)(WT + ((size_t)((nn >> 4) * frag_nk + (kk >> 5)) * 64 + (nn & 15) + 16 * ((kk & 31) >> 3)) * 8) = o[j]; }
            else *(GAS u32x4*)(WT + (size_t)(row_off + n0 + n) * ldt + k0 + 8 * c) = o[j]; } }
    LDS_WAIT(); asm volatile("" ::: "memory");
}
DI int titems(int K, int N) { return ((K + 63) / 64) * ((N + 31) / 32); }
DI void p0_prologue(const Frame& F, const CAS Args& a) {
    LAS float* scr = (LAS float*)(F.lds + F.wave * 16384);
    const int gw = F.bid * 8 + F.wave, NGW = F.G * 8;
    constexpr int I_IN = (D / 64) * ((INCOLS + 31) / 32), I_VA = (D / 64) * 2, I_SQ = (D / 64) * (D / 32), I_1 = (D / 64) * (DFF / 32), I_2 = (DFF / 64) * (D / 32),
                  I_GLU = (S5W / 64) * (S5W / 32), I_WL = 2 * 20, I_AL = 2 * 20, I_GL = 4 * 20, I_VB = 1 * 20;
    constexpr int PER_LAYER = I_IN + I_VA + 2 * I_SQ + I_1 + I_2 + I_GLU + I_WL + I_AL + I_GL + I_VB;
    for (int it = gw; it < DEPTH * PER_LAYER; it += NGW) {
        const int l = it / PER_LAYER; int r = it - l * PER_LAYER;
        if (r < I_IN) { transpose_item(a.in[2] + (size_t)l * D * INCOLS, D, INCOLS, (bf16*)lw(F, l, LW_WIN), D, 0, scr, r, F.lane, a.in[1] + (size_t)l * D); continue; } r -= I_IN;
        if (r < I_VA) { if (l > 0) transpose_item(a.in[25] + (size_t)(l - 1) * D * 64, D, 64, (bf16*)lw(F, l, LW_WIN), D, ZC_VRES, scr, r, F.lane, a.in[1] + (size_t)l * D); continue; } r -= I_VA;
        if (r < I_SQ) { transpose_item(a.in[32] + (size_t)l * D * D, D, D, (bf16*)lw(F, l, LW_WUP), D, 0, scr, r, F.lane); continue; } r -= I_SQ;
        if (r < I_SQ) { transpose_item(a.in[33] + (size_t)l * D * D, D, D, (bf16*)lw(F, l, LW_WOUT), D, 0, scr, r, F.lane); continue; } r -= I_SQ;
        if (r < I_1) { transpose_item(a.in[35] + (size_t)l * D * DFF, D, DFF, (bf16*)lw(F, l, LW_W1), D, 0, scr, r, F.lane, a.in[34] + (size_t)l * D); continue; } r -= I_1;
        if (r < I_2) { transpose_item(a.in[36] + (size_t)l * DFF * D, DFF, D, (bf16*)lw(F, l, LW_W2), DFF, 0, scr, r, F.lane); continue; } r -= I_2;
        if (r < I_GLU) { transpose_item(a.in[12] + (size_t)l * S5W * S5W, S5W, S5W, (bf16*)lw(F, l, LW_GLU), S5W, 0, scr, r, F.lane); continue; } r -= I_GLU;
        if (r < I_WL) { transpose_item(a.in[15] + (size_t)l * 96 * RW, 96, RW, (bf16*)lw(F, l, LW_WL), 96, 0, scr, r, F.lane, nullptr, 3); continue; } r -= I_WL;
        if (r < I_AL) { transpose_item(a.in[17] + (size_t)l * 128 * RW, 128, RW, (bf16*)lw(F, l, LW_AL), 128, 0, scr, r, F.lane, nullptr, 4); continue; } r -= I_AL;
        if (r < I_GL) { transpose_item(a.in[19] + (size_t)l * 256 * RW, 256, RW, (bf16*)lw(F, l, LW_GL), 256, 0, scr, r, F.lane, nullptr, 8); continue; } r -= I_GL;
        if (l > 0) transpose_item(a.in[27] + (size_t)(l - 1) * 64 * RW, 64, RW, (bf16*)lw(F, l, LW_VB), 64, 0, scr, r, F.lane, nullptr, 2);
    }
}

template <bool IN_BF16, bool OUT_F32>
DI void rmsnorm_phase(const Frame& F, const void* xp, const float* g, void* outp) {
    const int gw = F.bid * 8 + F.wave, NGW = F.G * 8;
    f32x4 gv[8];
    if (IN_BF16) {
#pragma unroll
        for (int j = 0; j < 4; ++j) { gv[2 * j] = ((const GAS f32x4*)g)[2 * (64 * j + F.lane)]; gv[2 * j + 1] = ((const GAS f32x4*)g)[2 * (64 * j + F.lane) + 1]; }
    } else {
#pragma unroll
        for (int j = 0; j < 8; ++j) gv[j] = ((const GAS f32x4*)g)[64 * j + F.lane];
    }
    for (int m = gw; m < M; m += NGW) {
        f32x4 v[8]; float s = 0.f;
        if (IN_BF16) { const GAS u32x4* xr = (const GAS u32x4*)((const bf16*)xp + (size_t)m * XP) + F.lane;
            u32x4 r[4];
#pragma unroll
            for (int j = 0; j < 4; ++j) r[j] = xr[64 * j];
#pragma unroll
            for (int j = 0; j < 4; ++j) { v[2 * j] = (f32x4){bflo(r[j].x), bfhi(r[j].x), bflo(r[j].y), bfhi(r[j].y)}; v[2 * j + 1] = (f32x4){bflo(r[j].z), bfhi(r[j].z), bflo(r[j].w), bfhi(r[j].w)}; }
#pragma unroll
            for (int j = 0; j < 8; ++j) s += (v[j].x * v[j].x + v[j].y * v[j].y) + (v[j].z * v[j].z + v[j].w * v[j].w);
        } else { const GAS f32x4* xr = (const GAS f32x4*)((const float*)xp + (size_t)m * D) + F.lane;
#pragma unroll
            for (int j = 0; j < 8; ++j) { v[j] = xr[64 * j]; s += (v[j].x * v[j].x + v[j].y * v[j].y) + (v[j].z * v[j].z + v[j].w * v[j].w); } }
        const float rstd = 1.f / sqrtf(wave_sum(s) * (1.f / D) + NORM_EPS);
        if (OUT_F32) {
            if (IN_BF16) { GAS f32x4* o = (GAS f32x4*)((float*)outp + (size_t)m * D);
#pragma unroll
                for (int j = 0; j < 4; ++j) { o[2 * (64 * j + F.lane)] = v[2 * j] * rstd * gv[2 * j]; o[2 * (64 * j + F.lane) + 1] = v[2 * j + 1] * rstd * gv[2 * j + 1]; }
            } else { GAS f32x4* o = (GAS f32x4*)((float*)outp + (size_t)m * D) + F.lane;
#pragma unroll
                for (int j = 0; j < 8; ++j) o[64 * j] = v[j] * rstd * gv[j]; }
        } else {
            if (IN_BF16) { GAS u32x4* o = (GAS u32x4*)((bf16*)outp + (size_t)m * D) + F.lane;
#pragma unroll
                for (int j = 0; j < 4; ++j) { const f32x4 y0 = v[2 * j] * rstd * gv[2 * j], y1 = v[2 * j + 1] * rstd * gv[2 * j + 1]; u32x4 w; w.x = pk2(y0.x, y0.y); w.y = pk2(y0.z, y0.w); w.z = pk2(y1.x, y1.y); w.w = pk2(y1.z, y1.w); o[64 * j] = w; }
            } else { GAS u32x2* o = (GAS u32x2*)((bf16*)outp + (size_t)m * D) + F.lane;
#pragma unroll
                for (int j = 0; j < 8; ++j) { const f32x4 y = v[j] * rstd * gv[j]; u32x2 w; w.x = pk2(y.x, y.y); w.y = pk2(y.z, y.w); o[64 * j] = w; } }
        }
    }
}

constexpr int AL_PITCH = 552;
constexpr int PO_PITCH = 68;
struct RwPrep { bf16 *R, *K2, *V, *KK, *BB, *G; float *LW, *BC, *VF; };
DI RwPrep rwprep_ptrs(const Frame& F) { RwPrep p; bf16* b = (bf16*)(F.ws + WS_R4); const size_t n = (size_t)RH * M * 64;
    p.R = b; p.K2 = b + n; p.V = b + 2 * n; p.KK = b + 3 * n; p.BB = b + 4 * n; p.G = b + 5 * n; p.LW = (float*)(F.ws + WS_LW); p.BC = (float*)(F.ws + WS_BC); p.VF = (float*)(F.ws + WS_R5); return p; }
#define SB() __builtin_amdgcn_sched_barrier(0)
#ifndef REP3_MASK
#define REP3_MASK 0
#endif
#define REP3(k) ((REP3_MASK >> (k)) & 1)
template <int K, int KOFF, int L>
DI void lora_tile(const LAS bf16* AL, const bf16* Bt, LAS float* PO, int h, int mt, int np, int fr, int fq) {
    constexpr int NK = K / 32;
    bf16x8 bv[2][NK], av[NK];
#pragma unroll
    for (int ks = 0; ks < NK; ++ks) { av[ks] = *(const LAS bf16x8*)(AL + (16 * mt + fr) * AL_PITCH + KOFF + 32 * ks + 8 * fq);
#pragma unroll
        for (int nn = 0; nn < 2; ++nn) bv[nn][ks] = *(const GAS bf16x8*)(Bt + (size_t)(h * 64 + 16 * (2 * np + nn) + fr) * K + 8 * fq + 32 * ks); }
    SB();
#pragma unroll
    for (int nn = 0; nn < 2; ++nn) { const int nt = 2 * np + nn; f32x4 acc = {0.f, 0.f, 0.f, 0.f};
#pragma unroll
        for (int ks = 0; ks < NK; ++ks) acc = __builtin_amdgcn_mfma_f32_16x16x32_bf16(av[ks], bv[nn][ks], acc, 0, 0, 0);
#pragma unroll
        for (int i = 0; i < 4; ++i) PO[(L * 64 + 16 * mt + 4 * fq + i) * PO_PITCH + 16 * nt + fr] = acc[i]; }
    SB();
}
DI void lora2_tile(const LAS bf16* AL, const bf16* WLt, const bf16* VBt, LAS float* PO, int h, int mt, int np, int fr, int fq, bool has_v) {
    bf16x8 b0[2][3], a0[3], b3[2][2], a3[2];
    const LAS bf16* arow = AL + (16 * mt + fr) * AL_PITCH + 8 * fq;
#pragma unroll
    for (int ks = 0; ks < 3; ++ks) { a0[ks] = *(const LAS bf16x8*)(arow + 32 * ks);
#pragma unroll
        for (int nn = 0; nn < 2; ++nn) b0[nn][ks] = *(const GAS bf16x8*)(WLt + (size_t)(h * 64 + 16 * (2 * np + nn) + fr) * 96 + 8 * fq + 32 * ks); }
#pragma unroll
    for (int ks = 0; ks < 2; ++ks) { a3[ks] = *(const LAS bf16x8*)(arow + 480 + 32 * ks);
#pragma unroll
        for (int nn = 0; nn < 2; ++nn) b3[nn][ks] = has_v ? *(const GAS bf16x8*)(VBt + (size_t)(h * 64 + 16 * (2 * np + nn) + fr) * 64 + 8 * fq + 32 * ks) : (bf16x8){0, 0, 0, 0, 0, 0, 0, 0}; }
    SB();
#pragma unroll
    for (int nn = 0; nn < 2; ++nn) { const int nt = 2 * np + nn; f32x4 c0 = {0.f, 0.f, 0.f, 0.f}, c3 = c0;
#pragma unroll
        for (int ks = 0; ks < 3; ++ks) c0 = __builtin_amdgcn_mfma_f32_16x16x32_bf16(a0[ks], b0[nn][ks], c0, 0, 0, 0);
#pragma unroll
        for (int ks = 0; ks < 2; ++ks) c3 = __builtin_amdgcn_mfma_f32_16x16x32_bf16(a3[ks], b3[nn][ks], c3, 0, 0, 0);
#pragma unroll
        for (int i = 0; i < 4; ++i) { PO[(0 * 64 + 16 * mt + 4 * fq + i) * PO_PITCH + 16 * nt + fr] = c0[i]; PO[(3 * 64 + 16 * mt + 4 * fq + i) * PO_PITCH + 16 * nt + fr] = c3[i]; } }
    SB();
}
DI void rwkv_prep_phase(const Frame& F, const CAS Args& a, int l) {
    const bf16* Z = (const bf16*)(F.ws + WS_R2);
    LAS bf16* AL = (LAS bf16*)F.lds;
    LAS float* PO = (LAS float*)(F.lds + 64 * AL_PITCH * 2);
    const float* mu = a.in[14] + (size_t)l * RWCOLS;
    const float* vmu = a.in[26] + (size_t)(l > 0 ? l - 1 : 0) * 64;
    const RwPrep P = rwprep_ptrs(F);
    const bf16* WLt = (const bf16*)lw(F, l, LW_WL); const bf16* ALt = (const bf16*)lw(F, l, LW_AL); const bf16* GLt = (const bf16*)lw(F, l, LW_GL); const bf16* VBt = (const bf16*)lw(F, l, LW_VB);
    for (int c = F.bid; c < M / 64; c += F.G) {
        for (int rep_ = 0; rep_ < 1 + REP3(0); ++rep_) {
        if (F.tid < 476) { const int cc = F.tid % 68, r0 = F.tid / 68, j = cc * 8;
            const int zc = (j < 480) ? ZC_WIN + j : ZC_VRES + (j - 480); const float* mp = (j < 480) ? mu + (ZC_WIN - ZC_R) + j : vmu + (j - 480);
            const int kind = (j < 96) ? 0 : ((j >= 224 && j < 480) ? 2 : ((j >= 480 && l == 0) ? 3 : 1));
            const f32x4 m0 = *(const GAS f32x4*)mp, m1 = *(const GAS f32x4*)(mp + 4);
            for (int ib = 0; ib < 2; ++ib) {
                u32x4 cu[5], pr[5];
#pragma unroll
                for (int u = 0; u < 5; ++u) { const int r = r0 + 7 * (5 * ib + u), rr = r < 64 ? r : 63, gr = 64 * c + rr;
                    cu[u] = *(const GAS u32x4*)(Z + (size_t)gr * ZP + zc); pr[u] = *(const GAS u32x4*)(Z + (size_t)(gr > 0 ? gr - 1 : 0) * ZP + zc); }
                SB();
#pragma unroll
                for (int u = 0; u < 5; ++u) { const int r = r0 + 7 * (5 * ib + u); if (r < 64) { const int gr = 64 * c + r;
                    float cur[8], prv[8], o[8]; unpack8(cu[u], cur); unpack8(pr[u], prv);
#pragma unroll
                    for (int e = 0; e < 8; ++e) { const float pv = gr > 0 ? prv[e] : 0.f; const float mm = e < 4 ? m0[e] : m1[e - 4]; o[e] = cur[e] + (pv - cur[e]) * mm; }
                    if (kind == 0) {
#pragma unroll
                        for (int e = 0; e < 8; ++e) o[e] = 1.f - 2.f * __builtin_amdgcn_rcpf(__expf(2.f * o[e]) + 1.f);
                    } else if (kind == 2) {
#pragma unroll
                        for (int e = 0; e < 8; ++e) o[e] = sigmoidf_(o[e]);
                    } else if (kind == 3) {
#pragma unroll
                        for (int e = 0; e < 8; ++e) o[e] = 0.f; }
                    *(LAS u32x4*)(AL + r * AL_PITCH + j) = pack8(o); } }
                SB();
            } }
        }
        __syncthreads();
        for (int h = 0; h < RH; ++h) {
            const int t = F.tid >> 3, cg = F.tid & 7, gr = 64 * c + t, ch = h * 64 + 8 * cg;
            const size_t po = ((size_t)h * M + gr) * 64 + 8 * cg;
            u32x4 zc_[3], zp_[3]; f32x4 zm0[3], zm1[3];
#pragma unroll
            for (int which = 0; which < 3; ++which) { const int zc = (which == 0 ? ZC_R : (which == 1 ? ZC_K : ZC_V)) + ch;
                zc_[which] = *(const GAS u32x4*)(Z + (size_t)gr * ZP + zc); zp_[which] = *(const GAS u32x4*)(Z + (size_t)(gr > 0 ? gr - 1 : 0) * ZP + zc);
                zm0[which] = *(const GAS f32x4*)(mu + (zc - ZC_R)); zm1[which] = *(const GAS f32x4*)(mu + (zc - ZC_R) + 4); }
            SB();
            for (int rep_ = 0; rep_ < 1 + REP3(1); ++rep_)
            { const int mt = F.wave & 3, np = F.wave >> 2, fr = F.lane & 15, fq = F.lane >> 4;
              lora2_tile(AL, WLt, VBt, PO, h, mt, np, fr, fq, l > 0);
              lora_tile<128, 96, 1>(AL, ALt, PO, h, mt, np, fr, fq);
              lora_tile<256, 224, 2>(AL, GLt, PO, h, mt, np, fr, fq);
            }
            f32x4 pw0[2], pa0[2], pkk[2], pka[2], prk[2], pvb[2], pvf[2];
#pragma unroll
            for (int q = 0; q < 2; ++q) { pw0[q] = *(const GAS f32x4*)(a.in[16] + (size_t)l * RW + ch + 4 * q); pa0[q] = *(const GAS f32x4*)(a.in[18] + (size_t)l * RW + ch + 4 * q); pkk[q] = *(const GAS f32x4*)(a.in[20] + (size_t)l * RW + ch + 4 * q);
                pka[q] = *(const GAS f32x4*)(a.in[21] + (size_t)l * RW + ch + 4 * q); prk[q] = *(const GAS f32x4*)(a.in[22] + (size_t)l * RW + ch + 4 * q);
                pvb[q] = (l > 0) ? *(const GAS f32x4*)(a.in[28] + (size_t)(l - 1) * RW + ch + 4 * q) : (f32x4){0.f, 0.f, 0.f, 0.f}; pvf[q] = (l > 0) ? *(const GAS f32x4*)(P.VF + po + 4 * q) : (f32x4){0.f, 0.f, 0.f, 0.f}; }
            SB();
            __syncthreads();
            for (int rep_ = 0; rep_ < 1 + REP3(2); ++rep_)
            {
              float r[8], k[8], v[8];
#pragma unroll
              for (int which = 0; which < 3; ++which) { float cu[8], pr[8]; unpack8(zc_[which], cu); unpack8(zp_[which], pr);
#pragma unroll
                  for (int e = 0; e < 8; ++e) { const float pv = gr > 0 ? pr[e] : 0.f; const float mm = e < 4 ? zm0[which][e] : zm1[which][e - 4]; const float zs = cu[e] + (pv - cu[e]) * mm;
                      if (which == 0) r[e] = zs; else if (which == 1) k[e] = zs; else v[e] = zs; } }
              float wpre[8], apre[8], gpre[8], vpre[8];
#pragma unroll
              for (int q = 0; q < 2; ++q) { const f32x4 x0 = *(const LAS f32x4*)(PO + (0 * 64 + t) * PO_PITCH + 8 * cg + 4 * q), x1 = *(const LAS f32x4*)(PO + (1 * 64 + t) * PO_PITCH + 8 * cg + 4 * q), x2 = *(const LAS f32x4*)(PO + (2 * 64 + t) * PO_PITCH + 8 * cg + 4 * q);
                  const f32x4 x3 = (l > 0) ? *(const LAS f32x4*)(PO + (3 * 64 + t) * PO_PITCH + 8 * cg + 4 * q) : (f32x4){0.f, 0.f, 0.f, 0.f};
#pragma unroll
                  for (int e = 0; e < 4; ++e) { wpre[4 * q + e] = x0[e]; apre[4 * q + e] = x1[e]; gpre[4 * q + e] = x2[e]; vpre[4 * q + e] = x3[e]; } }
              float lwv[8], av[8], kk[8], k2[8], bb[8]; float ss = 0.f, bc = 0.f;
              if (l > 0) {
#pragma unroll
                  for (int e = 0; e < 8; ++e) { const float vg = sigmoidf_(pvb[e >> 2][e & 3] + vpre[e]); const float vf = pvf[e >> 2][e & 3]; v[e] = v[e] + (vf - v[e]) * vg; } }
#pragma unroll
              for (int e = 0; e < 8; ++e) {
                  const float w = -softplusf_(-(pw0[e >> 2][e & 3] + wpre[e])) - 0.5f; lwv[e] = -__expf(w);
                  av[e] = sigmoidf_(pa0[e >> 2][e & 3] + apre[e]);
                  kk[e] = k[e] * pkk[e >> 2][e & 3]; ss += kk[e] * kk[e];
                  k2[e] = k[e] * (1.f + (av[e] - 1.f) * pka[e >> 2][e & 3]); bc += r[e] * k2[e] * prk[e >> 2][e & 3]; }
              ss = sum8(ss); bc = sum8(bc); const float rn = 1.f / sqrtf(fmaxf(ss, 1e-24f));
#pragma unroll
              for (int e = 0; e < 8; ++e) { kk[e] *= rn; bb[e] = kk[e] * av[e]; }
#define ST8(dst, arr) do { *(GAS f32x4*)((dst) + po) = (f32x4){arr[0], arr[1], arr[2], arr[3]}; *(GAS f32x4*)((dst) + po + 4) = (f32x4){arr[4], arr[5], arr[6], arr[7]}; } while (0)
#define ST8B(dst, arr) do { *(GAS u32x4*)((dst) + po) = pack8(arr); } while (0)
              ST8B(P.R, r); ST8(P.LW, lwv); ST8B(P.K2, k2); ST8B(P.V, v); ST8B(P.KK, kk); ST8B(P.BB, bb); ST8B(P.G, gpre);
              if (cg == 0) P.BC[(size_t)h * M + gr] = bc;
              if (l == 0) ST8(P.VF, v);
#undef ST8B
#undef ST8
            }
            __syncthreads();
        }
    }
}
DI float gelu_tanh(float y) { const float u = 0.7978845608028654f * (y + 0.044715f * y * y * y); const float e = __expf(2.f * u); const float th = 1.f - 2.f * __builtin_amdgcn_rcpf(e + 1.f); return 0.5f * y * (1.f + th); }

typedef short s16x4 __attribute__((ext_vector_type(4)));
DI bf16x8 ld_pi(const LAS bf16* row, int ks, int kg) {
    const u32x2 a = *(const LAS u32x2*)(row + 32 * ks + 4 * kg), b = *(const LAS u32x2*)(row + 32 * ks + 16 + 4 * kg);
    u32x4 v; v.x = a.x; v.y = a.y; v.z = b.x; v.w = b.y; return __builtin_bit_cast(bf16x8, v);
}
DI bf16x8 pack_pi(const f32x4 lo, const f32x4 hi) { u32x4 v; v.x = pk2(lo[0], lo[1]); v.y = pk2(lo[2], lo[3]); v.z = pk2(hi[0], hi[1]); v.w = pk2(hi[2], hi[3]); return __builtin_bit_cast(bf16x8, v); }
DI unsigned char* ck_ptr(const Frame& F, int c, int h) { return F.ws + WS_CK + ((size_t)c * RH + h) * CK_SIZE; }

constexpr int RPP = 72;
constexpr int RP_AT = 0, RP_BT = 9216, RP_KT = 18432, RP_RT = 27648, RP_BDT = 36864, RP_KDT = 46080, RP_VT = 55296, RP_LAK = 64512, RP_MRB = 73728, RP_MRK = 82944;
constexpr int RP_L = 92160, RP_CUM = RP_L + 17408, RP_TBB = RP_CUM + 17408, RP_SEG = RP_TBB + 5120, RP_END = RP_SEG + 2048;
static_assert(RP_END + 9 * 64 * 4 <= MISC_OFF, "rwkv_pre LDS");

DI void rwkv_chunk_tail(const Frame& F, unsigned char* const ck, LAS bf16* const At, LAS bf16* const Bt, LAS bf16* const Kt, LAS bf16* const Rt, LAS bf16* const BdT, LAS bf16* const KdT, LAS bf16* const VT,
                        LAS bf16* const Lak, LAS bf16* const Mrb, LAS bf16* const Mrk, LAS float* const Lm, LAS float* const Tbb) {
    const int lane = F.lane, w = F.wave, n = lane & 15, g4 = lane >> 4;
    {
        { const int p = w >> 1;
          const LAS bf16* Xs = (p & 1) ? Kt : Bt; const LAS bf16* Xt = (p & 2) ? Rt : At;
          bf16x8 bfrag[2][2], afrag[4][2];
#pragma unroll
          for (int nn = 0; nn < 2; ++nn)
#pragma unroll
              for (int ks = 0; ks < 2; ++ks) bfrag[nn][ks] = *(const LAS bf16x8*)(Xt + (16 * (2 * (w & 1) + nn) + n) * RPP + 32 * ks + 8 * g4);
#pragma unroll
          for (int ms = 0; ms < 4; ++ms)
#pragma unroll
              for (int ks = 0; ks < 2; ++ks) afrag[ms][ks] = *(const LAS bf16x8*)(Xs + (16 * ms + n) * RPP + 32 * ks + 8 * g4);
          SB();
#pragma unroll
          for (int nn = 0; nn < 2; ++nn) { const int nt = 2 * (w & 1) + nn; const int t = 16 * nt + n;
#pragma unroll
              for (int ms = 0; ms < 4; ++ms) {
                  if (ms <= nt) { f32x4 acc = {0.f, 0.f, 0.f, 0.f};
#pragma unroll
                      for (int ks = 0; ks < 2; ++ks) acc = __builtin_amdgcn_mfma_f32_16x16x32_bf16(afrag[ms][ks], bfrag[nn][ks], acc, 0, 0, 0);
#pragma unroll
                      for (int r = 0; r < 4; ++r) { const int s = 16 * ms + 4 * g4 + r; const bool keep = (p & 2) ? (s <= t) : (s < t); acc[r] = keep ? acc[r] : 0.f; }
                      if (p == 0) *(LAS f32x4*)(Lm + t * 68 + 16 * ms + 4 * g4) = acc;
                      else { LAS bf16* dst = (p == 1) ? Lak : (p == 2 ? Mrb : Mrk); u32x2 o; o.x = pk2(acc[0], acc[1]); o.y = pk2(acc[2], acc[3]); *(LAS u32x2*)(dst + t * RPP + 16 * ms + 4 * g4) = o; } } } } }
        __syncthreads();
        if (F.tid < 64) { const int b = F.tid >> 4, cc = F.tid & 15; float x[16];
#pragma unroll
            for (int t0 = 0; t0 < 16; t0 += 4) { f32x4 lr[4][4];
#pragma unroll
                for (int tt = 0; tt < 4; ++tt)
#pragma unroll
                    for (int q = 0; q < 4; ++q) if (4 * q < t0 + tt) lr[tt][q] = *(const LAS f32x4*)(Lm + (16 * b + t0 + tt) * 68 + 16 * b + 4 * q);
                SB();
#pragma unroll
                for (int tt = 0; tt < 4; ++tt) { const int t = t0 + tt; float s = (t == cc) ? 1.f : 0.f;
#pragma unroll
                    for (int s2 = 0; s2 < t; ++s2) s += lr[tt][s2 >> 2][s2 & 3] * x[s2];
                    x[t] = s; Tbb[(b * 16 + t) * 20 + cc] = s; }
                SB(); } }
        __syncthreads();
        { f32x4 rhs[4];
          if (w < 4) {
#pragma unroll
              for (int b = 0; b < 4; ++b)
#pragma unroll
                  for (int r = 0; r < 4; ++r) rhs[b][r] = bf2f(At[(16 * b + 4 * g4 + r) * RPP + 16 * w + n]);
          } else { const int vs = w - 4;
              bf16x8 vf[2];
#pragma unroll
              for (int ks = 0; ks < 2; ++ks) vf[ks] = *(const LAS bf16x8*)(VT + (16 * vs + n) * RPP + 32 * ks + 8 * g4);
#pragma unroll
              for (int b = 0; b < 4; ++b) { f32x4 acc = {0.f, 0.f, 0.f, 0.f};
#pragma unroll
                  for (int ks = 0; ks < 2; ++ks) { const bf16x8 af = *(const LAS bf16x8*)(Lak + (16 * b + n) * RPP + 32 * ks + 8 * g4); acc = __builtin_amdgcn_mfma_f32_16x16x32_bf16(af, vf[ks], acc, 0, 0, 0); }
                  rhs[b] = acc; } }
          SB();
          f32x4 X[4];
#pragma unroll
          for (int b = 0; b < 4; ++b) { f32x4 lf[3], tf;
              tf = *(const LAS f32x4*)(Tbb + (b * 16 + n) * 20 + 4 * g4);
#pragma unroll
              for (int b2 = 0; b2 < 3; ++b2) if (b2 < b) lf[b2] = *(const LAS f32x4*)(Lm + (16 * b + n) * 68 + 16 * b2 + 4 * g4);
              SB();
              f32x4 acc = rhs[b];
#pragma unroll
              for (int b2 = 0; b2 < b; ++b2) {
#pragma unroll
                  for (int q = 0; q < 4; ++q) acc = __builtin_amdgcn_mfma_f32_16x16x4f32(lf[b2][q], X[b2][q], acc, 0, 0, 0); }
              f32x4 o = {0.f, 0.f, 0.f, 0.f};
#pragma unroll
              for (int q = 0; q < 4; ++q) o = __builtin_amdgcn_mfma_f32_16x16x4f32(tf[q], acc[q], o, 0, 0, 0);
              X[b] = o;
              SB(); }
          bf16x8 xf[2]; xf[0] = pack_pi(X[0], X[1]); xf[1] = pack_pi(X[2], X[3]);
          SB();
          if (w < 4) { const int ws_ = w;
#pragma unroll
              for (int n0 = 0; n0 < 4; n0 += 2) { bf16x8 fb[2][2], fm[2][2]; u32x2 rr[2];
#pragma unroll
                  for (int nn = 0; nn < 2; ++nn) { const int nt = n0 + nn; rr[nn] = *(const LAS u32x2*)(Rt + (16 * nt + n) * RPP + 16 * ws_ + 4 * g4);
#pragma unroll
                      for (int ks = 0; ks < 2; ++ks) { fb[nn][ks] = ld_pi(BdT + (16 * nt + n) * RPP, ks, g4); fm[nn][ks] = ld_pi(Mrb + (16 * nt + n) * RPP, ks, g4); } }
                  SB();
#pragma unroll
                  for (int nn = 0; nn < 2; ++nn) { const int nt = n0 + nn;
                      f32x4 acc = {0.f, 0.f, 0.f, 0.f}, ac2 = {0.f, 0.f, 0.f, 0.f};
#pragma unroll
                      for (int ks = 0; ks < 2; ++ks) { acc = __builtin_amdgcn_mfma_f32_16x16x32_bf16(xf[ks], fb[nn][ks], acc, 0, 0, 0); ac2 = __builtin_amdgcn_mfma_f32_16x16x32_bf16(xf[ks], fm[nn][ks], ac2, 0, 0, 0); }
                      u32x2 o; o.x = pk2(acc[0], acc[1]); o.y = pk2(acc[2], acc[3]);
                      *(GAS u32x2*)(ck + CK_PL + ((size_t)((nt * 2 + (ws_ >> 1)) * 64 + lane)) * 16 + (ws_ & 1) * 8) = o;
                      ac2[0] += bflo(rr[nn].x); ac2[1] += bfhi(rr[nn].x); ac2[2] += bflo(rr[nn].y); ac2[3] += bfhi(rr[nn].y);
                      u32x2 o2; o2.x = pk2(ac2[0], ac2[1]); o2.y = pk2(ac2[2], ac2[3]);
                      *(GAS u32x2*)(ck + CK_RP + ((size_t)((nt * 2 + (ws_ >> 1)) * 64 + lane)) * 16 + (ws_ & 1) * 8) = o2; }
                  SB(); }
          } else { const int vs = w - 4;
              bf16x8 vf[2];
#pragma unroll
              for (int ks = 0; ks < 2; ++ks) vf[ks] = *(const LAS bf16x8*)(VT + (16 * vs + n) * RPP + 32 * ks + 8 * g4);
#pragma unroll
              for (int mt = 0; mt < 4; ++mt) { bf16x8 fb[2], fm[2], fk[2], fr[2];
#pragma unroll
                  for (int ks = 0; ks < 2; ++ks) { fb[ks] = ld_pi(BdT + (16 * mt + n) * RPP, ks, g4); fm[ks] = ld_pi(Mrb + (16 * mt + n) * RPP, ks, g4);
                      fk[ks] = *(const LAS bf16x8*)(KdT + (16 * mt + n) * RPP + 32 * ks + 8 * g4); fr[ks] = *(const LAS bf16x8*)(Mrk + (16 * mt + n) * RPP + 32 * ks + 8 * g4); }
                  SB();
                  f32x4 q = {0.f, 0.f, 0.f, 0.f}, o0 = {0.f, 0.f, 0.f, 0.f};
#pragma unroll
                  for (int ks = 0; ks < 2; ++ks) { q = __builtin_amdgcn_mfma_f32_16x16x32_bf16(fb[ks], xf[ks], q, 0, 0, 0); o0 = __builtin_amdgcn_mfma_f32_16x16x32_bf16(xf[ks], fm[ks], o0, 0, 0, 0);
                      q = __builtin_amdgcn_mfma_f32_16x16x32_bf16(fk[ks], vf[ks], q, 0, 0, 0); o0 = __builtin_amdgcn_mfma_f32_16x16x32_bf16(vf[ks], fr[ks], o0, 0, 0, 0); }
                  u32x2 qo; qo.x = pk2(q[0], q[1]); qo.y = pk2(q[2], q[3]);
                  *(GAS u32x2*)(ck + CK_Q + ((size_t)((vs * 4 + mt) * 64 + lane)) * 8) = qo;
                  *(GAS f32x4*)(ck + CK_O0 + ((size_t)((vs * 4 + mt) * 64 + lane)) * 16) = o0;
                  SB(); } } }
        __syncthreads();
    }
}

DI void x0_phase(const Frame& F, const float* x, bf16* xb, float* ssq) {
    const int gw = F.bid * 8 + F.wave, NGW = F.G * 8;
    for (int m = gw; m < M; m += NGW) {
        const GAS f32x4* xr = (const GAS f32x4*)(x + (size_t)m * D) + F.lane;
        f32x4 v[8]; float s = 0.f;
#pragma unroll
        for (int j = 0; j < 8; ++j) { v[j] = xr[64 * j]; s += (v[j].x * v[j].x + v[j].y * v[j].y) + (v[j].z * v[j].z + v[j].w * v[j].w); }
        s = wave_sum(s);
        GAS u32x2* o = (GAS u32x2*)(xb + (size_t)m * XP) + F.lane;
#pragma unroll
        for (int j = 0; j < 8; ++j) { u32x2 w; w.x = pk2(v[j].x, v[j].y); w.y = pk2(v[j].z, v[j].w); o[64 * j] = w; }
        if (F.lane < 32) ssq[(size_t)m * 32 + F.lane] = (F.lane == 0) ? s : 0.f;
    }
}
constexpr int RS_OFF = STAGE_BYTES;
static_assert(RS_OFF + 2048 * 4 <= MISC_OFF, "rstd table");
DI const LAS float* rstd_table(const Frame& F) {
    LAS float* const tab = (LAS float*)(F.lds + RS_OFF);
    const int base = (F.bid & 7) * 2048;
    const float* P = (const float*)(F.ws + WS_SSQ) + (size_t)base * 32;
    for (int r = F.tid; r < 2048; r += 512) { f32x4 p[8];
#pragma unroll
        for (int q = 0; q < 8; ++q) p[q] = ((const GAS f32x4*)(P + (size_t)r * 32))[q];
        SB();
        f32x4 t = (p[0] + p[1]) + (p[2] + p[3]) + ((p[4] + p[5]) + (p[6] + p[7]));
        tab[r] = 1.f / sqrtf(((t[0] + t[1]) + (t[2] + t[3])) * (1.f / D) + NORM_EPS);
        SB(); }
    __syncthreads();
    return tab - base;
}
constexpr size_t ALG_BYTES = (size_t)64 * AL_PITCH * 2;
template <int K, int KOFF, int L>
DI void lora_tile_g(const bf16* ALG, const bf16* Bt, LAS float* PO, int h, int mt, int np, int fr, int fq) {
    constexpr int NK = K / 32;
    bf16x8 bv[2][NK], av[NK];
    unsigned lo = (unsigned)(fr + 16 * fq) * 16u; asm volatile("" : "+v"(lo));
    const unsigned char* const ab = (const unsigned char*)ALG + (size_t)(mt * 17 + KOFF / 32) * 1024;
    const unsigned char* const bb = (const unsigned char*)Bt + (size_t)((4 * h + 2 * np) * NK) * 1024;
#pragma unroll
    for (int ks = 0; ks < NK; ++ks) { av[ks] = *(const GAS bf16x8*)(ab + ks * 1024 + lo);
#pragma unroll
        for (int nn = 0; nn < 2; ++nn) bv[nn][ks] = *(const GAS bf16x8*)(bb + (nn * NK + ks) * 1024 + lo); }
    SB();
#pragma unroll
    for (int nn = 0; nn < 2; ++nn) { const int nt = 2 * np + nn; f32x4 acc = {0.f, 0.f, 0.f, 0.f};
#pragma unroll
        for (int ks = 0; ks < NK; ++ks) acc = __builtin_amdgcn_mfma_f32_16x16x32_bf16(av[ks], bv[nn][ks], acc, 0, 0, 0);
#pragma unroll
        for (int i = 0; i < 4; ++i) PO[(L * 64 + 16 * mt + 4 * fq + i) * PO_PITCH + 16 * nt + fr] = acc[i]; }
    SB();
}
static_assert(3 * 64 * PO_PITCH * 4 <= RP_LAK && RP_END + 64 * PO_PITCH * 4 + 9 * 64 * 4 <= MISC_OFF, "the LoRA output tiles overlay only images that are rewritten for every item");

DI void rwkv_fused_phase(const Frame& F, const CAS Args& a, int l) {
    const bf16* Z = (const bf16*)(F.ws + WS_R2);
    const RwPrep P = rwprep_ptrs(F);
    LAS unsigned char* const lds = F.lds;
    LAS float* const PO = (LAS float*)lds;
    LAS float* const PO3 = (LAS float*)(lds + RP_END) - 3 * 64 * PO_PITCH;
    LAS bf16* const At = (LAS bf16*)(lds + RP_AT); LAS bf16* const Bt = (LAS bf16*)(lds + RP_BT); LAS bf16* const Kt = (LAS bf16*)(lds + RP_KT); LAS bf16* const Rt = (LAS bf16*)(lds + RP_RT);
    LAS bf16* const BdT = (LAS bf16*)(lds + RP_BDT); LAS bf16* const KdT = (LAS bf16*)(lds + RP_KDT); LAS bf16* const VT = (LAS bf16*)(lds + RP_VT);
    LAS bf16* const Lak = (LAS bf16*)(lds + RP_LAK); LAS bf16* const Mrb = (LAS bf16*)(lds + RP_MRB); LAS bf16* const Mrk = (LAS bf16*)(lds + RP_MRK);
    LAS float* const Lm = (LAS float*)(lds + RP_L); LAS float* const cum = (LAS float*)(lds + RP_CUM); LAS float* const Tbb = (LAS float*)(lds + RP_TBB); LAS float* const seg = (LAS float*)(lds + RP_SEG);
    const float* mu = a.in[14] + (size_t)l * RWCOLS;
    const float* vmu = a.in[26] + (size_t)__builtin_amdgcn_readfirstlane(l > 0 ? l - 1 : 0) * 64;
    const bf16* WLt = (const bf16*)lw(F, l, LW_WL); const bf16* ALt = (const bf16*)lw(F, l, LW_AL); const bf16* GLt = (const bf16*)lw(F, l, LW_GL); const bf16* VBt = (const bf16*)lw(F, l, LW_VB);
    bf16* const ALG = (bf16*)(F.ws + WS_ALG + (size_t)F.bid * ALG_BYTES);
    const int lane = F.lane, w = F.wave, n = lane & 15, g4 = lane >> 4;
    { unsigned zz = 0u; asm volatile("" : "+v"(zz));
      for (int q = F.tid; q < (RP_CUM - RP_LAK) / 16; q += 512) *(LAS u32x4*)(lds + RP_LAK + q * 16) = (u32x4){zz, zz, zz, zz}; }
    __syncthreads();
    for (int c = F.bid; c < NCH; c += F.G) {
        if (F.tid < 476) { int cc = F.tid % 68; asm volatile("" : "+v"(cc)); const int j = cc * 8; int r0 = F.tid / 68;
            const int zc = (j < 480) ? ZC_WIN + j : ZC_VRES + (j - 480); const float* mp = (j < 480) ? mu + (ZC_WIN - ZC_R) + j : vmu + (j - 480);
            const int kind = (j < 96) ? 0 : ((j >= 224 && j < 480) ? 2 : ((j >= 480 && l == 0) ? 3 : 1));
            const f32x4 m0 = *(const GAS f32x4*)mp, m1 = *(const GAS f32x4*)(mp + 4);
            unsigned jfo = (unsigned)((j >> 5) * 1024 + ((j & 31) >> 3) * 256); asm volatile("" : "+v"(jfo));
#define SA_LOAD(cu, pr, ib) do { _Pragma("unroll") for (int u = 0; u < 3; ++u) { const int r = r0 + 7 * (3 * (ib) + u), rr = r < 64 ? r : 63, gr = 64 * c + rr; \
                    cu[u] = *(const GAS u32x4*)(Z + (size_t)gr * ZP + zc); pr[u] = *(const GAS u32x4*)(Z + (size_t)(gr > 0 ? gr - 1 : 0) * ZP + zc); } } while (0)
#define SA_COMP(cu, pr, ib) do { _Pragma("unroll") for (int u = 0; u < 3; ++u) { const int r = r0 + 7 * (3 * (ib) + u); if (r < 64) { const int gr = 64 * c + r; \
                    float cur[8], prv[8], o[8]; unpack8(cu[u], cur); unpack8(pr[u], prv); \
                    _Pragma("unroll") for (int e = 0; e < 8; ++e) { const float pv = gr > 0 ? prv[e] : 0.f; const float mm = e < 4 ? m0[e] : m1[e - 4]; o[e] = cur[e] + (pv - cur[e]) * mm; } \
                    if (kind == 0) { _Pragma("unroll") for (int e = 0; e < 8; ++e) o[e] = 1.f - 2.f * __builtin_amdgcn_rcpf(__expf(2.f * o[e]) + 1.f); } \
                    else if (kind == 2) { _Pragma("unroll") for (int e = 0; e < 8; ++e) o[e] = sigmoidf_(o[e]); } \
                    else if (kind == 3) { _Pragma("unroll") for (int e = 0; e < 8; ++e) o[e] = 0.f; } \
                    *(GAS u32x4*)((GAS unsigned char*)ALG + (unsigned)((r >> 4) * (17 * 1024) + (r & 15) * 16) + jfo) = pack8(o); } } } while (0)
            u32x4 cuA[3], prA[3];
            for (int ib = 0; ib < 4; ++ib) {
                asm volatile("" : "+v"(r0));
                SA_LOAD(cuA, prA, ib);
                SB();
                SA_COMP(cuA, prA, ib);
                SB();
            }
#undef SA_LOAD
#undef SA_COMP
            }
        __builtin_amdgcn_fence(__ATOMIC_RELEASE, "workgroup");
        __syncthreads();
        __builtin_amdgcn_fence(__ATOMIC_ACQUIRE, "workgroup");
        float* const LWp = (float*)(F.ws + WS_R3) + (size_t)F.bid * (RH * 4096);
        bf16* const LAp = (bf16*)(F.ws + WS_R1) + (size_t)F.bid * (RH * 2 * 4096);
        { const int mt = w & 3, np = w >> 2;
          unsigned lo = (unsigned)lane * 16u; asm volatile("" : "+v"(lo));
          bf16x8 af[17];
#pragma unroll
          for (int i = 0; i < 17; ++i) af[i] = *(const GAS bf16x8*)((const unsigned char*)ALG + (size_t)(mt * 17 + i) * 1024 + lo);
          const int nch = (l > 0) ? 68 : 60;
#define LP_DMA(hh) do { LAS unsigned char* const bufd = lds + ((hh) & 1) * 69632; \
            for (int cix = w; cix < nch; cix += 8) { const unsigned char* srcp = (cix < 12) ? (const unsigned char*)WLt + (size_t)(4 * (hh) * 3 + cix) * 1024 : (cix < 28) ? (const unsigned char*)ALt + (size_t)(4 * (hh) * 4 + cix - 12) * 1024 \
                    : (cix < 60) ? (const unsigned char*)GLt + (size_t)(4 * (hh) * 8 + cix - 28) * 1024 : (const unsigned char*)VBt + (size_t)(4 * (hh) * 2 + cix - 60) * 1024; \
                __builtin_amdgcn_global_load_lds((const unsigned*)(srcp + lo), (LAS unsigned*)(bufd + cix * 1024), 16, 0, 0); } } while (0)
#define LP_TILE(NK, KO, OFF, STORE) do { \
            _Pragma("unroll") for (int nn = 0; nn < 2; ++nn) { bf16x8 bfr[NK]; \
                _Pragma("unroll") for (int ks = 0; ks < NK; ++ks) bfr[ks] = *(const LAS bf16x8*)(bufc + ((OFF) + (2 * np + nn) * (NK) + ks) * 1024 + lane * 16); \
                SB(); \
                f32x4 acc = {0.f, 0.f, 0.f, 0.f}; \
                _Pragma("unroll") for (int ks = 0; ks < NK; ++ks) acc = __builtin_amdgcn_mfma_f32_16x16x32_bf16(bfr[ks], af[(KO) + ks], acc, 0, 0, 0); \
                const int chu = 16 * (2 * np + nn); STORE; \
                SB(); } } while (0)
          LP_DMA(0);
          for (int h = 0; h < RH; ++h) {
              asm volatile("s_waitcnt vmcnt(0)" ::: "memory");
              __syncthreads();
              if (h + 1 < RH) LP_DMA(h + 1);
              const LAS unsigned char* const bufc = lds + (h & 1) * 69632;
              unsigned lof = (unsigned)(((16 * mt + n) * 64 + 4 * g4) * 2); asm volatile("" : "+v"(lof));
              LP_TILE(3, 0, 0, *(GAS f32x4*)((unsigned char*)(LWp + (size_t)h * 4096 + chu) + 2 * lof) = acc);
              LP_TILE(4, 3, 12, { u32x2 o; o.x = pk2(acc[0], acc[1]); o.y = pk2(acc[2], acc[3]); *(GAS u32x2*)((unsigned char*)(LAp + (size_t)(h * 2 + 0) * 4096 + chu) + lof) = o; });
              LP_TILE(8, 7, 28, { u32x2 o; o.x = pk2(acc[0], acc[1]); o.y = pk2(acc[2], acc[3]); *(GAS u32x2*)((unsigned char*)(P.G + ((size_t)h * M + 64 * c) * 64 + chu) + lof) = o; });
              if (l > 0) LP_TILE(2, 15, 60, { u32x2 o; o.x = pk2(acc[0], acc[1]); o.y = pk2(acc[2], acc[3]); *(GAS u32x2*)((unsigned char*)(LAp + (size_t)(h * 2 + 1) * 4096 + chu) + lof) = o; });
          }
#undef LP_DMA
#undef LP_TILE
        }
        asm volatile("s_waitcnt vmcnt(0)" ::: "memory");
        __builtin_amdgcn_fence(__ATOMIC_RELEASE, "workgroup");
        __syncthreads();
        __builtin_amdgcn_fence(__ATOMIC_ACQUIRE, "workgroup");
        { unsigned zz = 0u; asm volatile("" : "+v"(zz));
          for (int q = F.tid; q < (RP_CUM - RP_LAK) / 16; q += 512) *(LAS u32x4*)(lds + RP_LAK + q * 16) = (u32x4){zz, zz, zz, zz}; }
        __syncthreads();
        for (int h = 0; h < RH; ++h) {
            const int t = F.tid >> 3, cg = F.tid & 7, gr = 64 * c + t; int ch = h * 64 + 8 * cg;
            asm volatile("" : "+v"(ch));
            unsigned pol = (unsigned)(((size_t)h * M + gr) * 64 + 8 * cg); asm volatile("" : "+v"(pol)); const size_t po = pol;
            int hrow = h * 64 + n; asm volatile("" : "+v"(hrow));
            unsigned char* const ck = ck_ptr(F, c, h);
            u32x4 zc_[3], zp_[3];
            LAS float* const PRM = (LAS float*)(lds + RP_END + 64 * PO_PITCH * 4);
            f32x4 prmv = {0.f, 0.f, 0.f, 0.f};
            { unsigned pq = (unsigned)(F.tid < 144 ? F.tid : 0) * 16u; asm volatile("" : "+v"(pq));
              prmv = *(const GAS f32x4*)((const unsigned char*)(F.ws + WS_PRM) + (size_t)((l * RH + h) * 576) * 4 + pq); }
            f32x4 pvf[2], wl_[2]; u32x4 al_, vl_ = {0u, 0u, 0u, 0u};
            { unsigned lro = (unsigned)((h * 64 + t) * 64 + 8 * cg); asm volatile("" : "+v"(lro));
              wl_[0] = *(const GAS f32x4*)(LWp + lro); wl_[1] = *(const GAS f32x4*)(LWp + lro + 4);
              unsigned lao = (unsigned)(((h * 2) * 64 + t) * 64 + 8 * cg); asm volatile("" : "+v"(lao));
              al_ = *(const GAS u32x4*)(LAp + lao); if (l > 0) vl_ = *(const GAS u32x4*)(LAp + lao + 4096); }
#pragma unroll
            for (int q = 0; q < 2; ++q) pvf[q] = *(const GAS f32x4*)(P.VF + po + 4 * q);
#pragma unroll
            for (int which = 0; which < 3; ++which) { const int zc = (which == 0 ? ZC_R : (which == 1 ? ZC_K : ZC_V)) + ch;
                zc_[which] = *(const GAS u32x4*)(Z + (size_t)gr * ZP + zc); zp_[which] = *(const GAS u32x4*)(Z + (size_t)(gr > 0 ? gr - 1 : 0) * ZP + zc); }
            SB();
            if (F.tid < 144) *(LAS f32x4*)(PRM + 4 * F.tid) = prmv;
            asm volatile("s_waitcnt lgkmcnt(0)" ::: "memory");
            __builtin_amdgcn_s_barrier();
            SB();
            float r[8], k2[8], kk[8], bb[8], v[8], lwv[8];
            { float k[8];
#pragma unroll
              for (int which = 0; which < 3; ++which) { float cu[8], pr[8]; unpack8(zc_[which], cu); unpack8(zp_[which], pr);
#pragma unroll
                  for (int e = 0; e < 8; ++e) { const float pv = gr > 0 ? pr[e] : 0.f; const float mm = PRM[which * 64 + 8 * cg + e]; const float zs = cu[e] + (pv - cu[e]) * mm;
                      if (which == 0) r[e] = zs; else if (which == 1) k[e] = zs; else v[e] = zs; } }
              SB();
              if (l > 0) { float vpre[8]; unpack8(vl_, vpre);
#pragma unroll
                  for (int e = 0; e < 8; ++e) { const float vg = sigmoidf_(PRM[8 * 64 + 8 * cg + e] + vpre[e]); const float vf = pvf[e >> 2][e & 3]; v[e] = v[e] + (vf - v[e]) * vg; } }
              *(GAS u32x4*)(P.V + po) = pack8(v);
              if (l == 0) { *(GAS f32x4*)(P.VF + po) = (f32x4){v[0], v[1], v[2], v[3]}; *(GAS f32x4*)(P.VF + po + 4) = (f32x4){v[4], v[5], v[6], v[7]}; }
              SB();
              { float wpre[8];
#pragma unroll
                for (int q = 0; q < 2; ++q) { wpre[4 * q] = wl_[q][0]; wpre[4 * q + 1] = wl_[q][1]; wpre[4 * q + 2] = wl_[q][2]; wpre[4 * q + 3] = wl_[q][3]; }
#pragma unroll
                for (int e = 0; e < 8; ++e) { const float wv = -softplusf_(-(PRM[3 * 64 + 8 * cg + e] + wpre[e])) - 0.5f; lwv[e] = -__expf(wv); } }
              *(LAS f32x4*)(cum + t * 68 + 8 * cg) = (f32x4){lwv[0], lwv[1], lwv[2], lwv[3]}; *(LAS f32x4*)(cum + t * 68 + 8 * cg + 4) = (f32x4){lwv[4], lwv[5], lwv[6], lwv[7]};
              SB();
              float av[8], apre[8]; float ss = 0.f, bc = 0.f;
              unpack8(al_, apre);
#pragma unroll
              for (int e = 0; e < 8; ++e) {
                  av[e] = sigmoidf_(PRM[4 * 64 + 8 * cg + e] + apre[e]);
                  kk[e] = k[e] * PRM[5 * 64 + 8 * cg + e]; ss += kk[e] * kk[e];
                  k2[e] = k[e] * (1.f + (av[e] - 1.f) * PRM[6 * 64 + 8 * cg + e]); bc += r[e] * k2[e] * PRM[7 * 64 + 8 * cg + e]; }
              ss = sum8(ss); bc = sum8(bc); const float rn = 1.f / sqrtf(fmaxf(ss, 1e-24f));
#pragma unroll
              for (int e = 0; e < 8; ++e) { kk[e] *= rn; bb[e] = kk[e] * av[e]; }
              if (cg == 0) P.BC[(size_t)h * M + gr] = bc; }
            __syncthreads();
            { const int pk_ = F.tid & 63, ptq = F.tid >> 6; float run = 0.f;
#pragma unroll
              for (int i = 0; i < 8; ++i) { run += cum[(8 * ptq + i) * 68 + pk_]; cum[(8 * ptq + i) * 68 + pk_] = run; }
              seg[ptq * 64 + pk_] = run;
              __syncthreads();
              float off = 0.f;
              for (int q = 0; q < ptq; ++q) off += seg[q * 64 + pk_];
#pragma unroll
              for (int i = 0; i < 8; ++i) cum[(8 * ptq + i) * 68 + pk_] += off; }
            __syncthreads();
            { float cmv[8], ccv[8];
              { const f32x4 c0 = *(const LAS f32x4*)(cum + t * 68 + 8 * cg), c1 = *(const LAS f32x4*)(cum + t * 68 + 8 * cg + 4), d0 = *(const LAS f32x4*)(cum + 63 * 68 + 8 * cg), d1 = *(const LAS f32x4*)(cum + 63 * 68 + 8 * cg + 4);
#pragma unroll
                for (int e = 0; e < 4; ++e) { cmv[e] = c0[e]; cmv[4 + e] = c1[e]; ccv[e] = d0[e]; ccv[4 + e] = d1[e]; } }
              float at[8], bt[8], kt[8], rt[8];
#pragma unroll
              for (int e = 0; e < 8; ++e) { const float cm = cmv[e], cC = ccv[e];
                  const float ein = __expf(cm), einv = __expf(-cm), eex = __expf(cm - lwv[e]), ed = __expf(cC - cm);
                  at[e] = -kk[e] * eex; bt[e] = bb[e] * einv; kt[e] = k2[e] * einv; rt[e] = r[e] * ein;
                  const unsigned pbd = pk2(bb[e] * ed, k2[e] * ed);
                  BdT[(8 * cg + e) * RPP + t] = (bf16)(pbd & 0xffffu); KdT[(8 * cg + e) * RPP + t] = (bf16)(pbd >> 16);
                  VT[(8 * cg + e) * RPP + t] = (bf16)(pk2(v[e], 0.f) & 0xffffu); }
              *(LAS u32x4*)(At + t * RPP + 8 * cg) = pack8(at); *(LAS u32x4*)(Bt + t * RPP + 8 * cg) = pack8(bt); *(LAS u32x4*)(Kt + t * RPP + 8 * cg) = pack8(kt); *(LAS u32x4*)(Rt + t * RPP + 8 * cg) = pack8(rt);
              if (F.tid < 64) ((GAS float*)(ck + CK_GC))[F.tid] = __expf(cum[63 * 68 + F.tid]); }
            __syncthreads();
            rwkv_chunk_tail(F, ck, At, Bt, Kt, Rt, BdT, KdT, VT, Lak, Mrb, Mrk, Lm, Tbb);
        }
    }
}

constexpr int SC_SLOT = 8192 + 2048 + 512, SC_NS = 14;
static_assert(SC_NS * SC_SLOT <= MISC_OFF, "scan ring");
DI void rwkv_scan_phase(const Frame& F, int h, int vs) {
    LAS unsigned char* const lds = F.lds;
    const int lane = F.lane, w = F.wave, g4 = lane >> 4;
    if (w >= 4) {
        const int lw_ = w - 4;
#define SC_DMA(cc) do { const int cq_ = (cc) < NCH ? (cc) : NCH - 1; const unsigned char* ck_ = ck_ptr(F, cq_, h); LAS unsigned char* sl_ = lds + ((cc) % SC_NS) * SC_SLOT; \
            _Pragma("unroll") for (int i_ = 0; i_ < 2; ++i_) __builtin_amdgcn_global_load_lds((const unsigned*)(ck_ + CK_PL + (size_t)((lw_ * 2 + i_) * 64 + lane) * 16), (LAS unsigned*)(sl_ + (lw_ * 2 + i_) * 1024), 16, 0, 0); \
            if (lw_ < 2) __builtin_amdgcn_global_load_lds((const unsigned*)(ck_ + CK_Q + (size_t)vs * 2048 + (size_t)(lw_ * 64 + lane) * 16), (LAS unsigned*)(sl_ + 8192 + lw_ * 1024), 16, 0, 0); \
            else __builtin_amdgcn_global_load_lds((const unsigned*)(ck_ + CK_GC + (size_t)lane * 4), (LAS unsigned*)(sl_ + 10240 + (lw_ - 2) * 256), 4, 0, 0); } while (0)
        for (int cc = 0; cc < SC_NS - 1; ++cc) SC_DMA(cc);
        asm volatile("s_waitcnt vmcnt(33)" ::: "memory");
        __builtin_amdgcn_s_barrier();
        for (int c = 0; c < NCH; ++c) {
            SC_DMA(c + SC_NS - 1);
            asm volatile("s_waitcnt vmcnt(33)" ::: "memory");
            __builtin_amdgcn_s_barrier();
        }
#undef SC_DMA
    } else if (w == 0) {
        f32x4 Hf[4];
#pragma unroll
        for (int mt = 0; mt < 4; ++mt) Hf[mt] = (f32x4){0.f, 0.f, 0.f, 0.f};
        __builtin_amdgcn_s_barrier();
        f32x4 gqA[4], gqB[4]; u32x2 qqA[4], qqB[4]; bf16x8 pfA[4][2], pfB[4][2];
#define SC_LDS(cc, gq, qq, pf) do { const LAS unsigned char* sl = lds + ((cc) % SC_NS) * SC_SLOT; \
            _Pragma("unroll") for (int mt = 0; mt < 4; ++mt) { gq[mt] = *(const LAS f32x4*)(sl + 10240 + (16 * mt + 4 * g4) * 4); qq[mt] = *(const LAS u32x2*)(sl + 8192 + (size_t)(mt * 64 + lane) * 8); \
                _Pragma("unroll") for (int ks = 0; ks < 2; ++ks) pf[mt][ks] = *(const LAS bf16x8*)(sl + (size_t)((mt * 2 + ks) * 64 + lane) * 16); } } while (0)
#define SC_STEP(c, gq, qq, pf, gqn, qqn, pfn) do { \
            SC_LDS((c) + 1, gqn, qqn, pfn); SB(); \
            f32x4 acc[4]; \
            bf16x8 hb[2]; hb[0] = pack_pi(Hf[0], Hf[1]); hb[1] = pack_pi(Hf[2], Hf[3]); \
            unsigned char* ck = ck_ptr(F, (c), h); \
            _Pragma("unroll") for (int ks = 0; ks < 2; ++ks) *(GAS bf16x8*)(ck + CK_H + (size_t)((vs * 2 + ks) * 64 + lane) * 16) = hb[ks]; \
            _Pragma("unroll") for (int mt = 0; mt < 4; ++mt) { const f32x4 qf = {bflo(qq[mt].x), bfhi(qq[mt].x), bflo(qq[mt].y), bfhi(qq[mt].y)}; acc[mt] = gq[mt] * Hf[mt] + qf; } \
            _Pragma("unroll") for (int ks = 0; ks < 2; ++ks) \
                _Pragma("unroll") for (int mt = 0; mt < 4; ++mt) acc[mt] = __builtin_amdgcn_mfma_f32_16x16x32_bf16(pf[mt][ks], hb[ks], acc[mt], 0, 0, 0); \
            _Pragma("unroll") for (int mt = 0; mt < 4; ++mt) Hf[mt] = acc[mt]; \
            SB(); \
            asm volatile("s_waitcnt lgkmcnt(0)" ::: "memory"); \
            __builtin_amdgcn_s_barrier(); } while (0)
        SC_LDS(0, gqA, qqA, pfA);
        for (int c = 0; c < NCH; c += 2) {
            SC_STEP(c, gqA, qqA, pfA, gqB, qqB, pfB);
            SC_STEP(c + 1, gqB, qqB, pfB, gqA, qqA, pfA);
        }
#undef SC_STEP
#undef SC_LDS
    } else {
        for (int c = 0; c <= NCH; ++c) __builtin_amdgcn_s_barrier();
    }
}

DI float sum16(float v) { v += __builtin_bit_cast(float, __builtin_amdgcn_update_dpp(0, __builtin_bit_cast(int, v), 0xB1, 0xF, 0xF, true));
                          v += __builtin_bit_cast(float, __builtin_amdgcn_update_dpp(0, __builtin_bit_cast(int, v), 0x4E, 0xF, 0xF, true));
                          v += __builtin_bit_cast(float, __builtin_amdgcn_update_dpp(0, __builtin_bit_cast(int, v), 0x141, 0xF, 0xF, true));
                          v += __builtin_bit_cast(float, __builtin_amdgcn_update_dpp(0, __builtin_bit_cast(int, v), 0x140, 0xF, 0xF, true)); return v; }
DI void rwkv_post_phase(const Frame& F, const CAS Args& a, int l) {
    const RwPrep P = rwprep_ptrs(F);
    bf16* ycat = (bf16*)(F.ws + WS_R3);
    const int lane = F.lane, n = lane & 15, g4 = lane >> 4;
    const int gw = F.bid * 8 + F.wave, NGW = F.G * 8;
#define XSUM(v) do { v += __builtin_bit_cast(float, __builtin_amdgcn_ds_bpermute(a16, __builtin_bit_cast(int, v))); v += __builtin_bit_cast(float, __builtin_amdgcn_ds_bpermute(a32, __builtin_bit_cast(int, v))); } while (0)
    for (int it = gw; it < NCH * RH * 4; it += NGW) {
        const int mt = it & 3, ch_ = it >> 2, c = ch_ / RH, h = ch_ - c * RH;
        const unsigned char* ck = ck_ptr(F, c, h);
        bf16x8 af[2], hf[4][2]; f32x4 acc[4], lw4[4], lb4[4]; u32x2 vv[4], gg[4];
        const int t = 64 * c + 16 * mt + n; const size_t po = ((size_t)h * M + t) * 64 + 4 * g4;
        int a16 = (lane ^ 16) << 2, a32 = (lane ^ 32) << 2; asm volatile("" : "+v"(a16), "+v"(a32));
#pragma unroll
        for (int ks = 0; ks < 2; ++ks) af[ks] = *(const GAS bf16x8*)(ck + CK_RP + (size_t)((mt * 2 + ks) * 64 + lane) * 16);
#pragma unroll
        for (int nt = 0; nt < 4; ++nt) { acc[nt] = *(const GAS f32x4*)(ck + CK_O0 + (size_t)((nt * 4 + mt) * 64 + lane) * 16);
#pragma unroll
            for (int ks = 0; ks < 2; ++ks) hf[nt][ks] = *(const GAS bf16x8*)(ck + CK_H + (size_t)((nt * 2 + ks) * 64 + lane) * 16);
            vv[nt] = *(const GAS u32x2*)(P.V + po + 16 * nt); gg[nt] = *(const GAS u32x2*)(P.G + po + 16 * nt); }
        const float bcv = P.BC[(size_t)h * M + t];
#pragma unroll
        for (int nt = 0; nt < 4; ++nt) { lw4[nt] = *(const GAS f32x4*)(a.in[23] + (size_t)l * RW + h * 64 + 16 * nt + 4 * g4); lb4[nt] = *(const GAS f32x4*)(a.in[24] + (size_t)l * RW + h * 64 + 16 * nt + 4 * g4); }
        SB();
#pragma unroll
        for (int nt = 0; nt < 4; ++nt)
#pragma unroll
            for (int ks = 0; ks < 2; ++ks) acc[nt] = __builtin_amdgcn_mfma_f32_16x16x32_bf16(hf[nt][ks], af[ks], acc[nt], 0, 0, 0);
        float s = 0.f;
#pragma unroll
        for (int nt = 0; nt < 4; ++nt) s += (acc[nt][0] + acc[nt][1]) + (acc[nt][2] + acc[nt][3]);
        XSUM(s); const float mean = s * (1.f / 64.f);
        float vs = 0.f;
#pragma unroll
        for (int nt = 0; nt < 4; ++nt)
#pragma unroll
            for (int r = 0; r < 4; ++r) { const float d = acc[nt][r] - mean; vs += d * d; }
        XSUM(vs); const float rstd = 1.f / sqrtf(vs * (1.f / 64.f) + 64e-5f);
#pragma unroll
        for (int nt = 0; nt < 4; ++nt) { const float v0 = bflo(vv[nt].x), v1 = bfhi(vv[nt].x), v2 = bflo(vv[nt].y), v3 = bfhi(vv[nt].y), g0 = bflo(gg[nt].x), g1 = bfhi(gg[nt].x), g2 = bflo(gg[nt].y), g3 = bfhi(gg[nt].y);
            const float y0 = ((acc[nt][0] - mean) * rstd * lw4[nt][0] + lb4[nt][0] + bcv * v0) * g0, y1 = ((acc[nt][1] - mean) * rstd * lw4[nt][1] + lb4[nt][1] + bcv * v1) * g1;
            const float y2 = ((acc[nt][2] - mean) * rstd * lw4[nt][2] + lb4[nt][2] + bcv * v2) * g2, y3 = ((acc[nt][3] - mean) * rstd * lw4[nt][3] + lb4[nt][3] + bcv * v3) * g3;
            u32x2 o; o.x = pk2(y0, y1); o.y = pk2(y2, y3);
            *(GAS u32x2*)(ycat + (size_t)t * D + S5W + h * 64 + 16 * nt + 4 * g4) = o; }
    }
#undef XSUM
}
constexpr size_t GK_E = 0, GK_H = 32768, GK_GC = 49152, GK_SIZE = 49408;
DI unsigned char* gk_ptr(const Frame& F, int c, int h) { return F.ws + WS_GK + ((size_t)c * GH + h) * GK_SIZE; }
constexpr int GP_CUM = 0, GP_SEG = 17408, GP_KDT = GP_SEG + 2048, GP_VT = GP_KDT + 9216, GP_QT = GP_VT + 18432, GP_KT = GP_QT + 9216, GP_ATT = GP_KT + 9216, GP_PART = GP_ATT + 9216, GP_END = GP_PART + 2048;
static_assert(GP_END <= MISC_OFF, "gla LDS");

DI void gla_store_vt(const Frame& F, const u32x4 (&rv)[2], LAS bf16* VT) {
#pragma unroll
    for (int half = 0; half < 2; ++half) { const int t = F.tid >> 3, v0 = 64 * half + 8 * (F.tid & 7); float f[8]; unpack8(rv[half], f);
#pragma unroll
        for (int e = 0; e < 8; ++e) VT[(v0 + e) * RPP + t] = (bf16)(pk2(f[e], 0.f) & 0xffffu); }
}
DI void gla_pre_phase(const Frame& F, const CAS Args& a, int l) {
    const bf16* Z = (const bf16*)(F.ws + WS_R2);
    LAS float* const cum = (LAS float*)(F.lds + GP_CUM); LAS float* const seg = (LAS float*)(F.lds + GP_SEG);
    LAS bf16* const KdT = (LAS bf16*)(F.lds + GP_KDT); LAS bf16* const VT = (LAS bf16*)(F.lds + GP_VT);
    const int lane = F.lane, w = F.wave, n = lane & 15, g4 = lane >> 4;
    const int t = F.tid >> 3, cg = F.tid & 7;
    u32x4 rv[2], rk, rq, ra0, ra1;
#define GP_LOADZ(itx) do { const int c_ = (itx) / GH, h_ = (itx) - c_ * GH; const bf16* zr_ = Z + (size_t)(64 * c_ + t) * ZP; \
        rv[0] = *(const GAS u32x4*)(zr_ + ZC_GV + h_ * 128 + 8 * cg); rv[1] = *(const GAS u32x4*)(zr_ + ZC_GV + h_ * 128 + 64 + 8 * cg); \
        rk = *(const GAS u32x4*)(zr_ + ZC_GKK + h_ * 64 + 8 * cg); rq = *(const GAS u32x4*)(zr_ + ZC_GQ + h_ * 64 + 8 * cg); \
        ra0 = *(const GAS u32x4*)(zr_ + ZC_GA); ra1 = *(const GAS u32x4*)(zr_ + ZC_GA + 8); } while (0)
    if (F.bid < NCH * GH) GP_LOADZ(F.bid);
    for (int it = F.bid; it < NCH * GH; it += F.G) {
        const int c = it / GH, h = it - c * GH;
        unsigned char* const gk = gk_ptr(F, c, h);
        unsigned char* const qkimg = F.ws + WS_GQK + (size_t)it * 16384; unsigned char* const vimg = F.ws + WS_GVP + (size_t)it * 16384;
        { const float* alora = a.in[29] + (size_t)l * 16 * GK + h * 64 + 8 * cg; const float* abias = a.in[30] + (size_t)l * GK + h * 64 + 8 * cg;
          const f32x4 b0 = *(const GAS f32x4*)abias, b1 = *(const GAS f32x4*)(abias + 4);
          f32x4 w0[16], w1[16];
#pragma unroll
          for (int j = 0; j < 16; ++j) { w0[j] = *(const GAS f32x4*)(alora + (size_t)j * GK); w1[j] = *(const GAS f32x4*)(alora + (size_t)j * GK + 4); }
          SB();
          float ain[16]; { float f0[8], f1[8]; unpack8(ra0, f0); unpack8(ra1, f1);
#pragma unroll
              for (int e = 0; e < 8; ++e) { ain[e] = f0[e]; ain[8 + e] = f1[e]; } }
          float x[8]; x[0] = b0[0]; x[1] = b0[1]; x[2] = b0[2]; x[3] = b0[3]; x[4] = b1[0]; x[5] = b1[1]; x[6] = b1[2]; x[7] = b1[3];
#pragma unroll
          for (int j = 0; j < 16; ++j) {
#pragma unroll
              for (int e = 0; e < 4; ++e) { x[e] += ain[j] * w0[j][e]; x[4 + e] += ain[j] * w1[j][e]; } }
          f32x4 o0, o1;
#pragma unroll
          for (int e = 0; e < 4; ++e) { o0[e] = -softplusf_(-x[e]) * (1.f / 16.f); o1[e] = -softplusf_(-x[4 + e]) * (1.f / 16.f); }
          *(LAS f32x4*)(cum + t * 68 + 8 * cg) = o0; *(LAS f32x4*)(cum + t * 68 + 8 * cg + 4) = o1; }
        __syncthreads();
        { const int k = F.tid & 63, tq = F.tid >> 6; float run = 0.f;
#pragma unroll
          for (int i = 0; i < 8; ++i) { run += cum[(8 * tq + i) * 68 + k]; cum[(8 * tq + i) * 68 + k] = run; }
          seg[tq * 64 + k] = run;
          __syncthreads();
          float off = 0.f;
          for (int q = 0; q < tq; ++q) off += seg[q * 64 + k];
#pragma unroll
          for (int i = 0; i < 8; ++i) cum[(8 * tq + i) * 68 + k] += off; }
        __syncthreads();
        { float kf[8], qf[8]; unpack8(rk, kf); unpack8(rq, qf);
          const f32x4 c0 = *(const LAS f32x4*)(cum + t * 68 + 8 * cg), c1 = *(const LAS f32x4*)(cum + t * 68 + 8 * cg + 4), d0 = *(const LAS f32x4*)(cum + 63 * 68 + 8 * cg), d1 = *(const LAS f32x4*)(cum + 63 * 68 + 8 * cg + 4);
          float qt[8], kt[8];
#pragma unroll
          for (int e = 0; e < 8; ++e) { const float cm = (e < 4 ? c0[e] : c1[e - 4]); const float ed = __expf((e < 4 ? d0[e] : d1[e - 4]) - cm); KdT[(8 * cg + e) * RPP + t] = (bf16)(pk2(kf[e] * ed, 0.f) & 0xffffu);
              qt[e] = qf[e] * 0.125f * __expf(cm); kt[e] = kf[e] * __expf(-cm); }
          { const int q3 = cg & 3; unsigned char* const qd = qkimg + (size_t)((((t >> 4) * 2 + (cg >> 2)) * 64 + (2 * (q3 & 1)) * 16 + (t & 15)) * 16 + (q3 >> 1) * 8);
            u32x2 o; o.x = pk2(qt[0], qt[1]); o.y = pk2(qt[2], qt[3]); *(GAS u32x2*)qd = o; o.x = pk2(qt[4], qt[5]); o.y = pk2(qt[6], qt[7]); *(GAS u32x2*)(qd + 256) = o;
            o.x = pk2(kt[0], kt[1]); o.y = pk2(kt[2], kt[3]); *(GAS u32x2*)(qd + 8192) = o; o.x = pk2(kt[4], kt[5]); o.y = pk2(kt[6], kt[7]); *(GAS u32x2*)(qd + 8192 + 256) = o; }
          if (F.tid < 64) ((GAS float*)(gk + GK_GC))[F.tid] = __expf(cum[63 * 68 + F.tid]); }
        gla_store_vt(F, rv, VT);
        SB();
        { const int itn = it + F.G; if (itn < NCH * GH) GP_LOADZ(itn); }
        SB();
        asm volatile("s_waitcnt lgkmcnt(0)" ::: "memory"); __builtin_amdgcn_s_barrier(); SB();
        { bf16x8 vf[2], kf_[4][2];
#pragma unroll
          for (int ks = 0; ks < 2; ++ks) { *(GAS bf16x8*)(vimg + (size_t)((w * 2 + ks) * 64 + lane) * 16) = ld_pi(VT + (16 * w + n) * RPP, ks, g4);
              vf[ks] = *(const LAS bf16x8*)(VT + (16 * w + n) * RPP + 32 * ks + 8 * g4);
#pragma unroll
              for (int mt = 0; mt < 4; ++mt) kf_[mt][ks] = *(const LAS bf16x8*)(KdT + (16 * mt + n) * RPP + 32 * ks + 8 * g4); }
          SB();
#pragma unroll
          for (int mt = 0; mt < 4; ++mt) { f32x4 acc = {0.f, 0.f, 0.f, 0.f};
#pragma unroll
              for (int ks = 0; ks < 2; ++ks) acc = __builtin_amdgcn_mfma_f32_16x16x32_bf16(kf_[mt][ks], vf[ks], acc, 0, 0, 0);
              *(GAS f32x4*)(gk + GK_E + (size_t)((w * 4 + mt) * 64 + lane) * 16) = acc; } }
        asm volatile("s_waitcnt lgkmcnt(0)" ::: "memory"); __builtin_amdgcn_s_barrier(); SB();
    }
#undef GP_LOADZ
}
DI void gla_scan_wave(const Frame& F, int item) {
    const int mt = item & 3, vs = (item >> 2) & 7, h = item >> 5;
    const int lane = F.lane, g4 = lane >> 4;
    f32x4 H = {0.f, 0.f, 0.f, 0.f};
    constexpr int U = 16;
    for (int c0 = 0; c0 < NCH; c0 += U) {
        f32x4 e[U], g[U];
#pragma unroll
        for (int u = 0; u < U; ++u) { const unsigned char* gk = gk_ptr(F, c0 + u, h); e[u] = *(const GAS f32x4*)(gk + GK_E + (size_t)((vs * 4 + mt) * 64 + lane) * 16); g[u] = *(const GAS f32x4*)(gk + GK_GC + (16 * mt + 4 * g4) * 4); }
        SB();
#pragma unroll
        for (int u = 0; u < U; ++u) { unsigned char* gk = gk_ptr(F, c0 + u, h);
            u32x2 o; o.x = pk2(H[0], H[1]); o.y = pk2(H[2], H[3]);
            *(GAS u32x2*)(gk + GK_H + (size_t)((vs * 2 + (mt >> 1)) * 64 + lane) * 16 + (mt & 1) * 8) = o;
            H = g[u] * H + e[u]; }
    }
}
#define GLDU(T, ubase, loff) (*(const GAS T*)((const unsigned char*)(ubase) + (loff)))
DI void gla_post_item(const Frame& F, const CAS Args& a, int l, int item) {
    const bf16* Z = (const bf16*)(F.ws + WS_R2);
    bf16* ycat = (bf16*)(F.ws + WS_R3);
    const int lane = F.lane, n = lane & 15, g4 = lane >> 4;
    const int mt = item & 3, ch_ = item >> 2, c = ch_ / GH, h = ch_ - c * GH;
    const unsigned char* const gk = gk_ptr(F, c, h) + GK_H;
    const unsigned char* const qk = F.ws + WS_GQK + (size_t)ch_ * 16384;
    const unsigned char* const vp = F.ws + WS_GVP + (size_t)ch_ * 16384;
    unsigned lo16 = (unsigned)lane * 16u; asm volatile("" : "+v"(lo16));
    bf16x8 qf[2], kf[4][2], hA[4][2], vA[4][2];
#pragma unroll
    for (int ks = 0; ks < 2; ++ks) qf[ks] = GLDU(bf16x8, qk + (mt * 2 + ks) * 1024, lo16);
#pragma unroll
    for (int ms = 0; ms < 4; ++ms)
#pragma unroll
        for (int ks = 0; ks < 2; ++ks) kf[ms][ks] = GLDU(bf16x8, qk + 8192 + (ms * 2 + ks) * 1024, lo16);
#pragma unroll
    for (int vt = 0; vt < 4; ++vt)
#pragma unroll
        for (int ks = 0; ks < 2; ++ks) { hA[vt][ks] = GLDU(bf16x8, gk + (vt * 2 + ks) * 1024, lo16); vA[vt][ks] = GLDU(bf16x8, vp + (vt * 2 + ks) * 1024, lo16); }
    SB();
    bf16x8 Pb[2];
    { f32x4 att[4];
#pragma unroll
      for (int ms = 0; ms < 4; ++ms) { att[ms] = (f32x4){0.f, 0.f, 0.f, 0.f};
          if (ms <= mt) {
#pragma unroll
              for (int ks = 0; ks < 2; ++ks) att[ms] = __builtin_amdgcn_mfma_f32_16x16x32_bf16(kf[ms][ks], qf[ks], att[ms], 0, 0, 0);
              if (ms == mt) {
#pragma unroll
                  for (int r = 0; r < 4; ++r) att[ms][r] = ((4 * g4 + r) <= n) ? att[ms][r] : 0.f; } } }
      Pb[0] = pack_pi(att[0], att[1]); Pb[1] = pack_pi(att[2], att[3]); }
    SB();
    bf16x8 hB[4][2], vB[4][2]; u32x2 gzr[8];
    const int tl = 64 * c + 16 * mt + n;
#pragma unroll
    for (int vt = 0; vt < 4; ++vt)
#pragma unroll
        for (int ks = 0; ks < 2; ++ks) { hB[vt][ks] = GLDU(bf16x8, gk + ((vt + 4) * 2 + ks) * 1024, lo16); vB[vt][ks] = GLDU(bf16x8, vp + ((vt + 4) * 2 + ks) * 1024, lo16); }
#pragma unroll
    for (int vt = 0; vt < 8; ++vt) gzr[vt] = *(const GAS u32x2*)(Z + (size_t)tl * ZP + ZC_GG + h * 128 + 16 * vt + 4 * g4);
    SB();
    f32x4 acc[8];
#pragma unroll
    for (int vt = 0; vt < 4; ++vt) { acc[vt] = (f32x4){0.f, 0.f, 0.f, 0.f};
#pragma unroll
        for (int ks = 0; ks < 2; ++ks) acc[vt] = __builtin_amdgcn_mfma_f32_16x16x32_bf16(hA[vt][ks], qf[ks], acc[vt], 0, 0, 0);
        acc[vt] = __builtin_amdgcn_mfma_f32_16x16x32_bf16(vA[vt][0], Pb[0], acc[vt], 0, 0, 0);
        if (mt >= 2) acc[vt] = __builtin_amdgcn_mfma_f32_16x16x32_bf16(vA[vt][1], Pb[1], acc[vt], 0, 0, 0); }
    SB();
#pragma unroll
    for (int vt = 0; vt < 4; ++vt) { acc[4 + vt] = (f32x4){0.f, 0.f, 0.f, 0.f};
#pragma unroll
        for (int ks = 0; ks < 2; ++ks) acc[4 + vt] = __builtin_amdgcn_mfma_f32_16x16x32_bf16(hB[vt][ks], qf[ks], acc[4 + vt], 0, 0, 0);
        acc[4 + vt] = __builtin_amdgcn_mfma_f32_16x16x32_bf16(vB[vt][0], Pb[0], acc[4 + vt], 0, 0, 0);
        if (mt >= 2) acc[4 + vt] = __builtin_amdgcn_mfma_f32_16x16x32_bf16(vB[vt][1], Pb[1], acc[4 + vt], 0, 0, 0); }
    SB();
    f32x4 ngv[8];
    { const float* ngp = a.in[31] + (size_t)l * GV + h * 128 + 4 * g4;
#pragma unroll
      for (int vt = 0; vt < 8; ++vt) ngv[vt] = *(const GAS f32x4*)(ngp + 16 * vt); }
    float ss = 0.f;
#pragma unroll
    for (int vt = 0; vt < 8; ++vt)
#pragma unroll
        for (int r = 0; r < 4; ++r) ss += acc[vt][r] * acc[vt][r];
    { int a16 = (lane ^ 16) << 2, a32 = (lane ^ 32) << 2; asm volatile("" : "+v"(a16), "+v"(a32));
      ss += __builtin_bit_cast(float, __builtin_amdgcn_ds_bpermute(a16, __builtin_bit_cast(int, ss)));
      ss += __builtin_bit_cast(float, __builtin_amdgcn_ds_bpermute(a32, __builtin_bit_cast(int, ss))); }
    const float rn = 1.f / sqrtf(ss * (1.f / 128.f) + NORM_EPS);
    SB();
#pragma unroll
    for (int vt = 0; vt < 8; ++vt) { const float g0 = bflo(gzr[vt].x), g1 = bfhi(gzr[vt].x), g2 = bflo(gzr[vt].y), g3 = bfhi(gzr[vt].y);
        const float y0 = acc[vt][0] * rn * ngv[vt][0] * g0 * sigmoidf_(g0), y1 = acc[vt][1] * rn * ngv[vt][1] * g1 * sigmoidf_(g1);
        const float y2 = acc[vt][2] * rn * ngv[vt][2] * g2 * sigmoidf_(g2), y3 = acc[vt][3] * rn * ngv[vt][3] * g3 * sigmoidf_(g3);
        u32x2 o; o.x = pk2(y0, y1); o.y = pk2(y2, y3);
        *(GAS u32x2*)(ycat + (size_t)tl * D + S5W + RW + h * 128 + 16 * vt + 4 * g4) = o; }
}
DI void gla_post_phase(const Frame& F, const CAS Args& a, int l) {
    constexpr int NIT = NCH * GH * 4;
    const int NGW = F.G * 8, rounds = NIT / NGW, rem = NIT - rounds * NGW, per = rem / F.G, left = rem - per * F.G;
    const int wv = __builtin_amdgcn_readfirstlane(F.wave);
    for (int r = 0; r < rounds; ++r) gla_post_item(F, a, l, r * NGW + F.bid * 8 + wv);
    if (wv < per) gla_post_item(F, a, l, rounds * NGW + F.bid * per + wv);
    else if (wv == per && F.bid < left) gla_post_item(F, a, l, rounds * NGW + F.G * per + F.bid);
}
constexpr size_t ALG_BYTES_C = (size_t)64 * 552 * 2;
constexpr size_t S5T_G = 0, S5T_K = 32768, S5T_F = 65536, S5T_L8 = 98304, S5T_LN = 98816, S5T_PN = 99328, S5T_SIZE = 99328 + 8192;
constexpr size_t WS_S5X = WS_S5XA;
static_assert(256 * ALG_BYTES_C <= SZ_HB && (size_t)DEPTH * 48 * S5T_SIZE <= 2 * SZ_HB && WS_S5TA >= WS_R4 + 3 * SZ_HB, "scratch overlays");
constexpr int S5_TW = 0, S5_X0 = 2 * 8 * 128 * 4, S5_END = S5_X0 + 2 * 128 * 4;
static_assert(S5_END <= MISC_OFF, "s5 LDS");

DI void s5_tables(const Frame& F, const CAS Args& a, int l, int g) {
    LAS float* PWr = (LAS float*)F.lds;
    LAS float* PWi = PWr + 9 * 64;
    LAS float* Bbr = PWi + 9 * 64;
    LAS float* Bbi = Bbr + 1024;
    LAS float* Cr = Bbi + 1024;
    LAS float* Ci = Cr + 1024;
    LAS float* Kt = Ci + 1024;
    unsigned char* tb = F.ws + WS_S5TA + ((size_t)l * S5G + g) * S5T_SIZE;
    if (F.tid < 64) { const int p = F.tid; const size_t gp = ((size_t)l * S5G + g) * S5P + p;
        const float lre = fminf(a.in[4][gp], -1e-4f), lim = a.in[5][gp], dt = expf(a.in[6][(size_t)l * S5G + g]);
        const float er = expf(lre * dt); float sn, cs; sincosf(lim * dt, &sn, &cs);
        const float lbr = er * cs, lbi = er * sn;
        const float nr = lbr - 1.f, ni = lbi, den = 1.f / (lre * lre + lim * lim);
        const float fr_ = (nr * lre + ni * lim) * den, fi_ = (ni * lre - nr * lim) * den;
#pragma unroll
        for (int jj = 0; jj < 16; ++jj) { const float br = a.in[7][gp * 16 + jj], bi = a.in[8][gp * 16 + jj]; Bbr[p * 16 + jj] = fr_ * br - fi_ * bi; Bbi[p * 16 + jj] = fr_ * bi + fi_ * br; }
        float pr = 1.f, pi = 0.f;
#pragma unroll
        for (int nn = 0; nn < 9; ++nn) { PWr[nn * 64 + p] = pr; PWi[nn * 64 + p] = pi; const float t0 = pr * lbr - pi * lbi, t1 = pr * lbi + pi * lbr; pr = t0; pi = t1; }
        float qr = PWr[8 * 64 + p], qi = PWi[8 * 64 + p];
        ((GAS float*)(tb + S5T_L8))[p] = qr; ((GAS float*)(tb + S5T_L8))[64 + p] = qi;
        { float ur = 1.f, ui = 0.f;
#pragma unroll
          for (int nn = 0; nn < 16; ++nn) { ((GAS float*)(tb + S5T_PN))[nn * 128 + p] = ur; ((GAS float*)(tb + S5T_PN))[nn * 128 + 64 + p] = ui; const float t0 = ur * qr - ui * qi, t1 = ur * qi + ui * qr; ur = t0; ui = t1; } }
#pragma unroll
        for (int s = 0; s < 7; ++s) { const float t0 = qr * qr - qi * qi, t1 = 2.f * qr * qi; qr = t0; qi = t1; }
        ((GAS float*)(tb + S5T_LN))[p] = qr; ((GAS float*)(tb + S5T_LN))[64 + p] = qi; }
    for (int q = F.tid; q < 1024; q += 512) { const int i = q >> 6, pp = q & 63; const size_t ci = (((size_t)l * S5G + g) * 16 + i) * S5P + pp; Cr[q] = a.in[9][ci]; Ci[q] = a.in[10][ci]; }
    __syncthreads();
    { const int tau = F.tid >> 6, i = (F.tid >> 2) & 15, j0 = (F.tid & 3) * 4; float s[4] = {0.f, 0.f, 0.f, 0.f};
      for (int p = 0; p < 64; ++p) { const float cr = Cr[i * 64 + p], ci = Ci[i * 64 + p], wr = PWr[tau * 64 + p], wi = PWi[tau * 64 + p];
          const float mr = cr * wr - ci * wi, mi = cr * wi + ci * wr;
#pragma unroll
          for (int e = 0; e < 4; ++e) s[e] += mr * Bbr[p * 16 + j0 + e] - mi * Bbi[p * 16 + j0 + e]; }
#pragma unroll
      for (int e = 0; e < 4; ++e) Kt[(tau * 16 + i) * 16 + j0 + e] = s[e]; }
    __syncthreads();
    { const int row = F.tid >> 2, c0 = (F.tid & 3) * 32;
#pragma unroll
      for (int q8 = 0; q8 < 4; ++q8) { float gv[8], kv[8], fv[8];
#pragma unroll
          for (int e = 0; e < 8; ++e) { const int col = c0 + 8 * q8 + e;
              { const int p = row & 63, part = row >> 6, b = col >> 4, j = col & 15; const float wr = PWr[(7 - b) * 64 + p], wi = PWi[(7 - b) * 64 + p], br = Bbr[p * 16 + j], bi = Bbi[p * 16 + j];
                gv[e] = part == 0 ? (wr * br - wi * bi) : (wr * bi + wi * br); }
              { const int bt = row >> 4, i = row & 15, bs = col >> 4, j = col & 15; kv[e] = (bs <= bt) ? Kt[((bt - bs) * 16 + i) * 16 + j] : 0.f; }
              { const int b = row >> 4, i = row & 15; const int pks = col >> 5, pkg = (col >> 3) & 3, pj = col & 7, pp = 16 * (2 * pks + (pj >> 2)) + 4 * pkg + (pj & 3);
                const int p = pp & 63, part = pp >> 6; const float cr = Cr[i * 64 + p], ci = Ci[i * 64 + p], wr = PWr[(b + 1) * 64 + p], wi = PWi[(b + 1) * 64 + p];
                fv[e] = part == 0 ? (cr * wr - ci * wi) : -(cr * wi + ci * wr); } }
          const int colb = c0 + 8 * q8; const size_t fo = ((size_t)(((row >> 4) * 4 + (colb >> 5)) * 64 + ((colb >> 3) & 3) * 16 + (row & 15))) * 16;
          *(GAS u32x4*)(tb + S5T_G + fo) = pack8(gv); *(GAS u32x4*)(tb + S5T_K + fo) = pack8(kv); *(GAS u32x4*)(tb + S5T_F + fo) = pack8(fv); } }
    __syncthreads();
}

#define LDU(T, ubase, loff) (*(const GAS T*)((const unsigned char*)(ubase) + (loff)))
#define DPPF(v, ctrl) __builtin_bit_cast(float, __builtin_amdgcn_update_dpp(0, __builtin_bit_cast(int, (v)), (ctrl), 0xF, 0xF, true))
template <int CTRL> DI f32x4 dpp4(const f32x4 v) { const float a0 = v[0], a1 = v[1], a2 = v[2], a3 = v[3]; const float b0 = DPPF(a0, CTRL), b1 = DPPF(a1, CTRL), b2 = DPPF(a2, CTRL), b3 = DPPF(a3, CTRL); return (f32x4){b0, b1, b2, b3}; }
template <int D>
DI void s5_scan_step(f32x4 (&Yr)[4], f32x4 (&Yi)[4], f32x4 (&Ar)[4], f32x4 (&Ai)[4]) {
#pragma unroll
    for (int m = 0; m < 4; ++m) {
        const f32x4 sr = dpp4<0x110 + D>(Yr[m]), si = dpp4<0x110 + D>(Yi[m]);
        Yr[m] += Ar[m] * sr - Ai[m] * si; Yi[m] += Ar[m] * si + Ai[m] * sr;
        const f32x4 a2r = Ar[m] * Ar[m] - Ai[m] * Ai[m], a2i = 2.f * Ar[m] * Ai[m]; Ar[m] = a2r; Ai[m] = a2i; }
}
template <bool POST>
DI void s5_phase(const Frame& F, const CAS Args& a, int l, int first, int stride) {
    const bf16* Z = (const bf16*)(F.ws + WS_R2);
    bf16* ypre = (bf16*)(F.ws + WS_R1 + (size_t)M * RW * 4);
    const int lane = F.lane, w = F.wave, n = lane & 15, kg = lane >> 4;
    int par = 0;
    for (int it = first; it < S5G * 16; it += stride, par ^= 1) {
        const int g = it >> 4, ib = it & 15;
        const unsigned char* tb = F.ws + WS_S5TA + ((size_t)l * S5G + g) * S5T_SIZE;
        float* TOT = (float*)(F.ws + WS_S5X) + (size_t)(g * 16) * 128;
        LAS float* const TW = (LAS float*)(F.lds + S5_TW) + par * 8 * 128;
        LAS float* const X0 = (LAS float*)(F.lds + S5_X0) + par * 128;
        const int sb = 128 * ib + 16 * w + n;
        const unsigned char* zb = F.ws + WS_ZS5 + ((size_t)g * M + 8 * (128 * ib + 16 * w)) * 32;
        unsigned lzu = (unsigned)((8 * n + (kg >> 1)) * 32 + (kg & 1) * 16);
        unsigned lzo = (unsigned)(8 * n * 32 + 8 * kg);
        unsigned ltab = (unsigned)lane * 16u;
        unsigned lyo = (unsigned)(8 * n * S5W + 4 * kg) * 2u;
        asm volatile("" : "+v"(lzu), "+v"(lzo), "+v"(ltab), "+v"(lyo));
        bf16x8 uf[4];
#pragma unroll
        for (int ks = 0; ks < 4; ++ks) uf[ks] = LDU(bf16x8, zb + 64 * ks, lzu);
        f32x4 Ar[4], Ai[4];
#pragma unroll
        for (int m = 0; m < 4; ++m) { Ar[m] = *(const GAS f32x4*)((const float*)(tb + S5T_L8) + 16 * m + 4 * kg); Ai[m] = *(const GAS f32x4*)((const float*)(tb + S5T_L8) + 64 + 16 * m + 4 * kg); }
        if (POST && w == 0) { const int p = lane; const float lnr = ((const GAS float*)(tb + S5T_LN))[p], lni = ((const GAS float*)(tb + S5T_LN))[64 + p];
            float xr = 0.f, xi = 0.f;
            for (int q0 = 0; q0 < ib; q0 += 4) { float tr[4], ti[4];
#pragma unroll
                for (int u = 0; u < 4; ++u) { const int q = (q0 + u < ib) ? q0 + u : q0; tr[u] = TOT[q * 128 + p]; ti[u] = TOT[q * 128 + 64 + p]; }
                SB();
#pragma unroll
                for (int u = 0; u < 4; ++u) if (q0 + u < ib) { const float t0 = lnr * xr - lni * xi + tr[u], t1 = lnr * xi + lni * xr + ti[u]; xr = t0; xi = t1; }
                SB(); }
            X0[p] = xr; X0[64 + p] = xi; }
        SB();
        f32x4 Yr[4], Yi[4];
        { bf16x8 gf[2][4];
#pragma unroll
          for (int ks = 0; ks < 4; ++ks) gf[0][ks] = LDU(bf16x8, tb + S5T_G + (0 * 4 + ks) * 1024, ltab);
#pragma unroll
          for (int mt = 0; mt < 8; ++mt) {
              if (mt + 1 < 8) {
#pragma unroll
                  for (int ks = 0; ks < 4; ++ks) gf[(mt + 1) & 1][ks] = LDU(bf16x8, tb + S5T_G + ((mt + 1) * 4 + ks) * 1024, ltab); }
              SB();
              f32x4 acc = {0.f, 0.f, 0.f, 0.f};
#pragma unroll
              for (int ks = 0; ks < 4; ++ks) acc = __builtin_amdgcn_mfma_f32_16x16x32_bf16(gf[mt & 1][ks], uf[ks], acc, 0, 0, 0);
              if (mt < 4) Yr[mt] = acc; else Yi[mt - 4] = acc;
              SB(); } }
        SB();
        s5_scan_step<1>(Yr, Yi, Ar, Ai); SB(); s5_scan_step<2>(Yr, Yi, Ar, Ai); SB(); s5_scan_step<4>(Yr, Yi, Ar, Ai); SB(); s5_scan_step<8>(Yr, Yi, Ar, Ai); SB();
        if (n == 15) {
#pragma unroll
            for (int m = 0; m < 4; ++m) { *(LAS f32x4*)(TW + w * 128 + 16 * m + 4 * kg) = Yr[m]; *(LAS f32x4*)(TW + w * 128 + 64 + 16 * m + 4 * kg) = Yi[m]; } }
        __syncthreads();
        f32x4 Sr[4], Si[4];
#pragma unroll
        for (int m = 0; m < 4; ++m) { Sr[m] = POST ? *(const LAS f32x4*)(X0 + 16 * m + 4 * kg) : (f32x4){0.f, 0.f, 0.f, 0.f}; Si[m] = POST ? *(const LAS f32x4*)(X0 + 64 + 16 * m + 4 * kg) : (f32x4){0.f, 0.f, 0.f, 0.f}; }
        const int nprev = POST ? w : 8;
        for (int q = 0; q < nprev; ++q) {
#pragma unroll
            for (int m = 0; m < 4; ++m) { const f32x4 tr = *(const LAS f32x4*)(TW + q * 128 + 16 * m + 4 * kg), ti = *(const LAS f32x4*)(TW + q * 128 + 64 + 16 * m + 4 * kg);
                const f32x4 nr = Ar[m] * Sr[m] - Ai[m] * Si[m] + tr, ni = Ar[m] * Si[m] + Ai[m] * Sr[m] + ti; Sr[m] = nr; Si[m] = ni; } }
        if (!POST) { if (w == 0 && n == 0) {
#pragma unroll
                for (int m = 0; m < 4; ++m) { *(GAS f32x4*)(TOT + ib * 128 + 16 * m + 4 * kg) = Sr[m]; *(GAS f32x4*)(TOT + ib * 128 + 64 + 16 * m + 4 * kg) = Si[m]; } } }
        if (POST) {
            f32x4 Xr[4], Xi[4], Pr[4], Pi[4];
#pragma unroll
            for (int m = 0; m < 4; ++m) { Pr[m] = *(const GAS f32x4*)((const float*)(tb + S5T_PN) + n * 128 + 16 * m + 4 * kg); Pi[m] = *(const GAS f32x4*)((const float*)(tb + S5T_PN) + n * 128 + 64 + 16 * m + 4 * kg); }
            SB();
#pragma unroll
            for (int m = 0; m < 4; ++m) { const f32x4 yr = dpp4<0x111>(Yr[m]), yi = dpp4<0x111>(Yi[m]); Xr[m] = Pr[m] * Sr[m] - Pi[m] * Si[m] + yr; Xi[m] = Pr[m] * Si[m] + Pi[m] * Sr[m] + yi; }
            bf16x8 xf[4]; xf[0] = pack_pi(Xr[0], Xr[1]); xf[1] = pack_pi(Xr[2], Xr[3]); xf[2] = pack_pi(Xi[0], Xi[1]); xf[3] = pack_pi(Xi[2], Xi[3]);
            SB();
            u32x2 uu[8]; bf16x8 uf2[4];
#pragma unroll
            for (int ks = 0; ks < 4; ++ks) uf2[ks] = LDU(bf16x8, zb + 64 * ks, lzu);
            const f32x4 dv = *(const GAS f32x4*)(a.in[11] + (size_t)l * S5W + 16 * g + 4 * kg);
#pragma unroll
            for (int mt = 0; mt < 8; ++mt) uu[mt] = LDU(u32x2, zb + 32 * mt, lzo);
            { bf16x8 kf[2][4], ff[2][4];
#pragma unroll
              for (int ks = 0; ks < 4; ++ks) { if (2 * ks <= 0) kf[0][ks] = LDU(bf16x8, tb + S5T_K + (0 * 4 + ks) * 1024, ltab); ff[0][ks] = LDU(bf16x8, tb + S5T_F + (0 * 4 + ks) * 1024, ltab); }
#pragma unroll
              for (int mt = 0; mt < 8; ++mt) {
                  if (mt + 1 < 8) {
#pragma unroll
                      for (int ks = 0; ks < 4; ++ks) { if (2 * ks <= mt + 1) kf[(mt + 1) & 1][ks] = LDU(bf16x8, tb + S5T_K + ((mt + 1) * 4 + ks) * 1024, ltab);
                          ff[(mt + 1) & 1][ks] = LDU(bf16x8, tb + S5T_F + ((mt + 1) * 4 + ks) * 1024, ltab); } }
                  SB();
                  f32x4 acc = {0.f, 0.f, 0.f, 0.f};
#pragma unroll
                  for (int ks = 0; ks < 4; ++ks) { if (2 * ks <= mt) acc = __builtin_amdgcn_mfma_f32_16x16x32_bf16(kf[mt & 1][ks], uf2[ks], acc, 0, 0, 0); }
#pragma unroll
                  for (int ks = 0; ks < 4; ++ks) acc = __builtin_amdgcn_mfma_f32_16x16x32_bf16(ff[mt & 1][ks], xf[ks], acc, 0, 0, 0);
                  const float y0 = acc[0] + dv[0] * bflo(uu[mt].x), y1 = acc[1] + dv[1] * bfhi(uu[mt].x), y2 = acc[2] + dv[2] * bflo(uu[mt].y), y3 = acc[3] + dv[3] * bfhi(uu[mt].y);
                  u32x2 o; o.x = pk2(gelu_tanh(y0), gelu_tanh(y1)); o.y = pk2(gelu_tanh(y2), gelu_tanh(y3));
                  *(GAS u32x2*)((unsigned char*)(ypre + (size_t)(8 * (128 * ib + 16 * w) + mt) * S5W + 16 * g) + lyo) = o;
                  SB(); } }
        }
    }
}
constexpr int NPH = 12, NSTEPS = 1 + DEPTH * NPH + 1;
#ifndef MK_PER_STEP
#define MK_PER_STEP 0
#endif
__global__ void __launch_bounds__(512, 2) trunk_fwd(Args args_unused) {
    extern __shared__ __attribute__((aligned(16))) unsigned char lds_raw[];
    LAS unsigned char* const lds = (LAS unsigned char*)lds_raw;
    volatile LAS unsigned* MISC = (volatile LAS unsigned*)(lds + MISC_OFF);
    for (int u = threadIdx.x; u < 128; u += 512) MISC[u] = 0u;
    int wv = __builtin_amdgcn_readfirstlane(threadIdx.x >> 6); asm volatile("" : "+s"(wv));
    __syncthreads();
    const CAS Args* ap0 = (const CAS Args*)__builtin_amdgcn_kernarg_segment_ptr();
    const int lo = ap0->lo, hi = ap0->hi;
    XcdBarrier bar; bar.bar = (unsigned*)(ap0->ws + WS_CTL) + CW_BAR; bar.x = 0; bar.st = MISC + 8; bar.w0 = (wv == 0);
    if ((hi - lo) > 1) bar = xcd_barrier_post(bar.bar, MISC + 8, wv == 0);
#ifndef ONLY_PH
#define ONLY_PH 0xFFFF
#endif
#define PHEN(ph) ((ONLY_PH >> (ph)) & 1)
#define IN(k) (lo <= (k) && (k) < hi)
#define SEAM(k) do { if (IN((k) + 1) && IN(k)) xcd_barrier(bar); } while (0)
#define FRAME() const CAS Args* ap; const Frame F = make_frame(lds, ap, wv); const CAS Args& A = *ap; (void)A
#ifndef REPEAT_MASK
#define REPEAT_MASK 0
#endif
#define REP(ph) ((REPEAT_MASK >> (ph)) & 1)
#ifndef REP2_MASK
#define REP2_MASK 0
#endif
#define REP2(k) ((REP2_MASK >> (k)) & 1)

    if (PHEN(12) && IN(0)) { { FRAME(); float* prm = (float*)(F.ws + WS_PRM);
            for (int e = F.bid * 512 + F.tid; e < DEPTH * RH * 576; e += F.G * 512) { const int i = e & 63, pi = (e >> 6) % 9, lh = e / 576, hh = lh % RH, ll = lh / RH; float val;
                if (pi < 3) val = A.in[14][(size_t)ll * RWCOLS + (pi == 0 ? ZC_R : (pi == 1 ? ZC_K : ZC_V)) - ZC_R + hh * 64 + i];
                else if (pi == 3) val = A.in[16][(size_t)ll * RW + hh * 64 + i]; else if (pi == 4) val = A.in[18][(size_t)ll * RW + hh * 64 + i]; else if (pi == 5) val = A.in[20][(size_t)ll * RW + hh * 64 + i];
                else if (pi == 6) val = A.in[21][(size_t)ll * RW + hh * 64 + i]; else if (pi == 7) val = A.in[22][(size_t)ll * RW + hh * 64 + i];
                else val = (ll > 0) ? A.in[28][(size_t)(ll - 1) * RW + hh * 64 + i] : 0.f;
                prm[e] = val; } }
        { FRAME(); p0_prologue(F, A); __syncthreads(); } { FRAME(); for (int it = F.bid; it < DEPTH * S5G; it += F.G) s5_tables(F, A, it / S5G, it % S5G); } SEAM(0); }

    for (int l = 0; l < DEPTH; ++l) {
        const int s0 = 1 + l * NPH;
        if (REP(0) && PHEN(0) && IN(s0 + 0)) { if (l == 0) { FRAME(); x0_phase(F, A.in[0], (bf16*)F.out, (float*)(F.ws + WS_SSQ)); xcd_barrier(bar); } }
        if (PHEN(0) && IN(s0 + 0)) { if (l == 0) { FRAME(); x0_phase(F, A.in[0], (bf16*)F.out, (float*)(F.ws + WS_SSQ)); SEAM(s0 + 0); } }
        if (REP(1) && PHEN(1) && IN(s0 + 1)) { FRAME();
            const int nN = (l == 0) ? 44 : 45;
            const LAS float* rs = rstd_table(F);
            SchedPlain S; S.init((const bf16*)F.out, XP, (const bf16*)lw(F, l, LW_WIN), D, M / BM, nN, D, F.G, F.bid);
            EpiInproj E{(bf16*)(F.ws + WS_R2), A.in[3] + (size_t)l * 6144, (bf16*)(F.ws + WS_ZS5), rs};
            gemm_phase<EpiInproj, SchedPlain>(F.lds, F.wave, XP, D, S, E);
            xcd_barrier(bar);
        }
        if (PHEN(1) && IN(s0 + 1)) { FRAME();
            const int nN = (l == 0) ? 44 : 45;
            const LAS float* rs = rstd_table(F);
            SchedPlain S; S.init((const bf16*)F.out, XP, (const bf16*)lw(F, l, LW_WIN), D, M / BM, nN, D, F.G, F.bid);
            EpiInproj E{(bf16*)(F.ws + WS_R2), A.in[3] + (size_t)l * 6144, (bf16*)(F.ws + WS_ZS5), rs};
            gemm_phase<EpiInproj, SchedPlain>(F.lds, F.wave, XP, D, S, E);
            SEAM(s0 + 1);
        }
        if (REP(2) && PHEN(2) && IN(s0 + 2)) { FRAME(); rwkv_fused_phase(F, A, l); gla_pre_phase(F, A, l); s5_phase<false>(F, A, l, F.bid, F.G); xcd_barrier(bar); }
        if (PHEN(2) && IN(s0 + 2)) { FRAME(); if (REP2(0)) rwkv_fused_phase(F, A, l); rwkv_fused_phase(F, A, l); if (REP2(1)) gla_pre_phase(F, A, l); gla_pre_phase(F, A, l); if (REP2(2)) s5_phase<false>(F, A, l, F.bid, F.G); s5_phase<false>(F, A, l, F.bid, F.G); SEAM(s0 + 2); }
        if (REP(4) && PHEN(4) && IN(s0 + 4)) { FRAME();
            if (F.bid < 40) rwkv_scan_phase(F, F.bid >> 2, F.bid & 3);
            else if (F.bid < 60) gla_scan_wave(F, (F.bid - 40) * 8 + F.wave);
            else s5_phase<true>(F, A, l, F.bid - 60, F.G - 60);
            xcd_barrier(bar);
        }
        if (PHEN(4) && IN(s0 + 4)) { FRAME();
            if (F.bid < 40) { if (REP2(3)) rwkv_scan_phase(F, F.bid >> 2, F.bid & 3); rwkv_scan_phase(F, F.bid >> 2, F.bid & 3); }
            else if (F.bid < 60) { if (REP2(4)) gla_scan_wave(F, (F.bid - 40) * 8 + F.wave); gla_scan_wave(F, (F.bid - 40) * 8 + F.wave); }
            else { if (REP2(5)) s5_phase<true>(F, A, l, F.bid - 60, F.G - 60); s5_phase<true>(F, A, l, F.bid - 60, F.G - 60); }
            SEAM(s0 + 4);
        }
        if (REP(5) && PHEN(5) && IN(s0 + 5)) { FRAME(); gla_post_phase(F, A, l); rwkv_post_phase(F, A, l); xcd_barrier(bar); }
        if (PHEN(5) && IN(s0 + 5)) { FRAME(); if (REP2(7)) gla_post_phase(F, A, l); gla_post_phase(F, A, l); if (REP2(6)) rwkv_post_phase(F, A, l); rwkv_post_phase(F, A, l); SEAM(s0 + 5); }
        if (REP(6) && PHEN(6) && IN(s0 + 6)) { FRAME();
            const bf16* ypre = (const bf16*)(F.ws + WS_R1 + (size_t)M * RW * 4);
            SchedPlain S; S.init(ypre, S5W, (const bf16*)lw(F, l, LW_GLU), S5W, M / BM, 3, S5W, F.G, F.bid);
            EpiGlu E{ypre, (bf16*)(F.ws + WS_R3), A.in[13] + (size_t)l * S5W};
            gemm_phase<EpiGlu, SchedPlain>(F.lds, F.wave, S5W, S5W, S, E);
            xcd_barrier(bar);
        }
        if (PHEN(6) && IN(s0 + 6)) { FRAME();
            const bf16* ypre = (const bf16*)(F.ws + WS_R1 + (size_t)M * RW * 4);
            SchedPlain S; S.init(ypre, S5W, (const bf16*)lw(F, l, LW_GLU), S5W, M / BM, 3, S5W, F.G, F.bid);
            EpiGlu E{ypre, (bf16*)(F.ws + WS_R3), A.in[13] + (size_t)l * S5W};
            gemm_phase<EpiGlu, SchedPlain>(F.lds, F.wave, S5W, S5W, S, E);
            SEAM(s0 + 6);
        }
        if (REP(7) && PHEN(7) && IN(s0 + 7)) { FRAME();
            SchedSeg3 S; S.init((const bf16*)(F.ws + WS_R3), D, (const bf16*)lw(F, l, LW_WUP), D, M / BM, D / BM, F.G, F.bid);
            EpiMerged E{(const bf16*)(F.ws + WS_R2), (bf16*)(F.ws + WS_R1)};
            gemm_phase<EpiMerged, SchedSeg3>(F.lds, F.wave, D, D, S, E);
            xcd_barrier(bar);
        }
        if (PHEN(7) && IN(s0 + 7)) { FRAME();
            SchedSeg3 S; S.init((const bf16*)(F.ws + WS_R3), D, (const bf16*)lw(F, l, LW_WUP), D, M / BM, D / BM, F.G, F.bid);
            EpiMerged E{(const bf16*)(F.ws + WS_R2), (bf16*)(F.ws + WS_R1)};
            gemm_phase<EpiMerged, SchedSeg3>(F.lds, F.wave, D, D, S, E);
            SEAM(s0 + 7);
        }
        if (REP(8) && PHEN(8) && IN(s0 + 8)) { FRAME();
            SchedPlain S; S.init((const bf16*)(F.ws + WS_R1), D, (const bf16*)lw(F, l, LW_WOUT), D, M / BM, D / BM, D, F.G, F.bid);
            EpiResid E{(const bf16*)F.out, (bf16*)F.out, (float*)(F.ws + WS_SSQ)};
            gemm_phase<EpiResid, SchedPlain>(F.lds, F.wave, D, D, S, E);
            xcd_barrier(bar);
        }
        if (PHEN(8) && IN(s0 + 8)) { FRAME();
            SchedPlain S; S.init((const bf16*)(F.ws + WS_R1), D, (const bf16*)lw(F, l, LW_WOUT), D, M / BM, D / BM, D, F.G, F.bid);
            EpiResid E{(const bf16*)F.out, (bf16*)F.out, (float*)(F.ws + WS_SSQ)};
            gemm_phase<EpiResid, SchedPlain>(F.lds, F.wave, D, D, S, E);
            SEAM(s0 + 8);
        }
        if (REP(10) && PHEN(10) && IN(s0 + 10)) { FRAME();
            const LAS float* rs = rstd_table(F);
            SchedPlain S; S.init((const bf16*)F.out, XP, (const bf16*)lw(F, l, LW_W1), D, M / BM, DFF / BM, D, F.G, F.bid);
            EpiRelu2 E{(bf16*)(F.ws + WS_R2), rs};
            gemm_phase<EpiRelu2, SchedPlain>(F.lds, F.wave, XP, D, S, E);
            xcd_barrier(bar);
        }
        if (PHEN(10) && IN(s0 + 10)) { FRAME();
            const LAS float* rs = rstd_table(F);
            SchedPlain S; S.init((const bf16*)F.out, XP, (const bf16*)lw(F, l, LW_W1), D, M / BM, DFF / BM, D, F.G, F.bid);
            EpiRelu2 E{(bf16*)(F.ws + WS_R2), rs};
            gemm_phase<EpiRelu2, SchedPlain>(F.lds, F.wave, XP, D, S, E);
            SEAM(s0 + 10);
        }
        if (REP(11) && PHEN(11) && IN(s0 + 11)) { FRAME();
            SchedPlain S; S.init((const bf16*)(F.ws + WS_R2), DFF, (const bf16*)lw(F, l, LW_W2), DFF, M / BM, D / BM, DFF, F.G, F.bid);
            EpiResid E{(const bf16*)F.out, (l == DEPTH - 1) ? (bf16*)(F.ws + WS_R1) : (bf16*)F.out, (float*)(F.ws + WS_SSQ)};
            gemm_phase<EpiResid, SchedPlain>(F.lds, F.wave, DFF, DFF, S, E);
            xcd_barrier(bar);
        }
        if (PHEN(11) && IN(s0 + 11)) { FRAME();
            SchedPlain S; S.init((const bf16*)(F.ws + WS_R2), DFF, (const bf16*)lw(F, l, LW_W2), DFF, M / BM, D / BM, DFF, F.G, F.bid);
            EpiResid E{(const bf16*)F.out, (l == DEPTH - 1) ? (bf16*)(F.ws + WS_R1) : (bf16*)F.out, (float*)(F.ws + WS_SSQ)};
            gemm_phase<EpiResid, SchedPlain>(F.lds, F.wave, DFF, DFF, S, E);
            SEAM(s0 + 11);
        }
    }
    if (PHEN(13) && IN(NSTEPS - 1)) { FRAME(); rmsnorm_phase<true, true>(F, F.ws + WS_R1, A.in[37], F.out); }
#undef IN
#undef SEAM
}

extern "C" void kernel_launch(void* const* d_in, const int* in_sizes, int n_in, void* d_out, int out_size, void* d_ws, size_t ws_size, hipStream_t stream) {
    static int grid = 0;
    if (grid == 0) {
        if (n_in != 38 || out_size != M * D || ws_size < WS_END) { fprintf(stderr, "kernel_launch: unexpected shapes (n_in %d, out %d, ws %zu < %zu)\n", n_in, out_size, ws_size, (size_t)WS_END); grid = -1; return; }
        int dev = 0, cus = 0, per_cu = 0;
        if (hipGetDevice(&dev) != hipSuccess || hipDeviceGetAttribute(&cus, hipDeviceAttributeMultiprocessorCount, dev) != hipSuccess) { grid = -1; return; }
        if (hipFuncSetAttribute((const void*)trunk_fwd, hipFuncAttributeMaxDynamicSharedMemorySize, LDS_BYTES) != hipSuccess) { fprintf(stderr, "kernel_launch: hipFuncSetAttribute failed\n"); grid = -1; return; }
        if (hipOccupancyMaxActiveBlocksPerMultiprocessor(&per_cu, (const void*)trunk_fwd, 512, LDS_BYTES) != hipSuccess || per_cu < 1) { fprintf(stderr, "kernel_launch: occupancy query says %d\n", per_cu); }
        (void)hipGetLastError();
        grid = (cus / 8) * 8;
        if (grid < 64) { fprintf(stderr, "kernel_launch: %d CUs\n", cus); grid = -1; return; }
    }
    if (grid < 0) return;
    if (hipMemsetAsync((char*)d_ws + WS_CTL, 0, CTL_ZERO_BYTES, stream) != hipSuccess) return;
    Args a{};
    for (int i = 0; i < 38; ++i) a.in[i] = (const float*)d_in[i];
    a.out = (float*)d_out; a.ws = (unsigned char*)d_ws;
#if MK_PER_STEP
    for (int s = 0; s < NSTEPS; ++s) { a.lo = s; a.hi = s + 1; hipLaunchKernelGGL(trunk_fwd, dim3(grid), dim3(512), LDS_BYTES, stream, a); }
#else
    a.lo = 0; a.hi = NSTEPS;
    hipLaunchKernelGGL(trunk_fwd, dim3(grid), dim3(512), LDS_BYTES, stream, a);
#endif
}
```

```cpp
#include <hip/hip_runtime.h>
#include <cstdio>
#include <cstdint>

#define GAS __attribute__((address_space(1)))
#define LAS __attribute__((address_space(3)))
typedef unsigned short bf16;
typedef short bf16x8 __attribute__((ext_vector_type(8)));
typedef float f32x4 __attribute__((ext_vector_type(4)));
typedef float f32x2 __attribute__((ext_vector_type(2)));
typedef unsigned u32x4 __attribute__((ext_vector_type(4)));
typedef unsigned u32x2 __attribute__((ext_vector_type(2)));
typedef __bf16 bf16x2_t __attribute__((ext_vector_type(2)));
#define DI __device__ __forceinline__

constexpr int M = 16384, D = 2048, DEPTH = 4, DFF = 8192;
constexpr int S5W = 768, S5G = 48, S5P = 64;
constexpr int RW = 640, RH = 10, RN = 64, RWCOLS = 2400;
constexpr int GV = 640, GH = 5, GK = 320, GDK = 64, GDV = 128;
constexpr int INCOLS = 11248, ZP = 11520;
constexpr int ZC_R = 768, ZC_K = 1408, ZC_V = 2048, ZC_WIN = 2688, ZC_AIN = 2784, ZC_GIN = 2912;
constexpr int ZC_GQ = 3168, ZC_GKK = 3488, ZC_GV = 3808, ZC_GG = 4448, ZC_GA = 5088, ZC_GATE = 5104, ZC_VRES = 11248;
constexpr float NORM_EPS = 1e-6f;

DI unsigned pk2(float lo, float hi) { f32x2 v = {lo, hi}; bf16x2_t r = __builtin_convertvector(v, bf16x2_t); return __builtin_bit_cast(unsigned, r); }
DI float bflo(unsigned u) { return __builtin_bit_cast(float, u << 16); }
DI float bfhi(unsigned u) { return __builtin_bit_cast(float, u & 0xffff0000u); }
DI float bf2f(bf16 b) { return __builtin_bit_cast(float, ((unsigned)b) << 16); }
DI void unpack8(const u32x4 v, float (&f)[8]) { f[0] = bflo(v.x); f[1] = bfhi(v.x); f[2] = bflo(v.y); f[3] = bfhi(v.y); f[4] = bflo(v.z); f[5] = bfhi(v.z); f[6] = bflo(v.w); f[7] = bfhi(v.w); }
DI u32x4 pack8(const float (&f)[8]) { u32x4 o; o.x = pk2(f[0], f[1]); o.y = pk2(f[2], f[3]); o.z = pk2(f[4], f[5]); o.w = pk2(f[6], f[7]); return o; }
DI float sigmoidf_(float x) { return __builtin_amdgcn_rcpf(1.f + __expf(-x)); }
DI float softplusf_(float x) { return fmaxf(x, 0.f) + __logf(1.f + __expf(-fabsf(x))); }
DI float wave_sum(float v) {
    v += __builtin_bit_cast(float, __builtin_amdgcn_update_dpp(0, __builtin_bit_cast(int, v), 0xB1, 0xF, 0xF, true));
    v += __builtin_bit_cast(float, __builtin_amdgcn_update_dpp(0, __builtin_bit_cast(int, v), 0x4E, 0xF, 0xF, true));
    v += __builtin_bit_cast(float, __builtin_amdgcn_update_dpp(0, __builtin_bit_cast(int, v), 0x141, 0xF, 0xF, true));
    v += __builtin_bit_cast(float, __builtin_amdgcn_update_dpp(0, __builtin_bit_cast(int, v), 0x140, 0xF, 0xF, true));
    const int iv = __builtin_bit_cast(int, v);
    const float a0 = __builtin_bit_cast(float, __builtin_amdgcn_readlane(iv, 0)), a1 = __builtin_bit_cast(float, __builtin_amdgcn_readlane(iv, 16)),
                a2 = __builtin_bit_cast(float, __builtin_amdgcn_readlane(iv, 32)), a3 = __builtin_bit_cast(float, __builtin_amdgcn_readlane(iv, 48));
    return (a0 + a1) + (a2 + a3);
}
DI float sum8(float v) { v += __builtin_bit_cast(float, __builtin_amdgcn_update_dpp(0, __builtin_bit_cast(int, v), 0xB1, 0xF, 0xF, true));
                         v += __builtin_bit_cast(float, __builtin_amdgcn_update_dpp(0, __builtin_bit_cast(int, v), 0x4E, 0xF, 0xF, true));
                         v += __builtin_bit_cast(float, __builtin_amdgcn_update_dpp(0, __builtin_bit_cast(int, v), 0x141, 0xF, 0xF, true)); return v; }
#define LDS_WAIT() asm volatile("s_waitcnt lgkmcnt(0)" ::: "memory")
#define VM_WAIT() asm volatile("s_waitcnt vmcnt(0)" ::: "memory")

DI int lane_id_fresh() { int l; asm volatile("v_mbcnt_lo_u32_b32 %0, -1, 0\n\tv_mbcnt_hi_u32_b32 %0, -1, %0" : "=v"(l)); return l; }
#define XB_TMO      128
#define XB_XCNT(j)  (256  + 64 * (j))
#define XB_XSUB(j)  (1280 + 64 * (j))
#define XB_XGEN(j)  (2304 + 64 * (j))
#define XB_TOP      3328
#define XB_TOPGEN   3392
#define XCD_BAR_WORDS 3456
#define XB_SPIN_CAP (1u << 20)
__device__ __forceinline__ unsigned xb_ld(unsigned* p)              { return __hip_atomic_load(p, __ATOMIC_RELAXED, __HIP_MEMORY_SCOPE_AGENT); }
__device__ __forceinline__ unsigned xb_add(unsigned* p, unsigned v) { return __hip_atomic_fetch_add(p, v, __ATOMIC_RELAXED, __HIP_MEMORY_SCOPE_AGENT); }
__device__ __forceinline__ unsigned xb_xcc_id() { return (unsigned)__builtin_amdgcn_s_getreg((3 << 11) | 20) & 0xFu; }
#define XB_SPIN(cond, bar) do { unsigned _sp = 0; while (cond) { __builtin_amdgcn_s_sleep(1); \
    if ((++_sp & 255u) == 0u) { if (xb_ld(&(bar)[XB_TMO])) break; if (_sp > XB_SPIN_CAP) { atomicAdd(&(bar)[XB_TMO], 1u); break; } } } } while (0)
struct XcdBarrier { unsigned* bar; unsigned x; volatile LAS unsigned* st; unsigned w0; };
__device__ __forceinline__ XcdBarrier xcd_barrier_post(unsigned* bar, volatile LAS unsigned* st, unsigned w0) {
    XcdBarrier b; b.bar = bar; b.x = xb_xcc_id(); b.st = st; b.w0 = w0;
    if (w0 && lane_id_fresh() == 0) (void)xb_add(&bar[XB_XCNT(b.x)], 1u);
    return b;
}
__device__ __forceinline__ void xcd_barrier_complete(unsigned* bar, unsigned x, unsigned& nloc, unsigned& nx) {
    const unsigned G = gridDim.x * gridDim.y * gridDim.z;
    unsigned sum, cnt, mine, sp = 0u;
    for (;;) {
        sum = 0u; cnt = 0u; mine = 0u;
#pragma unroll
        for (unsigned j = 0; j < 16; ++j) { const unsigned c = xb_ld(&bar[XB_XCNT(j)]); sum += c; cnt += (c > 0u) ? 1u : 0u; mine = (j == x) ? c : mine; }
        if (sum == G) break;
        __builtin_amdgcn_s_sleep(1);
        if ((++sp & 255u) == 0u) { if (xb_ld(&bar[XB_TMO])) break; if (sp > XB_SPIN_CAP) { atomicAdd(&bar[XB_TMO], 1u); break; } }
    }
    nloc = mine > 0u ? mine : 1u; nx = cnt > 0u ? cnt : 1u;
}
__device__ __forceinline__ void xcd_barrier(const XcdBarrier& b) {
    asm volatile("s_waitcnt vmcnt(0)" ::: "memory");
    __syncthreads();
    if (b.w0 && lane_id_fresh() == 0) {
        unsigned* bar = b.bar;
        __builtin_amdgcn_s_waitcnt(0);
        unsigned nloc = b.st[0], nx = b.st[1];
        if (nloc == 0u) { xcd_barrier_complete(bar, b.x, nloc, nx); b.st[0] = nloc; b.st[1] = nx; }
        const unsigned old = xb_add(&bar[XB_XSUB(b.x)], 1u);
        const unsigned gen = old / nloc;
        if (old + 1u == (gen + 1u) * nloc) {
            __builtin_amdgcn_fence(__ATOMIC_RELEASE, "agent");
            asm volatile("s_waitcnt vmcnt(0)" ::: "memory");
            const unsigned og = xb_add(&bar[XB_TOP], 1u);
            const unsigned tg = og / nx;
            if (og + 1u == (tg + 1u) * nx) xb_add(&bar[XB_TOPGEN], 1u);
            else XB_SPIN(xb_ld(&bar[XB_TOPGEN]) == tg, bar);
            __builtin_amdgcn_fence(__ATOMIC_ACQUIRE, "agent");
            xb_add(&bar[XB_XGEN(b.x)], 1u);
            asm volatile("s_waitcnt vmcnt(0)" ::: "memory");
        } else {
            XB_SPIN(xb_ld(&bar[XB_XGEN(b.x)]) == gen, bar);
            __builtin_amdgcn_fence(__ATOMIC_ACQUIRE, "agent");
            asm volatile("s_waitcnt vmcnt(0)" ::: "memory");
        }
    }
    __syncthreads();
}
constexpr int BM = 256, BK = 64, HALF = 128, HTB = HALF * BK * 2, STAGE_BYTES = 8 * HTB;
DI int lds_byte(int r, int c) { const int st = (r >> 4) * 2 + (c >> 5), rr = r & 15, cc = c & 31, ob = rr * 64 + cc * 2; return st * 1024 + (ob ^ (((ob >> 9) & 1) << 5)); }
DI void stage_rc(int b, int& R, int& C) { const int st = b / 1024, sb = b % 1024, swz = sb ^ (((sb >> 9) & 1) << 5); R = (st >> 1) * 16 + swz / 64; C = (st & 1) * 32 + (swz % 64) / 2; }
DI int perm32(int rho) { const int n = rho >> 4, i = rho & 15; return 8 * (i >> 2) + 4 * n + (i & 3); }
struct Unit { int pm, pn, seg; };
struct TileOrder {
    int nM, nN, nwg;
    DI void init(int nM_, int nN_) { nM = nM_; nN = nN_; nwg = nM_ * nN_; }
    DI void map(int L, int& pm, int& pn) const {
        int wgid = L; { const int q = nwg / 8, r = nwg % 8, xcd = wgid % 8, off = wgid / 8; wgid = (xcd < r ? xcd * (q + 1) : r * (q + 1) + (xcd - r) * q) + off; }
        const int nig = 8 * nN, gid = wgid / nig, fm = gid * 8, gsz = (nM - fm) < 8 ? (nM - fm) : 8;
        pm = fm + ((wgid % nig) % gsz); pn = (wgid % nig) / gsz;
    }
};
struct SchedPlain {
    TileOrder T; int G, c, nt; const char* A; const char* B; size_t ta, tb;
    DI void init(const bf16* A_, int lda, const bf16* B_, int ldb, int nM, int nN, int K, int G_, int c_) { T.init(nM, nN); G = G_; c = c_; nt = K / BK; A = (const char*)A_; B = (const char*)B_; ta = (size_t)BM * lda * 2; tb = (size_t)BM * ldb * 2; }
    DI bool next(int i, Unit& u) const { const long L = (long)i * G + c; if (L >= T.nwg) return false; T.map((int)L, u.pm, u.pn); u.seg = 0; return true; }
    DI const char* aptr(const Unit& u) const { return A + (size_t)u.pm * ta; }
    DI const char* bptr(const Unit& u) const { return B + (size_t)u.pn * tb; }
    DI int ntiles(const Unit&) const { return nt; }
};
struct SchedSeg3 {
    TileOrder T; int G, c; const char* A; const char* B; size_t ta, tb;
    DI void init(const bf16* A_, int lda, const bf16* B_, int ldb, int nM, int nN, int G_, int c_) { T.init(nM, nN); G = G_; c = c_; A = (const char*)A_; B = (const char*)B_; ta = (size_t)BM * lda * 2; tb = (size_t)BM * ldb * 2; }
    DI bool next(int i, Unit& u) const { const int ti = i / 3; const long L = (long)ti * G + c; if (L >= T.nwg) return false; T.map((int)L, u.pm, u.pn); u.seg = i - 3 * ti; return true; }
    DI int kofs(int seg) const { return seg == 0 ? 0 : (seg == 1 ? 768 : 1408); }
    DI const char* aptr(const Unit& u) const { return A + (size_t)u.pm * ta + (size_t)kofs(u.seg) * 2; }
    DI const char* bptr(const Unit& u) const { return B + (size_t)u.pn * tb + (size_t)kofs(u.seg) * 2; }
    DI int ntiles(const Unit& u) const { return u.seg == 0 ? 12 : 10; }
};

template <class Epi, class Sched>
DI void gemm_phase(LAS unsigned char* lds, const int wv, const int lda, const int ldb, const Sched& S, const Epi& E) {
    int tid_ = wv * 64 + lane_id_fresh(); asm volatile("" : "+v"(tid_));
    const int tid = tid_, wid = __builtin_amdgcn_readfirstlane(tid >> 6), lane = tid & 63, wr = wid >> 2, wc = wid & 3, fr = lane & 15, fq = lane >> 4;
    unsigned voffA[2], voffB[2];
#pragma unroll
    for (int i = 0; i < 2; ++i) { int R, C; stage_rc(tid * 16 + i * 8192, R, C); const int Rb = Epi::PERM ? ((R & ~31) + perm32(R & 31)) : R;
        voffA[i] = (unsigned)(R * lda + C) * 2u; voffB[i] = (unsigned)(Rb * ldb + C) * 2u; }
    const size_t kstep = (size_t)(BK * 2);
    const size_t hstepA = (size_t)HALF * lda * 2, hstepB = (size_t)HALF * ldb * 2;
    const unsigned ldsw = (unsigned)wid * 1024u;
    const int aoff = lds_byte(wr * 64 + fr, fq * 8), boff = lds_byte(wc * 32 + fr, fq * 8);
#define PG8_SA(b, h) (((b) * 2 + (h)) * HTB)
#define PG8_SB(b, h) ((4 + (b) * 2 + (h)) * HTB)
#define PG8_STAGE(bufoff, gbase, voff) do { _Pragma("unroll") for (int _i = 0; _i < 2; ++_i) \
        __builtin_amdgcn_global_load_lds((const unsigned*)((const char*)(gbase) + (voff)[_i]), (LAS unsigned*)(lds + (bufoff) + ldsw + _i * 8192), 16, 0, 0); } while (0)
#define PG8_LDA(dst, b, h) do { _Pragma("unroll") for (int m = 0; m < 4; ++m) _Pragma("unroll") for (int k = 0; k < 2; ++k) dst[m][k] = *(const LAS bf16x8*)(lds + PG8_SA(b, h) + aoff + m * 2048 + k * 1024); } while (0)
#define PG8_LDB(dst, b, h) do { _Pragma("unroll") for (int n = 0; n < 2; ++n) _Pragma("unroll") for (int k = 0; k < 2; ++k) dst[n][k] = *(const LAS bf16x8*)(lds + PG8_SB(b, h) + boff + n * 2048 + k * 1024); } while (0)
#define PG8_MMA(ai, bj, At, Bt) do { __builtin_amdgcn_s_setprio(1); _Pragma("unroll") for (int m = 0; m < 4; ++m) _Pragma("unroll") for (int n = 0; n < 2; ++n) _Pragma("unroll") for (int k = 0; k < 2; ++k) \
        acc[ai][bj][m][n] = __builtin_amdgcn_mfma_f32_16x16x32_bf16(Bt[n][k], At[m][k], acc[ai][bj][m][n], 0, 0, 0); __builtin_amdgcn_s_setprio(0); } while (0)
#define PG8_WAIT_V(n) asm volatile("s_waitcnt vmcnt(" #n ")" ::: "memory")
#define PG8_WAIT_L(n) asm volatile("s_waitcnt lgkmcnt(" #n ")" ::: "memory")
#define PG8_BAR __builtin_amdgcn_s_barrier()
#define PG8_SCHED __builtin_amdgcn_sched_barrier(0)
    Unit cur, nxt; int ui = 0;
    if (!S.next(0, cur)) return;
    f32x4 acc[2][2][4][2];
#pragma unroll
    for (int a = 0; a < 2; ++a)
#pragma unroll
        for (int b = 0; b < 2; ++b)
#pragma unroll
            for (int m = 0; m < 4; ++m)
#pragma unroll
                for (int n = 0; n < 2; ++n) acc[a][b][m][n] = (f32x4){0.f, 0.f, 0.f, 0.f};
    bf16x8 At[4][2], B0[2][2], B1[2][2];
    const char* cA = S.aptr(cur); const char* cB = S.bptr(cur); int nt = S.ntiles(cur);
    PG8_STAGE(PG8_SB(0, 0), cB, voffB); PG8_STAGE(PG8_SB(0, 1), cB + hstepB, voffB); PG8_STAGE(PG8_SA(0, 0), cA, voffA); PG8_STAGE(PG8_SA(0, 1), cA + hstepA, voffA);
    if (wr == 1) PG8_BAR;
    PG8_WAIT_V(2); PG8_BAR;
    PG8_STAGE(PG8_SB(1, 0), cB + kstep, voffB); PG8_STAGE(PG8_SA(1, 0), cA + kstep, voffA); PG8_STAGE(PG8_SB(1, 1), cB + hstepB + kstep, voffB);
    PG8_WAIT_V(6); PG8_BAR;
    for (;;) {
        const bool has_next = S.next(ui + 1, nxt);
        const char* nA = has_next ? S.aptr(nxt) : cA; const char* nB = has_next ? S.bptr(nxt) : cB;
        for (int t = 0; t < nt; t += 2) {
            const bool last = (t == nt - 2);
            const char* a1 = cA + (size_t)(t + 1) * kstep;
            const char* a2 = last ? nA : cA + (size_t)(t + 2) * kstep; const char* b2 = last ? nB : cB + (size_t)(t + 2) * kstep;
            const char* a3 = a2 + kstep; const char* b3 = b2 + kstep;
            PG8_LDB(B0, 0, 0); PG8_LDB(B1, 0, 1); PG8_SCHED; PG8_LDA(At, 0, 0); PG8_STAGE(PG8_SA(1, 1), a1 + hstepA, voffA);
            PG8_WAIT_V(8); PG8_WAIT_L(0); PG8_BAR; PG8_MMA(0, 0, At, B0); PG8_MMA(0, 1, At, B1); PG8_BAR; PG8_SCHED;
            PG8_LDA(At, 0, 1); PG8_STAGE(PG8_SB(0, 0), b2, voffB); PG8_STAGE(PG8_SB(0, 1), b2 + hstepB, voffB); PG8_STAGE(PG8_SA(0, 0), a2, voffA);
            PG8_WAIT_V(8); PG8_WAIT_L(0); PG8_BAR; PG8_MMA(1, 0, At, B0); PG8_MMA(1, 1, At, B1); PG8_BAR; PG8_SCHED;
            PG8_LDB(B0, 1, 0); PG8_LDB(B1, 1, 1); PG8_SCHED; PG8_LDA(At, 1, 0); PG8_STAGE(PG8_SA(0, 1), a2 + hstepA, voffA);
            PG8_WAIT_V(8); PG8_WAIT_L(0); PG8_BAR; PG8_MMA(0, 0, At, B0); PG8_MMA(0, 1, At, B1); PG8_BAR; PG8_SCHED;
            PG8_LDA(At, 1, 1); PG8_STAGE(PG8_SB(1, 0), b3, voffB); PG8_STAGE(PG8_SB(1, 1), b3 + hstepB, voffB); PG8_STAGE(PG8_SA(1, 0), a3, voffA);
            PG8_WAIT_V(8); PG8_WAIT_L(0); PG8_BAR; PG8_MMA(1, 0, At, B0); PG8_MMA(1, 1, At, B1); PG8_BAR; PG8_SCHED;
        }
        if (wr == 0) PG8_BAR;
        const bool clr = E(acc, cur, wr, wc, fr, fq);
        if (!has_next) break;
        if (clr) {
#pragma unroll
            for (int a = 0; a < 2; ++a)
#pragma unroll
                for (int b = 0; b < 2; ++b)
#pragma unroll
                    for (int m = 0; m < 4; ++m)
#pragma unroll
                        for (int n = 0; n < 2; ++n) acc[a][b][m][n] = (f32x4){0.f, 0.f, 0.f, 0.f};
        }
        cur = nxt; cA = nA; cB = nB; nt = S.ntiles(cur); ++ui;
        if (wr == 1) PG8_BAR;
    }
    PG8_WAIT_V(0);
    PG8_BAR;
#undef PG8_SA
#undef PG8_SB
#undef PG8_STAGE
#undef PG8_LDA
#undef PG8_LDB
#undef PG8_MMA
#undef PG8_WAIT_V
#undef PG8_WAIT_L
#undef PG8_BAR
#undef PG8_SCHED
}

typedef f32x4 AccT[2][2][4][2];
struct EpiInproj {
    static constexpr bool PERM = true;
    bf16* Z; const float* gbias; bf16* ZS5; const LAS float* rs;
    DI bool operator()(AccT& acc, const Unit& u, int wr, int wc, int fr, int fq) const {
        const int row0 = u.pm * BM + wr * 64 + fr, col0 = u.pn * BM + wc * 32 + 8 * fq;
        float rsv[2][4];
#pragma unroll
        for (int ai = 0; ai < 2; ++ai)
#pragma unroll
            for (int m = 0; m < 4; ++m) rsv[ai][m] = rs[row0 + ai * HALF + m * 16];
#pragma unroll
        for (int bj = 0; bj < 2; ++bj) {
            const int col = col0 + bj * HALF; const bool gate = (col >= ZC_GATE) && (col < ZC_VRES); const bool s5c = col < S5W;
            f32x4 b0 = {0.f, 0.f, 0.f, 0.f}, b1 = b0;
            if (gate) { b0 = *(const GAS f32x4*)(gbias + (col - ZC_GATE)); b1 = *(const GAS f32x4*)(gbias + (col - ZC_GATE) + 4); }
#pragma unroll
            for (int ai = 0; ai < 2; ++ai)
#pragma unroll
                for (int m = 0; m < 4; ++m) {
                    f32x4 v0 = acc[ai][bj][m][0] * rsv[ai][m], v1 = acc[ai][bj][m][1] * rsv[ai][m];
                    if (gate) { v0 += b0; v1 += b1;
#pragma unroll
                        for (int e = 0; e < 4; ++e) { v0[e] = sigmoidf_(v0[e]); v1[e] = sigmoidf_(v1[e]); } }
                    u32x4 w; w.x = pk2(v0[0], v0[1]); w.y = pk2(v0[2], v0[3]); w.z = pk2(v1[0], v1[1]); w.w = pk2(v1[2], v1[3]);
                    if (s5c) *(GAS u32x4*)(ZS5 + ((size_t)(col >> 4) * M + (row0 + ai * HALF + m * 16)) * 16 + (col & 8)) = w;
                    else *(GAS u32x4*)(Z + (size_t)(row0 + ai * HALF + m * 16) * ZP + col) = w;
                }
        }
        return true;
    }
};
struct EpiGlu {
    static constexpr bool PERM = true;
    const bf16* ypre; bf16* ycat; const float* gb;
    DI bool operator()(AccT& acc, const Unit& u, int wr, int wc, int fr, int fq) const {
        const int row0 = u.pm * BM + wr * 64 + fr, col0 = u.pn * BM + wc * 32 + 8 * fq;
        f32x4 b0[2], b1[2];
#pragma unroll
        for (int bj = 0; bj < 2; ++bj) { b0[bj] = *(const GAS f32x4*)(gb + col0 + bj * HALF); b1[bj] = *(const GAS f32x4*)(gb + col0 + bj * HALF + 4); }
#pragma unroll
        for (int ai = 0; ai < 2; ++ai) {
            u32x4 yv[2][4];
#pragma unroll
            for (int bj = 0; bj < 2; ++bj)
#pragma unroll
                for (int m = 0; m < 4; ++m) yv[bj][m] = *(const GAS u32x4*)(ypre + (size_t)(row0 + ai * HALF + m * 16) * S5W + col0 + bj * HALF);
            __builtin_amdgcn_sched_barrier(0);
#pragma unroll
            for (int bj = 0; bj < 2; ++bj)
#pragma unroll
                for (int m = 0; m < 4; ++m) { float y[8]; unpack8(yv[bj][m], y);
                    const f32x4 v0 = acc[ai][bj][m][0] + b0[bj], v1 = acc[ai][bj][m][1] + b1[bj];
                    float o[8];
#pragma unroll
                    for (int e = 0; e < 4; ++e) { o[e] = y[e] * sigmoidf_(v0[e]); o[4 + e] = y[4 + e] * sigmoidf_(v1[e]); }
                    *(GAS u32x4*)(ycat + (size_t)(row0 + ai * HALF + m * 16) * D + col0 + bj * HALF) = pack8(o); }
            __builtin_amdgcn_sched_barrier(0);
        }
        return true;
    }
};
struct EpiMerged {
    static constexpr bool PERM = true;
    const bf16* Z; bf16* out;
    DI bool operator()(AccT& acc, const Unit& u, int wr, int wc, int fr, int fq) const {
        const int row0 = u.pm * BM + wr * 64 + fr, col0 = u.pn * BM + wc * 32 + 8 * fq;
        const int seg = u.seg;
#pragma unroll
        for (int ai = 0; ai < 2; ++ai) {
            u32x4 ga[2][4], gb[2][4];
#pragma unroll
            for (int bj = 0; bj < 2; ++bj)
#pragma unroll
                for (int m = 0; m < 4; ++m) { const bf16* zr = Z + (size_t)(row0 + ai * HALF + m * 16) * ZP + ZC_GATE + col0 + bj * HALF;
                    ga[bj][m] = *(const GAS u32x4*)(zr + seg * D); gb[bj][m] = *(const GAS u32x4*)(zr + (seg < 2 ? seg + 1 : seg) * D); }
            __builtin_amdgcn_sched_barrier(0);
#pragma unroll
            for (int bj = 0; bj < 2; ++bj)
#pragma unroll
                for (int m = 0; m < 4; ++m) {
                    float g0[8], g1[8], s[8]; unpack8(ga[bj][m], g0); unpack8(gb[bj][m], g1);
#pragma unroll
                    for (int e = 0; e < 8; ++e) { const float a = fmaxf(g0[e], 1e-20f); s[e] = (seg < 2) ? a * __builtin_amdgcn_rcpf(fmaxf(g1[e], 1e-20f)) : a; }
                    f32x4 v0 = acc[ai][bj][m][0], v1 = acc[ai][bj][m][1];
#pragma unroll
                    for (int e = 0; e < 4; ++e) { v0[e] *= s[e]; v1[e] *= s[4 + e]; }
                    acc[ai][bj][m][0] = v0; acc[ai][bj][m][1] = v1;
                    if (seg == 2) { u32x4 w; w.x = pk2(v0[0], v0[1]); w.y = pk2(v0[2], v0[3]); w.z = pk2(v1[0], v1[1]); w.w = pk2(v1[2], v1[3]);
                        *(GAS u32x4*)(out + (size_t)(row0 + ai * HALF + m * 16) * D + col0 + bj * HALF) = w; } }
            __builtin_amdgcn_sched_barrier(0);
        }
        return seg == 2;
    }
};
constexpr int XP = D;
struct EpiResid {
    static constexpr bool PERM = true;
    const bf16* xb; bf16* xo; float* ssq;
    DI bool operator()(AccT& acc, const Unit& u, int wr, int wc, int fr, int fq) const {
        const int row0 = u.pm * BM + wr * 64 + fr, col0 = u.pn * BM + wc * 32 + 8 * fq;
        float ps[2][4];
#pragma unroll
        for (int ai = 0; ai < 2; ++ai) {
            u32x4 xv[4][2];
#pragma unroll
            for (int m = 0; m < 4; ++m) { const bf16* rowp = xb + (size_t)(row0 + ai * HALF + m * 16) * XP + col0;
#pragma unroll
                for (int bj = 0; bj < 2; ++bj) xv[m][bj] = *(const GAS u32x4*)(rowp + bj * HALF); }
            __builtin_amdgcn_sched_barrier(0);
#pragma unroll
            for (int m = 0; m < 4; ++m) { bf16* rowp = xo + (size_t)(row0 + ai * HALF + m * 16) * XP + col0; float s = 0.f;
#pragma unroll
                for (int bj = 0; bj < 2; ++bj) { const u32x4 x = xv[m][bj]; const f32x4 a0 = acc[ai][bj][m][0], a1 = acc[ai][bj][m][1];
                    const float y0 = bflo(x.x) + a0[0], y1 = bfhi(x.x) + a0[1], y2 = bflo(x.y) + a0[2], y3 = bfhi(x.y) + a0[3], y4 = bflo(x.z) + a1[0], y5 = bfhi(x.z) + a1[1], y6 = bflo(x.w) + a1[2], y7 = bfhi(x.w) + a1[3];
                    s += (y0 * y0 + y1 * y1) + (y2 * y2 + y3 * y3) + (y4 * y4 + y5 * y5) + (y6 * y6 + y7 * y7);
                    u32x4 w; w.x = pk2(y0, y1); w.y = pk2(y2, y3); w.z = pk2(y4, y5); w.w = pk2(y6, y7);
                    *(GAS u32x4*)(rowp + bj * HALF) = w; }
                ps[ai][m] = s; }
            __builtin_amdgcn_sched_barrier(0);
        }
        { int a16 = ((fr + 16 * fq) ^ 16) << 2, a32 = ((fr + 16 * fq) ^ 32) << 2;
#pragma unroll
          for (int ai = 0; ai < 2; ++ai)
#pragma unroll
              for (int m = 0; m < 4; ++m) { float s = ps[ai][m];
                  s += __builtin_bit_cast(float, __builtin_amdgcn_ds_bpermute(a16, __builtin_bit_cast(int, s)));
                  s += __builtin_bit_cast(float, __builtin_amdgcn_ds_bpermute(a32, __builtin_bit_cast(int, s)));
                  if (fq == 0) ssq[(size_t)(row0 + ai * HALF + m * 16) * 32 + u.pn * 4 + wc] = s; } }
        return true;
    }
};
struct EpiRelu2 {
    static constexpr bool PERM = true;
    bf16* out; const LAS float* rs;
    DI bool operator()(AccT& acc, const Unit& u, int wr, int wc, int fr, int fq) const {
        const int row0 = u.pm * BM + wr * 64 + fr, col0 = u.pn * BM + wc * 32 + 8 * fq;
#pragma unroll
        for (int ai = 0; ai < 2; ++ai)
#pragma unroll
            for (int m = 0; m < 4; ++m) { bf16* rowp = out + (size_t)(row0 + ai * HALF + m * 16) * DFF + col0; const float rsv = rs[row0 + ai * HALF + m * 16];
#pragma unroll
                for (int bj = 0; bj < 2; ++bj) { f32x4 v0 = acc[ai][bj][m][0] * rsv, v1 = acc[ai][bj][m][1] * rsv;
#pragma unroll
                    for (int e = 0; e < 4; ++e) { const float a = fmaxf(v0[e], 0.f), b = fmaxf(v1[e], 0.f); v0[e] = a * a; v1[e] = b * b; }
                    u32x4 w; w.x = pk2(v0[0], v0[1]); w.y = pk2(v0[2], v0[3]); w.z = pk2(v1[0], v1[1]); w.w = pk2(v1[2], v1[3]);
                    *(GAS u32x4*)(rowp + bj * HALF) = w; } }
        return true;
    }
};
constexpr size_t MiB = 1u << 20;
constexpr size_t WS_CTL = 0, CTL_ZERO_BYTES = 1 * MiB;
constexpr size_t SZ_WIN = (size_t)ZP * D * 2, SZ_WSQ = (size_t)D * D * 2, SZ_W1 = (size_t)DFF * D * 2, SZ_GLU = (size_t)S5W * S5W * 2;
constexpr size_t SZ_WL = (size_t)RW * 96 * 2, SZ_AL = (size_t)RW * 128 * 2, SZ_GL = (size_t)RW * 256 * 2, SZ_VB = (size_t)RW * 64 * 2;
constexpr size_t LW_WIN = 0, LW_WUP = LW_WIN + SZ_WIN, LW_WOUT = LW_WUP + SZ_WSQ, LW_W1 = LW_WOUT + SZ_WSQ, LW_W2 = LW_W1 + SZ_W1, LW_GLU = LW_W2 + SZ_W1,
                 LW_WL = LW_GLU + SZ_GLU, LW_AL = LW_WL + SZ_WL, LW_GL = LW_AL + SZ_AL, LW_VB = LW_GL + SZ_GL, LW_SIZE = LW_VB + SZ_VB;
constexpr size_t WS_W = 1 * MiB;
constexpr size_t WS_R1 = WS_W + DEPTH * LW_SIZE;
constexpr size_t SZ_R1 = (size_t)M * D * 2;
constexpr size_t WS_R2 = WS_R1 + SZ_R1;
constexpr size_t SZ_R2 = (size_t)M * ZP * 2;
constexpr size_t WS_R3 = WS_R2 + SZ_R2;
constexpr size_t WS_R5 = WS_R3 + SZ_R1;
constexpr size_t SZ_HT = (size_t)RH * M * 64 * 4;
constexpr size_t SZ_HB = (size_t)RH * M * 64 * 2;
constexpr size_t WS_R4 = WS_R5 + SZ_HT;
constexpr size_t WS_LW = WS_R4 + 6 * SZ_HB, WS_BC = WS_LW + SZ_HT;
constexpr size_t WS_ALG = WS_R4;
constexpr size_t WS_S5TA = WS_R4 + 3 * SZ_HB;
constexpr size_t WS_S5XA = WS_LW;
constexpr int NCH = M / 64;
constexpr size_t CK_PL = 0, CK_RP = 8192, CK_Q = 16384, CK_O0 = 24576, CK_H = 40960, CK_GC = 49152, CK_SIZE = 49408;
constexpr size_t WS_CK = WS_BC + (size_t)RH * M * 4;
constexpr size_t WS_GK = WS_CK + (size_t)NCH * RH * CK_SIZE;
constexpr size_t WS_ZS5 = WS_GK + (size_t)NCH * GH * 49408;
constexpr size_t WS_END = WS_ZS5 + (size_t)M * S5W * 2;
constexpr size_t WS_GQK = WS_R4 + SZ_HB;
constexpr size_t WS_GVP = WS_LW + 4 * MiB;
static_assert((size_t)NCH * GH * 16384 <= SZ_HB && 4 * MiB + (size_t)NCH * GH * 16384 <= SZ_HT && (size_t)48 * 16 * 128 * 4 * 2 <= 4 * MiB, "gla images");
constexpr size_t WS_SSQ = WS_GVP + (size_t)NCH * GH * 16384;
static_assert(WS_SSQ + (size_t)M * 32 * 4 <= WS_LW + SZ_HT, "ssq");
static_assert(WS_END <= 1474297856ull, "workspace map exceeds 4 x largest input");
static_assert((size_t)M * RW * 4 + (size_t)M * S5W * 2 <= SZ_R1 && (size_t)M * DFF * 2 <= SZ_R2, "overlays");
constexpr int CW_BAR = 4096;
constexpr size_t WS_PRM = WS_CTL + 131072;
static_assert(131072 + (size_t)DEPTH * RH * 576 * 4 <= CTL_ZERO_BYTES, "prm");

constexpr int LDS_BYTES = 155648;
constexpr int MISC_OFF = LDS_BYTES - 512;

struct Args { const float* in[38]; float* out; unsigned char* ws; int lo, hi; };

#define CAS __attribute__((address_space(4)))
struct Frame {
    LAS unsigned char* lds; int tid, lane, wave, G, bid;
    unsigned char* ws; float* out;
};
DI Frame make_frame(LAS unsigned char* lds, const CAS Args*& ap, const int wv) {
    Frame F; F.lds = lds;
    int tid = wv * 64 + lane_id_fresh(); asm volatile("" : "+v"(tid));
    int bid = blockIdx.x, G = gridDim.x; asm volatile("" : "+s"(bid), "+s"(G));
    const CAS Args* p = (const CAS Args*)__builtin_amdgcn_kernarg_segment_ptr(); asm volatile("" : "+s"(p));
    F.tid = tid; F.lane = tid & 63; F.wave = wv; F.G = G; F.bid = bid;
    F.ws = p->ws; F.out = p->out; ap = p; return F;
}
DI unsigned char* lw(const Frame& F, int l, size_t off) { return F.ws + WS_W + (size_t)l * LW_SIZE + off; }

DI void transpose_item(const float* W, int K, int N, bf16* WT, int ldt, int row_off, LAS float* scr, int item, int lane, const float* kscale = nullptr, int frag_nk = 0) {
    const int nblk = (N + 31) / 32, kb = item / nblk, nb = item % nblk, k0 = 64 * kb, n0 = 32 * nb;
    const int lr = lane >> 3, c4 = (lane & 7) * 4; const bool nok = (n0 + c4) < N;
    f32x4 v[8];
#pragma unroll
    for (int i = 0; i < 8; ++i) { const int row = lr + 8 * i; const bool ok = nok && (k0 + row) < K; v[i] = ok ? *(const GAS f32x4*)(W + (size_t)(k0 + row) * N + n0 + c4) : (f32x4){0.f, 0.f, 0.f, 0.f}; }
    if (kscale) { float ks[8];
#pragma unroll
        for (int i = 0; i < 8; ++i) ks[i] = kscale[(k0 + lr + 8 * i) < K ? (k0 + lr + 8 * i) : 0];
#pragma unroll
        for (int i = 0; i < 8; ++i) v[i] = v[i] * ks[i]; }
    __builtin_amdgcn_sched_barrier(0);
#pragma unroll
    for (int i = 0; i < 8; ++i) { LAS float* d = scr + (lr + 8 * i) * 33 + c4; d[0] = v[i][0]; d[1] = v[i][1]; d[2] = v[i][2]; d[3] = v[i][3]; }
    LDS_WAIT(); asm volatile("" ::: "memory");
    const int c = lane & 7;
    u32x4 o[4];
#pragma unroll
    for (int j = 0; j < 4; ++j) { const int n = (lane >> 3) + 8 * j; const LAS float* s = scr + (8 * c) * 33 + n;
        o[j].x = pk2(s[0 * 33], s[1 * 33]); o[j].y = pk2(s[2 * 33], s[3 * 33]); o[j].z = pk2(s[4 * 33], s[5 * 33]); o[j].w = pk2(s[6 * 33], s[7 * 33]); }
#pragma unroll
    for (int j = 0; j < 4; ++j) { const int n = (lane >> 3) + 8 * j; if ((n0 + n) < N && (k0 + 8 * c) < K) {
            if (frag_nk) { const int nn = n0 + n, kk = k0 + 8 * c; *(GAS u32x4*)(WT + ((size_t)((nn >> 4) * frag_nk + (kk >> 5)) * 64 + (nn & 15) + 16 * ((kk & 31) >> 3)) * 8) = o[j]; }
            else *(GAS u32x4*)(WT + (size_t)(row_off + n0 + n) * ldt + k0 + 8 * c) = o[j]; } }
    LDS_WAIT(); asm volatile("" ::: "memory");
}
DI int titems(int K, int N) { return ((K + 63) / 64) * ((N + 31) / 32); }
DI void p0_prologue(const Frame& F, const CAS Args& a) {
    LAS float* scr = (LAS float*)(F.lds + F.wave * 16384);
    const int gw = F.bid * 8 + F.wave, NGW = F.G * 8;
    constexpr int I_IN = (D / 64) * ((INCOLS + 31) / 32), I_VA = (D / 64) * 2, I_SQ = (D / 64) * (D / 32), I_1 = (D / 64) * (DFF / 32), I_2 = (DFF / 64) * (D / 32),
                  I_GLU = (S5W / 64) * (S5W / 32), I_WL = 2 * 20, I_AL = 2 * 20, I_GL = 4 * 20, I_VB = 1 * 20;
    constexpr int PER_LAYER = I_IN + I_VA + 2 * I_SQ + I_1 + I_2 + I_GLU + I_WL + I_AL + I_GL + I_VB;
    for (int it = gw; it < DEPTH * PER_LAYER; it += NGW) {
        const int l = it / PER_LAYER; int r = it - l * PER_LAYER;
        if (r < I_IN) { transpose_item(a.in[2] + (size_t)l * D * INCOLS, D, INCOLS, (bf16*)lw(F, l, LW_WIN), D, 0, scr, r, F.lane, a.in[1] + (size_t)l * D); continue; } r -= I_IN;
        if (r < I_VA) { if (l > 0) transpose_item(a.in[25] + (size_t)(l - 1) * D * 64, D, 64, (bf16*)lw(F, l, LW_WIN), D, ZC_VRES, scr, r, F.lane, a.in[1] + (size_t)l * D); continue; } r -= I_VA;
        if (r < I_SQ) { transpose_item(a.in[32] + (size_t)l * D * D, D, D, (bf16*)lw(F, l, LW_WUP), D, 0, scr, r, F.lane); continue; } r -= I_SQ;
        if (r < I_SQ) { transpose_item(a.in[33] + (size_t)l * D * D, D, D, (bf16*)lw(F, l, LW_WOUT), D, 0, scr, r, F.lane); continue; } r -= I_SQ;
        if (r < I_1) { transpose_item(a.in[35] + (size_t)l * D * DFF, D, DFF, (bf16*)lw(F, l, LW_W1), D, 0, scr, r, F.lane, a.in[34] + (size_t)l * D); continue; } r -= I_1;
        if (r < I_2) { transpose_item(a.in[36] + (size_t)l * DFF * D, DFF, D, (bf16*)lw(F, l, LW_W2), DFF, 0, scr, r, F.lane); continue; } r -= I_2;
        if (r < I_GLU) { transpose_item(a.in[12] + (size_t)l * S5W * S5W, S5W, S5W, (bf16*)lw(F, l, LW_GLU), S5W, 0, scr, r, F.lane); continue; } r -= I_GLU;
        if (r < I_WL) { transpose_item(a.in[15] + (size_t)l * 96 * RW, 96, RW, (bf16*)lw(F, l, LW_WL), 96, 0, scr, r, F.lane, nullptr, 3); continue; } r -= I_WL;
        if (r < I_AL) { transpose_item(a.in[17] + (size_t)l * 128 * RW, 128, RW, (bf16*)lw(F, l, LW_AL), 128, 0, scr, r, F.lane, nullptr, 4); continue; } r -= I_AL;
        if (r < I_GL) { transpose_item(a.in[19] + (size_t)l * 256 * RW, 256, RW, (bf16*)lw(F, l, LW_GL), 256, 0, scr, r, F.lane, nullptr, 8); continue; } r -= I_GL;
        if (l > 0) transpose_item(a.in[27] + (size_t)(l - 1) * 64 * RW, 64, RW, (bf16*)lw(F, l, LW_VB), 64, 0, scr, r, F.lane, nullptr, 2);
    }
}

template <bool IN_BF16, bool OUT_F32>
DI void rmsnorm_phase(const Frame& F, const void* xp, const float* g, void* outp) {
    const int gw = F.bid * 8 + F.wave, NGW = F.G * 8;
    f32x4 gv[8];
    if (IN_BF16) {
#pragma unroll
        for (int j = 0; j < 4; ++j) { gv[2 * j] = ((const GAS f32x4*)g)[2 * (64 * j + F.lane)]; gv[2 * j + 1] = ((const GAS f32x4*)g)[2 * (64 * j + F.lane) + 1]; }
    } else {
#pragma unroll
        for (int j = 0; j < 8; ++j) gv[j] = ((const GAS f32x4*)g)[64 * j + F.lane];
    }
    for (int m = gw; m < M; m += NGW) {
        f32x4 v[8]; float s = 0.f;
        if (IN_BF16) { const GAS u32x4* xr = (const GAS u32x4*)((const bf16*)xp + (size_t)m * XP) + F.lane;
            u32x4 r[4];
#pragma unroll
            for (int j = 0; j < 4; ++j) r[j] = xr[64 * j];
#pragma unroll
            for (int j = 0; j < 4; ++j) { v[2 * j] = (f32x4){bflo(r[j].x), bfhi(r[j].x), bflo(r[j].y), bfhi(r[j].y)}; v[2 * j + 1] = (f32x4){bflo(r[j].z), bfhi(r[j].z), bflo(r[j].w), bfhi(r[j].w)}; }
#pragma unroll
            for (int j = 0; j < 8; ++j) s += (v[j].x * v[j].x + v[j].y * v[j].y) + (v[j].z * v[j].z + v[j].w * v[j].w);
        } else { const GAS f32x4* xr = (const GAS f32x4*)((const float*)xp + (size_t)m * D) + F.lane;
#pragma unroll
            for (int j = 0; j < 8; ++j) { v[j] = xr[64 * j]; s += (v[j].x * v[j].x + v[j].y * v[j].y) + (v[j].z * v[j].z + v[j].w * v[j].w); } }
        const float rstd = 1.f / sqrtf(wave_sum(s) * (1.f / D) + NORM_EPS);
        if (OUT_F32) {
            if (IN_BF16) { GAS f32x4* o = (GAS f32x4*)((float*)outp + (size_t)m * D);
#pragma unroll
                for (int j = 0; j < 4; ++j) { o[2 * (64 * j + F.lane)] = v[2 * j] * rstd * gv[2 * j]; o[2 * (64 * j + F.lane) + 1] = v[2 * j + 1] * rstd * gv[2 * j + 1]; }
            } else { GAS f32x4* o = (GAS f32x4*)((float*)outp + (size_t)m * D) + F.lane;
#pragma unroll
                for (int j = 0; j < 8; ++j) o[64 * j] = v[j] * rstd * gv[j]; }
        } else {
            if (IN_BF16) { GAS u32x4* o = (GAS u32x4*)((bf16*)outp + (size_t)m * D) + F.lane;
#pragma unroll
                for (int j = 0; j < 4; ++j) { const f32x4 y0 = v[2 * j] * rstd * gv[2 * j], y1 = v[2 * j + 1] * rstd * gv[2 * j + 1]; u32x4 w; w.x = pk2(y0.x, y0.y); w.y = pk2(y0.z, y0.w); w.z = pk2(y1.x, y1.y); w.w = pk2(y1.z, y1.w); o[64 * j] = w; }
            } else { GAS u32x2* o = (GAS u32x2*)((bf16*)outp + (size_t)m * D) + F.lane;
#pragma unroll
                for (int j = 0; j < 8; ++j) { const f32x4 y = v[j] * rstd * gv[j]; u32x2 w; w.x = pk2(y.x, y.y); w.y = pk2(y.z, y.w); o[64 * j] = w; } }
        }
    }
}

constexpr int AL_PITCH = 552;
constexpr int PO_PITCH = 68;
struct RwPrep { bf16 *R, *K2, *V, *KK, *BB, *G; float *LW, *BC, *VF; };
DI RwPrep rwprep_ptrs(const Frame& F) { RwPrep p; bf16* b = (bf16*)(F.ws + WS_R4); const size_t n = (size_t)RH * M * 64;
    p.R = b; p.K2 = b + n; p.V = b + 2 * n; p.KK = b + 3 * n; p.BB = b + 4 * n; p.G = b + 5 * n; p.LW = (float*)(F.ws + WS_LW); p.BC = (float*)(F.ws + WS_BC); p.VF = (float*)(F.ws + WS_R5); return p; }
#define SB() __builtin_amdgcn_sched_barrier(0)
#ifndef REP3_MASK
#define REP3_MASK 0
#endif
#define REP3(k) ((REP3_MASK >> (k)) & 1)
template <int K, int KOFF, int L>
DI void lora_tile(const LAS bf16* AL, const bf16* Bt, LAS float* PO, int h, int mt, int np, int fr, int fq) {
    constexpr int NK = K / 32;
    bf16x8 bv[2][NK], av[NK];
#pragma unroll
    for (int ks = 0; ks < NK; ++ks) { av[ks] = *(const LAS bf16x8*)(AL + (16 * mt + fr) * AL_PITCH + KOFF + 32 * ks + 8 * fq);
#pragma unroll
        for (int nn = 0; nn < 2; ++nn) bv[nn][ks] = *(const GAS bf16x8*)(Bt + (size_t)(h * 64 + 16 * (2 * np + nn) + fr) * K + 8 * fq + 32 * ks); }
    SB();
#pragma unroll
    for (int nn = 0; nn < 2; ++nn) { const int nt = 2 * np + nn; f32x4 acc = {0.f, 0.f, 0.f, 0.f};
#pragma unroll
        for (int ks = 0; ks < NK; ++ks) acc = __builtin_amdgcn_mfma_f32_16x16x32_bf16(av[ks], bv[nn][ks], acc, 0, 0, 0);
#pragma unroll
        for (int i = 0; i < 4; ++i) PO[(L * 64 + 16 * mt + 4 * fq + i) * PO_PITCH + 16 * nt + fr] = acc[i]; }
    SB();
}
DI void lora2_tile(const LAS bf16* AL, const bf16* WLt, const bf16* VBt, LAS float* PO, int h, int mt, int np, int fr, int fq, bool has_v) {
    bf16x8 b0[2][3], a0[3], b3[2][2], a3[2];
    const LAS bf16* arow = AL + (16 * mt + fr) * AL_PITCH + 8 * fq;
#pragma unroll
    for (int ks = 0; ks < 3; ++ks) { a0[ks] = *(const LAS bf16x8*)(arow + 32 * ks);
#pragma unroll
        for (int nn = 0; nn < 2; ++nn) b0[nn][ks] = *(const GAS bf16x8*)(WLt + (size_t)(h * 64 + 16 * (2 * np + nn) + fr) * 96 + 8 * fq + 32 * ks); }
#pragma unroll
    for (int ks = 0; ks < 2; ++ks) { a3[ks] = *(const LAS bf16x8*)(arow + 480 + 32 * ks);
#pragma unroll
        for (int nn = 0; nn < 2; ++nn) b3[nn][ks] = has_v ? *(const GAS bf16x8*)(VBt + (size_t)(h * 64 + 16 * (2 * np + nn) + fr) * 64 + 8 * fq + 32 * ks) : (bf16x8){0, 0, 0, 0, 0, 0, 0, 0}; }
    SB();
#pragma unroll
    for (int nn = 0; nn < 2; ++nn) { const int nt = 2 * np + nn; f32x4 c0 = {0.f, 0.f, 0.f, 0.f}, c3 = c0;
#pragma unroll
        for (int ks = 0; ks < 3; ++ks) c0 = __builtin_amdgcn_mfma_f32_16x16x32_bf16(a0[ks], b0[nn][ks], c0, 0, 0, 0);
#pragma unroll
        for (int ks = 0; ks < 2; ++ks) c3 = __builtin_amdgcn_mfma_f32_16x16x32_bf16(a3[ks], b3[nn][ks], c3, 0, 0, 0);
#pragma unroll
        for (int i = 0; i < 4; ++i) { PO[(0 * 64 + 16 * mt + 4 * fq + i) * PO_PITCH + 16 * nt + fr] = c0[i]; PO[(3 * 64 + 16 * mt + 4 * fq + i) * PO_PITCH + 16 * nt + fr] = c3[i]; } }
    SB();
}
DI void rwkv_prep_phase(const Frame& F, const CAS Args& a, int l) {
    const bf16* Z = (const bf16*)(F.ws + WS_R2);
    LAS bf16* AL = (LAS bf16*)F.lds;
    LAS float* PO = (LAS float*)(F.lds + 64 * AL_PITCH * 2);
    const float* mu = a.in[14] + (size_t)l * RWCOLS;
    const float* vmu = a.in[26] + (size_t)(l > 0 ? l - 1 : 0) * 64;
    const RwPrep P = rwprep_ptrs(F);
    const bf16* WLt = (const bf16*)lw(F, l, LW_WL); const bf16* ALt = (const bf16*)lw(F, l, LW_AL); const bf16* GLt = (const bf16*)lw(F, l, LW_GL); const bf16* VBt = (const bf16*)lw(F, l, LW_VB);
    for (int c = F.bid; c < M / 64; c += F.G) {
        for (int rep_ = 0; rep_ < 1 + REP3(0); ++rep_) {
        if (F.tid < 476) { const int cc = F.tid % 68, r0 = F.tid / 68, j = cc * 8;
            const int zc = (j < 480) ? ZC_WIN + j : ZC_VRES + (j - 480); const float* mp = (j < 480) ? mu + (ZC_WIN - ZC_R) + j : vmu + (j - 480);
            const int kind = (j < 96) ? 0 : ((j >= 224 && j < 480) ? 2 : ((j >= 480 && l == 0) ? 3 : 1));
            const f32x4 m0 = *(const GAS f32x4*)mp, m1 = *(const GAS f32x4*)(mp + 4);
            for (int ib = 0; ib < 2; ++ib) {
                u32x4 cu[5], pr[5];
#pragma unroll
                for (int u = 0; u < 5; ++u) { const int r = r0 + 7 * (5 * ib + u), rr = r < 64 ? r : 63, gr = 64 * c + rr;
                    cu[u] = *(const GAS u32x4*)(Z + (size_t)gr * ZP + zc); pr[u] = *(const GAS u32x4*)(Z + (size_t)(gr > 0 ? gr - 1 : 0) * ZP + zc); }
                SB();
#pragma unroll
                for (int u = 0; u < 5; ++u) { const int r = r0 + 7 * (5 * ib + u); if (r < 64) { const int gr = 64 * c + r;
                    float cur[8], prv[8], o[8]; unpack8(cu[u], cur); unpack8(pr[u], prv);
#pragma unroll
                    for (int e = 0; e < 8; ++e) { const float pv = gr > 0 ? prv[e] : 0.f; const float mm = e < 4 ? m0[e] : m1[e - 4]; o[e] = cur[e] + (pv - cur[e]) * mm; }
                    if (kind == 0) {
#pragma unroll
                        for (int e = 0; e < 8; ++e) o[e] = 1.f - 2.f * __builtin_amdgcn_rcpf(__expf(2.f * o[e]) + 1.f);
                    } else if (kind == 2) {
#pragma unroll
                        for (int e = 0; e < 8; ++e) o[e] = sigmoidf_(o[e]);
                    } else if (kind == 3) {
#pragma unroll
                        for (int e = 0; e < 8; ++e) o[e] = 0.f; }
                    *(LAS u32x4*)(AL + r * AL_PITCH + j) = pack8(o); } }
                SB();
            } }
        }
        __syncthreads();
        for (int h = 0; h < RH; ++h) {
            const int t = F.tid >> 3, cg = F.tid & 7, gr = 64 * c + t, ch = h * 64 + 8 * cg;
            const size_t po = ((size_t)h * M + gr) * 64 + 8 * cg;
            u32x4 zc_[3], zp_[3]; f32x4 zm0[3], zm1[3];
#pragma unroll
            for (int which = 0; which < 3; ++which) { const int zc = (which == 0 ? ZC_R : (which == 1 ? ZC_K : ZC_V)) + ch;
                zc_[which] = *(const GAS u32x4*)(Z + (size_t)gr * ZP + zc); zp_[which] = *(const GAS u32x4*)(Z + (size_t)(gr > 0 ? gr - 1 : 0) * ZP + zc);
                zm0[which] = *(const GAS f32x4*)(mu + (zc - ZC_R)); zm1[which] = *(const GAS f32x4*)(mu + (zc - ZC_R) + 4); }
            SB();
            for (int rep_ = 0; rep_ < 1 + REP3(1); ++rep_)
            { const int mt = F.wave & 3, np = F.wave >> 2, fr = F.lane & 15, fq = F.lane >> 4;
              lora2_tile(AL, WLt, VBt, PO, h, mt, np, fr, fq, l > 0);
              lora_tile<128, 96, 1>(AL, ALt, PO, h, mt, np, fr, fq);
              lora_tile<256, 224, 2>(AL, GLt, PO, h, mt, np, fr, fq);
            }
            f32x4 pw0[2], pa0[2], pkk[2], pka[2], prk[2], pvb[2], pvf[2];
#pragma unroll
            for (int q = 0; q < 2; ++q) { pw0[q] = *(const GAS f32x4*)(a.in[16] + (size_t)l * RW + ch + 4 * q); pa0[q] = *(const GAS f32x4*)(a.in[18] + (size_t)l * RW + ch + 4 * q); pkk[q] = *(const GAS f32x4*)(a.in[20] + (size_t)l * RW + ch + 4 * q);
                pka[q] = *(const GAS f32x4*)(a.in[21] + (size_t)l * RW + ch + 4 * q); prk[q] = *(const GAS f32x4*)(a.in[22] + (size_t)l * RW + ch + 4 * q);
                pvb[q] = (l > 0) ? *(const GAS f32x4*)(a.in[28] + (size_t)(l - 1) * RW + ch + 4 * q) : (f32x4){0.f, 0.f, 0.f, 0.f}; pvf[q] = (l > 0) ? *(const GAS f32x4*)(P.VF + po + 4 * q) : (f32x4){0.f, 0.f, 0.f, 0.f}; }
            SB();
            __syncthreads();
            for (int rep_ = 0; rep_ < 1 + REP3(2); ++rep_)
            {
              float r[8], k[8], v[8];
#pragma unroll
              for (int which = 0; which < 3; ++which) { float cu[8], pr[8]; unpack8(zc_[which], cu); unpack8(zp_[which], pr);
#pragma unroll
                  for (int e = 0; e < 8; ++e) { const float pv = gr > 0 ? pr[e] : 0.f; const float mm = e < 4 ? zm0[which][e] : zm1[which][e - 4]; const float zs = cu[e] + (pv - cu[e]) * mm;
                      if (which == 0) r[e] = zs; else if (which == 1) k[e] = zs; else v[e] = zs; } }
              float wpre[8], apre[8], gpre[8], vpre[8];
#pragma unroll
              for (int q = 0; q < 2; ++q) { const f32x4 x0 = *(const LAS f32x4*)(PO + (0 * 64 + t) * PO_PITCH + 8 * cg + 4 * q), x1 = *(const LAS f32x4*)(PO + (1 * 64 + t) * PO_PITCH + 8 * cg + 4 * q), x2 = *(const LAS f32x4*)(PO + (2 * 64 + t) * PO_PITCH + 8 * cg + 4 * q);
                  const f32x4 x3 = (l > 0) ? *(const LAS f32x4*)(PO + (3 * 64 + t) * PO_PITCH + 8 * cg + 4 * q) : (f32x4){0.f, 0.f, 0.f, 0.f};
#pragma unroll
                  for (int e = 0; e < 4; ++e) { wpre[4 * q + e] = x0[e]; apre[4 * q + e] = x1[e]; gpre[4 * q + e] = x2[e]; vpre[4 * q + e] = x3[e]; } }
              float lwv[8], av[8], kk[8], k2[8], bb[8]; float ss = 0.f, bc = 0.f;
              if (l > 0) {
#pragma unroll
                  for (int e = 0; e < 8; ++e) { const float vg = sigmoidf_(pvb[e >> 2][e & 3] + vpre[e]); const float vf = pvf[e >> 2][e & 3]; v[e] = v[e] + (vf - v[e]) * vg; } }
#pragma unroll
              for (int e = 0; e < 8; ++e) {
                  const float w = -softplusf_(-(pw0[e >> 2][e & 3] + wpre[e])) - 0.5f; lwv[e] = -__expf(w);
                  av[e] = sigmoidf_(pa0[e >> 2][e & 3] + apre[e]);
                  kk[e] = k[e] * pkk[e >> 2][e & 3]; ss += kk[e] * kk[e];
                  k2[e] = k[e] * (1.f + (av[e] - 1.f) * pka[e >> 2][e & 3]); bc += r[e] * k2[e] * prk[e >> 2][e & 3]; }
              ss = sum8(ss); bc = sum8(bc); const float rn = 1.f / sqrtf(fmaxf(ss, 1e-24f));
#pragma unroll
              for (int e = 0; e < 8; ++e) { kk[e] *= rn; bb[e] = kk[e] * av[e]; }
#define ST8(dst, arr) do { *(GAS f32x4*)((dst) + po) = (f32x4){arr[0], arr[1], arr[2], arr[3]}; *(GAS f32x4*)((dst) + po + 4) = (f32x4){arr[4], arr[5], arr[6], arr[7]}; } while (0)
#define ST8B(dst, arr) do { *(GAS u32x4*)((dst) + po) = pack8(arr); } while (0)
              ST8B(P.R, r); ST8(P.LW, lwv); ST8B(P.K2, k2); ST8B(P.V, v); ST8B(P.KK, kk); ST8B(P.BB, bb); ST8B(P.G, gpre);
              if (cg == 0) P.BC[(size_t)h * M + gr] = bc;
              if (l == 0) ST8(P.VF, v);
#undef ST8B
#undef ST8
            }
            __syncthreads();
        }
    }
}
DI float gelu_tanh(float y) { const float u = 0.7978845608028654f * (y + 0.044715f * y * y * y); const float e = __expf(2.f * u); const float th = 1.f - 2.f * __builtin_amdgcn_rcpf(e + 1.f); return 0.5f * y * (1.f + th); }

typedef short s16x4 __attribute__((ext_vector_type(4)));
DI bf16x8 ld_pi(const LAS bf16* row, int ks, int kg) {
    const u32x2 a = *(const LAS u32x2*)(row + 32 * ks + 4 * kg), b = *(const LAS u32x2*)(row + 32 * ks + 16 + 4 * kg);
    u32x4 v; v.x = a.x; v.y = a.y; v.z = b.x; v.w = b.y; return __builtin_bit_cast(bf16x8, v);
}
DI bf16x8 pack_pi(const f32x4 lo, const f32x4 hi) { u32x4 v; v.x = pk2(lo[0], lo[1]); v.y = pk2(lo[2], lo[3]); v.z = pk2(hi[0], hi[1]); v.w = pk2(hi[2], hi[3]); return __builtin_bit_cast(bf16x8, v); }
DI unsigned char* ck_ptr(const Frame& F, int c, int h) { return F.ws + WS_CK + ((size_t)c * RH + h) * CK_SIZE; }

constexpr int RPP = 72;
constexpr int RP_AT = 0, RP_BT = 9216, RP_KT = 18432, RP_RT = 27648, RP_BDT = 36864, RP_KDT = 46080, RP_VT = 55296, RP_LAK = 64512, RP_MRB = 73728, RP_MRK = 82944;
constexpr int RP_L = 92160, RP_CUM = RP_L + 17408, RP_TBB = RP_CUM + 17408, RP_SEG = RP_TBB + 5120, RP_END = RP_SEG + 2048;
static_assert(RP_END + 9 * 64 * 4 <= MISC_OFF, "rwkv_pre LDS");

DI void rwkv_chunk_tail(const Frame& F, unsigned char* const ck, LAS bf16* const At, LAS bf16* const Bt, LAS bf16* const Kt, LAS bf16* const Rt, LAS bf16* const BdT, LAS bf16* const KdT, LAS bf16* const VT,
                        LAS bf16* const Lak, LAS bf16* const Mrb, LAS bf16* const Mrk, LAS float* const Lm, LAS float* const Tbb) {
    const int lane = F.lane, w = F.wave, n = lane & 15, g4 = lane >> 4;
    {
        { const int p = w >> 1;
          const LAS bf16* Xs = (p & 1) ? Kt : Bt; const LAS bf16* Xt = (p & 2) ? Rt : At;
          bf16x8 bfrag[2][2], afrag[4][2];
#pragma unroll
          for (int nn = 0; nn < 2; ++nn)
#pragma unroll
              for (int ks = 0; ks < 2; ++ks) bfrag[nn][ks] = *(const LAS bf16x8*)(Xt + (16 * (2 * (w & 1) + nn) + n) * RPP + 32 * ks + 8 * g4);
#pragma unroll
          for (int ms = 0; ms < 4; ++ms)
#pragma unroll
              for (int ks = 0; ks < 2; ++ks) afrag[ms][ks] = *(const LAS bf16x8*)(Xs + (16 * ms + n) * RPP + 32 * ks + 8 * g4);
          SB();
#pragma unroll
          for (int nn = 0; nn < 2; ++nn) { const int nt = 2 * (w & 1) + nn; const int t = 16 * nt + n;
#pragma unroll
              for (int ms = 0; ms < 4; ++ms) {
                  if (ms <= nt) { f32x4 acc = {0.f, 0.f, 0.f, 0.f};
#pragma unroll
                      for (int ks = 0; ks < 2; ++ks) acc = __builtin_amdgcn_mfma_f32_16x16x32_bf16(afrag[ms][ks], bfrag[nn][ks], acc, 0, 0, 0);
#pragma unroll
                      for (int r = 0; r < 4; ++r) { const int s = 16 * ms + 4 * g4 + r; const bool keep = (p & 2) ? (s <= t) : (s < t); acc[r] = keep ? acc[r] : 0.f; }
                      if (p == 0) *(LAS f32x4*)(Lm + t * 68 + 16 * ms + 4 * g4) = acc;
                      else { LAS bf16* dst = (p == 1) ? Lak : (p == 2 ? Mrb : Mrk); u32x2 o; o.x = pk2(acc[0], acc[1]); o.y = pk2(acc[2], acc[3]); *(LAS u32x2*)(dst + t * RPP + 16 * ms + 4 * g4) = o; } } } } }
        asm volatile("s_waitcnt lgkmcnt(0)" ::: "memory"); __builtin_amdgcn_s_barrier(); SB();
        if (F.tid < 64) { const int b = F.tid >> 4, cc = F.tid & 15; float x[16];
#pragma unroll
            for (int t0 = 0; t0 < 16; t0 += 4) { f32x4 lr[4][4];
#pragma unroll
                for (int tt = 0; tt < 4; ++tt)
#pragma unroll
                    for (int q = 0; q < 4; ++q) if (4 * q < t0 + tt) lr[tt][q] = *(const LAS f32x4*)(Lm + (16 * b + t0 + tt) * 68 + 16 * b + 4 * q);
                SB();
#pragma unroll
                for (int tt = 0; tt < 4; ++tt) { const int t = t0 + tt; float s = (t == cc) ? 1.f : 0.f;
#pragma unroll
                    for (int s2 = 0; s2 < t; ++s2) s += lr[tt][s2 >> 2][s2 & 3] * x[s2];
                    x[t] = s; Tbb[(b * 16 + t) * 20 + cc] = s; }
                SB(); } }
        asm volatile("s_waitcnt lgkmcnt(0)" ::: "memory"); __builtin_amdgcn_s_barrier(); SB();
        { f32x4 rhs[4];
          if (w < 4) {
#pragma unroll
              for (int b = 0; b < 4; ++b)
#pragma unroll
                  for (int r = 0; r < 4; ++r) rhs[b][r] = bf2f(At[(16 * b + 4 * g4 + r) * RPP + 16 * w + n]);
          } else { const int vs = w - 4;
              bf16x8 vf[2];
#pragma unroll
              for (int ks = 0; ks < 2; ++ks) vf[ks] = *(const LAS bf16x8*)(VT + (16 * vs + n) * RPP + 32 * ks + 8 * g4);
#pragma unroll
              for (int b = 0; b < 4; ++b) { f32x4 acc = {0.f, 0.f, 0.f, 0.f};
#pragma unroll
                  for (int ks = 0; ks < 2; ++ks) { const bf16x8 af = *(const LAS bf16x8*)(Lak + (16 * b + n) * RPP + 32 * ks + 8 * g4); acc = __builtin_amdgcn_mfma_f32_16x16x32_bf16(af, vf[ks], acc, 0, 0, 0); }
                  rhs[b] = acc; } }
          SB();
          f32x4 X[4];
#pragma unroll
          for (int b = 0; b < 4; ++b) { f32x4 lf[3], tf;
              tf = *(const LAS f32x4*)(Tbb + (b * 16 + n) * 20 + 4 * g4);
#pragma unroll
              for (int b2 = 0; b2 < 3; ++b2) if (b2 < b) lf[b2] = *(const LAS f32x4*)(Lm + (16 * b + n) * 68 + 16 * b2 + 4 * g4);
              SB();
              f32x4 acc = rhs[b];
#pragma unroll
              for (int b2 = 0; b2 < b; ++b2) {
#pragma unroll
                  for (int q = 0; q < 4; ++q) acc = __builtin_amdgcn_mfma_f32_16x16x4f32(lf[b2][q], X[b2][q], acc, 0, 0, 0); }
              f32x4 o = {0.f, 0.f, 0.f, 0.f};
#pragma unroll
              for (int q = 0; q < 4; ++q) o = __builtin_amdgcn_mfma_f32_16x16x4f32(tf[q], acc[q], o, 0, 0, 0);
              X[b] = o;
              SB(); }
          bf16x8 xf[2]; xf[0] = pack_pi(X[0], X[1]); xf[1] = pack_pi(X[2], X[3]);
          SB();
          if (w < 4) { const int ws_ = w;
#pragma unroll
              for (int n0 = 0; n0 < 4; n0 += 2) { bf16x8 fb[2][2], fm[2][2]; u32x2 rr[2];
#pragma unroll
                  for (int nn = 0; nn < 2; ++nn) { const int nt = n0 + nn; rr[nn] = *(const LAS u32x2*)(Rt + (16 * nt + n) * RPP + 16 * ws_ + 4 * g4);
#pragma unroll
                      for (int ks = 0; ks < 2; ++ks) { fb[nn][ks] = ld_pi(BdT + (16 * nt + n) * RPP, ks, g4); fm[nn][ks] = ld_pi(Mrb + (16 * nt + n) * RPP, ks, g4); } }
                  SB();
#pragma unroll
                  for (int nn = 0; nn < 2; ++nn) { const int nt = n0 + nn;
                      f32x4 acc = {0.f, 0.f, 0.f, 0.f}, ac2 = {0.f, 0.f, 0.f, 0.f};
#pragma unroll
                      for (int ks = 0; ks < 2; ++ks) { acc = __builtin_amdgcn_mfma_f32_16x16x32_bf16(xf[ks], fb[nn][ks], acc, 0, 0, 0); ac2 = __builtin_amdgcn_mfma_f32_16x16x32_bf16(xf[ks], fm[nn][ks], ac2, 0, 0, 0); }
                      u32x2 o; o.x = pk2(acc[0], acc[1]); o.y = pk2(acc[2], acc[3]);
                      *(GAS u32x2*)(ck + CK_PL + ((size_t)((nt * 2 + (ws_ >> 1)) * 64 + lane)) * 16 + (ws_ & 1) * 8) = o;
                      ac2[0] += bflo(rr[nn].x); ac2[1] += bfhi(rr[nn].x); ac2[2] += bflo(rr[nn].y); ac2[3] += bfhi(rr[nn].y);
                      u32x2 o2; o2.x = pk2(ac2[0], ac2[1]); o2.y = pk2(ac2[2], ac2[3]);
                      *(GAS u32x2*)(ck + CK_RP + ((size_t)((nt * 2 + (ws_ >> 1)) * 64 + lane)) * 16 + (ws_ & 1) * 8) = o2; }
                  SB(); }
          } else { const int vs = w - 4;
              bf16x8 vf[2];
#pragma unroll
              for (int ks = 0; ks < 2; ++ks) vf[ks] = *(const LAS bf16x8*)(VT + (16 * vs + n) * RPP + 32 * ks + 8 * g4);
#pragma unroll
              for (int mt = 0; mt < 4; ++mt) { bf16x8 fb[2], fm[2], fk[2], fr[2];
#pragma unroll
                  for (int ks = 0; ks < 2; ++ks) { fb[ks] = ld_pi(BdT + (16 * mt + n) * RPP, ks, g4); fm[ks] = ld_pi(Mrb + (16 * mt + n) * RPP, ks, g4);
                      fk[ks] = *(const LAS bf16x8*)(KdT + (16 * mt + n) * RPP + 32 * ks + 8 * g4); fr[ks] = *(const LAS bf16x8*)(Mrk + (16 * mt + n) * RPP + 32 * ks + 8 * g4); }
                  SB();
                  f32x4 q = {0.f, 0.f, 0.f, 0.f}, o0 = {0.f, 0.f, 0.f, 0.f};
#pragma unroll
                  for (int ks = 0; ks < 2; ++ks) { q = __builtin_amdgcn_mfma_f32_16x16x32_bf16(fb[ks], xf[ks], q, 0, 0, 0); o0 = __builtin_amdgcn_mfma_f32_16x16x32_bf16(xf[ks], fm[ks], o0, 0, 0, 0);
                      q = __builtin_amdgcn_mfma_f32_16x16x32_bf16(fk[ks], vf[ks], q, 0, 0, 0); o0 = __builtin_amdgcn_mfma_f32_16x16x32_bf16(vf[ks], fr[ks], o0, 0, 0, 0); }
                  u32x2 qo; qo.x = pk2(q[0], q[1]); qo.y = pk2(q[2], q[3]);
                  *(GAS u32x2*)(ck + CK_Q + ((size_t)((vs * 4 + mt) * 64 + lane)) * 8) = qo;
                  *(GAS f32x4*)(ck + CK_O0 + ((size_t)((vs * 4 + mt) * 64 + lane)) * 16) = o0;
                  SB(); } } }
        asm volatile("s_waitcnt lgkmcnt(0)" ::: "memory"); __builtin_amdgcn_s_barrier(); SB();
    }
}

DI void x0_phase(const Frame& F, const float* x, bf16* xb, float* ssq) {
    const int gw = F.bid * 8 + F.wave, NGW = F.G * 8;
    for (int m = gw; m < M; m += NGW) {
        const GAS f32x4* xr = (const GAS f32x4*)(x + (size_t)m * D) + F.lane;
        f32x4 v[8]; float s = 0.f;
#pragma unroll
        for (int j = 0; j < 8; ++j) { v[j] = xr[64 * j]; s += (v[j].x * v[j].x + v[j].y * v[j].y) + (v[j].z * v[j].z + v[j].w * v[j].w); }
        s = wave_sum(s);
        GAS u32x2* o = (GAS u32x2*)(xb + (size_t)m * XP) + F.lane;
#pragma unroll
        for (int j = 0; j < 8; ++j) { u32x2 w; w.x = pk2(v[j].x, v[j].y); w.y = pk2(v[j].z, v[j].w); o[64 * j] = w; }
        if (F.lane < 32) ssq[(size_t)m * 32 + F.lane] = (F.lane == 0) ? s : 0.f;
    }
}
constexpr int RS_OFF = STAGE_BYTES;
static_assert(RS_OFF + 2048 * 4 <= MISC_OFF, "rstd table");
DI const LAS float* rstd_table(const Frame& F) {
    LAS float* const tab = (LAS float*)(F.lds + RS_OFF);
    const int base = (F.bid & 7) * 2048;
    const float* P = (const float*)(F.ws + WS_SSQ) + (size_t)base * 32;
    for (int r = F.tid; r < 2048; r += 512) { f32x4 p[8];
#pragma unroll
        for (int q = 0; q < 8; ++q) p[q] = ((const GAS f32x4*)(P + (size_t)r * 32))[q];
        SB();
        f32x4 t = (p[0] + p[1]) + (p[2] + p[3]) + ((p[4] + p[5]) + (p[6] + p[7]));
        tab[r] = 1.f / sqrtf(((t[0] + t[1]) + (t[2] + t[3])) * (1.f / D) + NORM_EPS);
        SB(); }
    asm volatile("s_waitcnt lgkmcnt(0)" ::: "memory"); __builtin_amdgcn_s_barrier(); SB();
    return tab - base;
}
constexpr size_t ALG_BYTES = (size_t)64 * AL_PITCH * 2;
template <int K, int KOFF, int L>
DI void lora_tile_g(const bf16* ALG, const bf16* Bt, LAS float* PO, int h, int mt, int np, int fr, int fq) {
    constexpr int NK = K / 32;
    bf16x8 bv[2][NK], av[NK];
    unsigned lo = (unsigned)(fr + 16 * fq) * 16u; asm volatile("" : "+v"(lo));
    const unsigned char* const ab = (const unsigned char*)ALG + (size_t)(mt * 17 + KOFF / 32) * 1024;
    const unsigned char* const bb = (const unsigned char*)Bt + (size_t)((4 * h + 2 * np) * NK) * 1024;
#pragma unroll
    for (int ks = 0; ks < NK; ++ks) { av[ks] = *(const GAS bf16x8*)(ab + ks * 1024 + lo);
#pragma unroll
        for (int nn = 0; nn < 2; ++nn) bv[nn][ks] = *(const GAS bf16x8*)(bb + (nn * NK + ks) * 1024 + lo); }
    SB();
#pragma unroll
    for (int nn = 0; nn < 2; ++nn) { const int nt = 2 * np + nn; f32x4 acc = {0.f, 0.f, 0.f, 0.f};
#pragma unroll
        for (int ks = 0; ks < NK; ++ks) acc = __builtin_amdgcn_mfma_f32_16x16x32_bf16(av[ks], bv[nn][ks], acc, 0, 0, 0);
#pragma unroll
        for (int i = 0; i < 4; ++i) PO[(L * 64 + 16 * mt + 4 * fq + i) * PO_PITCH + 16 * nt + fr] = acc[i]; }
    SB();
}
static_assert(3 * 64 * PO_PITCH * 4 <= RP_LAK && RP_END + 64 * PO_PITCH * 4 + 9 * 64 * 4 <= MISC_OFF, "the LoRA output tiles overlay only images that are rewritten for every item");

DI void rwkv_fused_phase(const Frame& F, const CAS Args& a, int l) {
    const bf16* Z = (const bf16*)(F.ws + WS_R2);
    const RwPrep P = rwprep_ptrs(F);
    LAS unsigned char* const lds = F.lds;
    LAS float* const PO = (LAS float*)lds;
    LAS float* const PO3 = (LAS float*)(lds + RP_END) - 3 * 64 * PO_PITCH;
    LAS bf16* const At = (LAS bf16*)(lds + RP_AT); LAS bf16* const Bt = (LAS bf16*)(lds + RP_BT); LAS bf16* const Kt = (LAS bf16*)(lds + RP_KT); LAS bf16* const Rt = (LAS bf16*)(lds + RP_RT);
    LAS bf16* const BdT = (LAS bf16*)(lds + RP_BDT); LAS bf16* const KdT = (LAS bf16*)(lds + RP_KDT); LAS bf16* const VT = (LAS bf16*)(lds + RP_VT);
    LAS bf16* const Lak = (LAS bf16*)(lds + RP_LAK); LAS bf16* const Mrb = (LAS bf16*)(lds + RP_MRB); LAS bf16* const Mrk = (LAS bf16*)(lds + RP_MRK);
    LAS float* const Lm = (LAS float*)(lds + RP_L); LAS float* const cum = (LAS float*)(lds + RP_CUM); LAS float* const Tbb = (LAS float*)(lds + RP_TBB); LAS float* const seg = (LAS float*)(lds + RP_SEG);
    const float* mu = a.in[14] + (size_t)l * RWCOLS;
    const float* vmu = a.in[26] + (size_t)__builtin_amdgcn_readfirstlane(l > 0 ? l - 1 : 0) * 64;
    const bf16* WLt = (const bf16*)lw(F, l, LW_WL); const bf16* ALt = (const bf16*)lw(F, l, LW_AL); const bf16* GLt = (const bf16*)lw(F, l, LW_GL); const bf16* VBt = (const bf16*)lw(F, l, LW_VB);
    bf16* const ALG = (bf16*)(F.ws + WS_ALG + (size_t)F.bid * ALG_BYTES);
    const int lane = F.lane, w = F.wave, n = lane & 15, g4 = lane >> 4;
    { unsigned zz = 0u; asm volatile("" : "+v"(zz));
      for (int q = F.tid; q < (RP_CUM - RP_LAK) / 16; q += 512) *(LAS u32x4*)(lds + RP_LAK + q * 16) = (u32x4){zz, zz, zz, zz}; }
    __syncthreads();
    for (int c = F.bid; c < NCH; c += F.G) {
        if (F.tid < 476) { int cc = F.tid % 68; asm volatile("" : "+v"(cc)); const int j = cc * 8; int r0 = F.tid / 68;
            const int zc = (j < 480) ? ZC_WIN + j : ZC_VRES + (j - 480); const float* mp = (j < 480) ? mu + (ZC_WIN - ZC_R) + j : vmu + (j - 480);
            const int kind = (j < 96) ? 0 : ((j >= 224 && j < 480) ? 2 : ((j >= 480 && l == 0) ? 3 : 1));
            const f32x4 m0 = *(const GAS f32x4*)mp, m1 = *(const GAS f32x4*)(mp + 4);
            unsigned jfo = (unsigned)((j >> 5) * 1024 + ((j & 31) >> 3) * 256); asm volatile("" : "+v"(jfo));
#define SA_LOAD(cu, pr, ib) do { _Pragma("unroll") for (int u = 0; u < 3; ++u) { const int r = r0 + 7 * (3 * (ib) + u), rr = r < 64 ? r : 63, gr = 64 * c + rr; \
                    cu[u] = *(const GAS u32x4*)(Z + (size_t)gr * ZP + zc); pr[u] = *(const GAS u32x4*)(Z + (size_t)(gr > 0 ? gr - 1 : 0) * ZP + zc); } } while (0)
#define SA_COMP(cu, pr, ib) do { _Pragma("unroll") for (int u = 0; u < 3; ++u) { const int r = r0 + 7 * (3 * (ib) + u); if (r < 64) { const int gr = 64 * c + r; \
                    float cur[8], prv[8], o[8]; unpack8(cu[u], cur); unpack8(pr[u], prv); \
                    _Pragma("unroll") for (int e = 0; e < 8; ++e) { const float pv = gr > 0 ? prv[e] : 0.f; const float mm = e < 4 ? m0[e] : m1[e - 4]; o[e] = cur[e] + (pv - cur[e]) * mm; } \
                    if (kind == 0) { _Pragma("unroll") for (int e = 0; e < 8; ++e) o[e] = 1.f - 2.f * __builtin_amdgcn_rcpf(__expf(2.f * o[e]) + 1.f); } \
                    else if (kind == 2) { _Pragma("unroll") for (int e = 0; e < 8; ++e) o[e] = sigmoidf_(o[e]); } \
                    else if (kind == 3) { _Pragma("unroll") for (int e = 0; e < 8; ++e) o[e] = 0.f; } \
                    *(GAS u32x4*)((GAS unsigned char*)ALG + (unsigned)((r >> 4) * (17 * 1024) + (r & 15) * 16) + jfo) = pack8(o); } } } while (0)
            u32x4 cuA[3], prA[3];
            for (int ib = 0; ib < 4; ++ib) {
                asm volatile("" : "+v"(r0));
                SA_LOAD(cuA, prA, ib);
                SB();
                SA_COMP(cuA, prA, ib);
                SB();
            }
#undef SA_LOAD
#undef SA_COMP
            }
        __builtin_amdgcn_fence(__ATOMIC_RELEASE, "workgroup");
        __syncthreads();
        __builtin_amdgcn_fence(__ATOMIC_ACQUIRE, "workgroup");
        float* const LWp = (float*)(F.ws + WS_R3) + (size_t)F.bid * (RH * 4096);
        bf16* const LAp = (bf16*)(F.ws + WS_R1) + (size_t)F.bid * (RH * 2 * 4096);
        { const int mt = w & 3, np = w >> 2;
          unsigned lo = (unsigned)lane * 16u; asm volatile("" : "+v"(lo));
          bf16x8 af[17];
#pragma unroll
          for (int i = 0; i < 17; ++i) af[i] = *(const GAS bf16x8*)((const unsigned char*)ALG + (size_t)(mt * 17 + i) * 1024 + lo);
          const int nch = (l > 0) ? 68 : 60;
#define LP_DMA(hh) do { LAS unsigned char* const bufd = lds + ((hh) & 1) * 69632; \
            for (int cix = w; cix < nch; cix += 8) { const unsigned char* srcp = (cix < 12) ? (const unsigned char*)WLt + (size_t)(4 * (hh) * 3 + cix) * 1024 : (cix < 28) ? (const unsigned char*)ALt + (size_t)(4 * (hh) * 4 + cix - 12) * 1024 \
                    : (cix < 60) ? (const unsigned char*)GLt + (size_t)(4 * (hh) * 8 + cix - 28) * 1024 : (const unsigned char*)VBt + (size_t)(4 * (hh) * 2 + cix - 60) * 1024; \
                __builtin_amdgcn_global_load_lds((const unsigned*)(srcp + lo), (LAS unsigned*)(bufd + cix * 1024), 16, 0, 0); } } while (0)
#define LP_TILE(NK, KO, OFF, STORE) do { \
            _Pragma("unroll") for (int nn = 0; nn < 2; ++nn) { bf16x8 bfr[NK]; \
                _Pragma("unroll") for (int ks = 0; ks < NK; ++ks) bfr[ks] = *(const LAS bf16x8*)(bufc + ((OFF) + (2 * np + nn) * (NK) + ks) * 1024 + lane * 16); \
                SB(); \
                f32x4 acc = {0.f, 0.f, 0.f, 0.f}; \
                _Pragma("unroll") for (int ks = 0; ks < NK; ++ks) acc = __builtin_amdgcn_mfma_f32_16x16x32_bf16(bfr[ks], af[(KO) + ks], acc, 0, 0, 0); \
                const int chu = 16 * (2 * np + nn); STORE; \
                SB(); } } while (0)
          LP_DMA(0);
          for (int h = 0; h < RH; ++h) {
              asm volatile("s_waitcnt vmcnt(0)" ::: "memory");
              __syncthreads();
              if (h + 1 < RH) LP_DMA(h + 1);
              const LAS unsigned char* const bufc = lds + (h & 1) * 69632;
              unsigned lof = (unsigned)(((16 * mt + n) * 64 + 4 * g4) * 2); asm volatile("" : "+v"(lof));
              LP_TILE(3, 0, 0, *(GAS f32x4*)((unsigned char*)(LWp + (size_t)h * 4096 + chu) + 2 * lof) = acc);
              LP_TILE(4, 3, 12, { u32x2 o; o.x = pk2(acc[0], acc[1]); o.y = pk2(acc[2], acc[3]); *(GAS u32x2*)((unsigned char*)(LAp + (size_t)(h * 2 + 0) * 4096 + chu) + lof) = o; });
              LP_TILE(8, 7, 28, { u32x2 o; o.x = pk2(acc[0], acc[1]); o.y = pk2(acc[2], acc[3]); *(GAS u32x2*)((unsigned char*)(P.G + ((size_t)h * M + 64 * c) * 64 + chu) + lof) = o; });
              if (l > 0) LP_TILE(2, 15, 60, { u32x2 o; o.x = pk2(acc[0], acc[1]); o.y = pk2(acc[2], acc[3]); *(GAS u32x2*)((unsigned char*)(LAp + (size_t)(h * 2 + 1) * 4096 + chu) + lof) = o; });
          }
#undef LP_DMA
#undef LP_TILE
        }
        asm volatile("s_waitcnt vmcnt(0)" ::: "memory");
        __builtin_amdgcn_fence(__ATOMIC_RELEASE, "workgroup");
        __syncthreads();
        __builtin_amdgcn_fence(__ATOMIC_ACQUIRE, "workgroup");
        { unsigned zz = 0u; asm volatile("" : "+v"(zz));
          for (int q = F.tid; q < (RP_CUM - RP_LAK) / 16; q += 512) *(LAS u32x4*)(lds + RP_LAK + q * 16) = (u32x4){zz, zz, zz, zz}; }
        __syncthreads();
        u32x4 zc_[3]; f32x4 pvf[2];
#define HL_LOADA(hh) do { const int t_ = F.tid >> 3, cg_ = F.tid & 7, gr_ = 64 * c + t_; \
            unsigned pol_ = (unsigned)(((size_t)(hh) * M + gr_) * 64 + 8 * cg_); asm volatile("" : "+v"(pol_)); \
            _Pragma("unroll") for (int q = 0; q < 2; ++q) pvf[q] = *(const GAS f32x4*)(P.VF + (size_t)pol_ + 4 * q); \
            int ch_ = (hh) * 64 + 8 * cg_; asm volatile("" : "+v"(ch_)); \
            _Pragma("unroll") for (int which = 0; which < 3; ++which) { const int zc = (which == 0 ? ZC_R : (which == 1 ? ZC_K : ZC_V)) + ch_; \
                zc_[which] = *(const GAS u32x4*)(Z + (size_t)gr_ * ZP + zc); } } while (0)
        HL_LOADA(0);
        for (int h = 0; h < RH; ++h) {
            const int t = F.tid >> 3, cg = F.tid & 7, gr = 64 * c + t; int ch = h * 64 + 8 * cg;
            asm volatile("" : "+v"(ch));
            unsigned pol = (unsigned)(((size_t)h * M + gr) * 64 + 8 * cg); asm volatile("" : "+v"(pol)); const size_t po = pol;
            int hrow = h * 64 + n; asm volatile("" : "+v"(hrow));
            unsigned char* const ck = ck_ptr(F, c, h);
            u32x4 zp_[3];
            LAS float* const PRM = (LAS float*)(lds + RP_END + 64 * PO_PITCH * 4);
            f32x4 prmv = {0.f, 0.f, 0.f, 0.f};
            { unsigned pq = (unsigned)(F.tid < 144 ? F.tid : 0) * 16u; asm volatile("" : "+v"(pq));
              prmv = *(const GAS f32x4*)((const unsigned char*)(F.ws + WS_PRM) + (size_t)((l * RH + h) * 576) * 4 + pq); }
            f32x4 wl_[2]; u32x4 al_, vl_ = {0u, 0u, 0u, 0u};
            { unsigned lro = (unsigned)((h * 64 + t) * 64 + 8 * cg); asm volatile("" : "+v"(lro));
              wl_[0] = *(const GAS f32x4*)(LWp + lro); wl_[1] = *(const GAS f32x4*)(LWp + lro + 4);
              unsigned lao = (unsigned)(((h * 2) * 64 + t) * 64 + 8 * cg); asm volatile("" : "+v"(lao));
              al_ = *(const GAS u32x4*)(LAp + lao); if (l > 0) vl_ = *(const GAS u32x4*)(LAp + lao + 4096); }
#pragma unroll
            for (int which = 0; which < 3; ++which) { const int zc = (which == 0 ? ZC_R : (which == 1 ? ZC_K : ZC_V)) + ch;
                zp_[which] = *(const GAS u32x4*)(Z + (size_t)(gr > 0 ? gr - 1 : 0) * ZP + zc); }
            SB();
            if (F.tid < 144) *(LAS f32x4*)(PRM + 4 * F.tid) = prmv;
            asm volatile("s_waitcnt lgkmcnt(0)" ::: "memory");
            __builtin_amdgcn_s_barrier();
            SB();
            float r[8], k2[8], kk[8], bb[8], v[8], lwv[8];
            { float k[8];
#pragma unroll
              for (int which = 0; which < 3; ++which) { float cu[8], pr[8]; unpack8(zc_[which], cu); unpack8(zp_[which], pr);
#pragma unroll
                  for (int e = 0; e < 8; ++e) { const float pv = gr > 0 ? pr[e] : 0.f; const float mm = PRM[which * 64 + 8 * cg + e]; const float zs = cu[e] + (pv - cu[e]) * mm;
                      if (which == 0) r[e] = zs; else if (which == 1) k[e] = zs; else v[e] = zs; } }
              SB();
              if (l > 0) { float vpre[8]; unpack8(vl_, vpre);
#pragma unroll
                  for (int e = 0; e < 8; ++e) { const float vg = sigmoidf_(PRM[8 * 64 + 8 * cg + e] + vpre[e]); const float vf = pvf[e >> 2][e & 3]; v[e] = v[e] + (vf - v[e]) * vg; } }
              *(GAS u32x4*)(P.V + po) = pack8(v);
              if (l == 0) { *(GAS f32x4*)(P.VF + po) = (f32x4){v[0], v[1], v[2], v[3]}; *(GAS f32x4*)(P.VF + po + 4) = (f32x4){v[4], v[5], v[6], v[7]}; }
              SB();
              { float wpre[8];
#pragma unroll
                for (int q = 0; q < 2; ++q) { wpre[4 * q] = wl_[q][0]; wpre[4 * q + 1] = wl_[q][1]; wpre[4 * q + 2] = wl_[q][2]; wpre[4 * q + 3] = wl_[q][3]; }
#pragma unroll
                for (int e = 0; e < 8; ++e) { const float wv = -softplusf_(-(PRM[3 * 64 + 8 * cg + e] + wpre[e])) - 0.5f; lwv[e] = -__expf(wv); } }
              *(LAS f32x4*)(cum + t * 68 + 8 * cg) = (f32x4){lwv[0], lwv[1], lwv[2], lwv[3]}; *(LAS f32x4*)(cum + t * 68 + 8 * cg + 4) = (f32x4){lwv[4], lwv[5], lwv[6], lwv[7]};
              SB();
              float av[8], apre[8]; float ss = 0.f, bc = 0.f;
              unpack8(al_, apre);
#pragma unroll
              for (int e = 0; e < 8; ++e) {
                  av[e] = sigmoidf_(PRM[4 * 64 + 8 * cg + e] + apre[e]);
                  kk[e] = k[e] * PRM[5 * 64 + 8 * cg + e]; ss += kk[e] * kk[e];
                  k2[e] = k[e] * (1.f + (av[e] - 1.f) * PRM[6 * 64 + 8 * cg + e]); bc += r[e] * k2[e] * PRM[7 * 64 + 8 * cg + e]; }
              ss = sum8(ss); bc = sum8(bc); const float rn = 1.f / sqrtf(fmaxf(ss, 1e-24f));
#pragma unroll
              for (int e = 0; e < 8; ++e) { kk[e] *= rn; bb[e] = kk[e] * av[e]; }
              if (cg == 0) P.BC[(size_t)h * M + gr] = bc; }
            SB();
            if (h + 1 < RH) HL_LOADA(h + 1);
            SB();
            asm volatile("s_waitcnt lgkmcnt(0)" ::: "memory"); __builtin_amdgcn_s_barrier(); SB();
            { const int pk_ = F.tid & 63, ptq = F.tid >> 6; float run = 0.f;
#pragma unroll
              for (int i = 0; i < 8; ++i) { run += cum[(8 * ptq + i) * 68 + pk_]; cum[(8 * ptq + i) * 68 + pk_] = run; }
              seg[ptq * 64 + pk_] = run;
              asm volatile("s_waitcnt lgkmcnt(0)" ::: "memory"); __builtin_amdgcn_s_barrier(); SB();
              float off = 0.f;
              for (int q = 0; q < ptq; ++q) off += seg[q * 64 + pk_];
#pragma unroll
              for (int i = 0; i < 8; ++i) cum[(8 * ptq + i) * 68 + pk_] += off; }
            asm volatile("s_waitcnt lgkmcnt(0)" ::: "memory"); __builtin_amdgcn_s_barrier(); SB();
            { float cmv[8], ccv[8];
              { const f32x4 c0 = *(const LAS f32x4*)(cum + t * 68 + 8 * cg), c1 = *(const LAS f32x4*)(cum + t * 68 + 8 * cg + 4), d0 = *(const LAS f32x4*)(cum + 63 * 68 + 8 * cg), d1 = *(const LAS f32x4*)(cum + 63 * 68 + 8 * cg + 4);
#pragma unroll
                for (int e = 0; e < 4; ++e) { cmv[e] = c0[e]; cmv[4 + e] = c1[e]; ccv[e] = d0[e]; ccv[4 + e] = d1[e]; } }
              float at[8], bt[8], kt[8], rt[8];
#pragma unroll
              for (int e = 0; e < 8; ++e) { const float cm = cmv[e], cC = ccv[e];
                  const float ein = __expf(cm), einv = __expf(-cm), eex = __expf(cm - lwv[e]), ed = __expf(cC - cm);
                  at[e] = -kk[e] * eex; bt[e] = bb[e] * einv; kt[e] = k2[e] * einv; rt[e] = r[e] * ein;
                  const unsigned pbd = pk2(bb[e] * ed, k2[e] * ed);
                  BdT[(8 * cg + e) * RPP + t] = (bf16)(pbd & 0xffffu); KdT[(8 * cg + e) * RPP + t] = (bf16)(pbd >> 16);
                  VT[(8 * cg + e) * RPP + t] = (bf16)(pk2(v[e], 0.f) & 0xffffu); }
              *(LAS u32x4*)(At + t * RPP + 8 * cg) = pack8(at); *(LAS u32x4*)(Bt + t * RPP + 8 * cg) = pack8(bt); *(LAS u32x4*)(Kt + t * RPP + 8 * cg) = pack8(kt); *(LAS u32x4*)(Rt + t * RPP + 8 * cg) = pack8(rt);
              if (F.tid < 64) ((GAS float*)(ck + CK_GC))[F.tid] = __expf(cum[63 * 68 + F.tid]); }
            asm volatile("s_waitcnt lgkmcnt(0)" ::: "memory"); __builtin_amdgcn_s_barrier(); SB();
            rwkv_chunk_tail(F, ck, At, Bt, Kt, Rt, BdT, KdT, VT, Lak, Mrb, Mrk, Lm, Tbb);
        }
    }
}

constexpr int SC_SLOT = 8192 + 2048 + 512, SC_NS = 14;
static_assert(SC_NS * SC_SLOT <= MISC_OFF, "scan ring");
DI void rwkv_scan_phase(const Frame& F, int h, int vs) {
    LAS unsigned char* const lds = F.lds;
    const int lane = F.lane, w = F.wave, g4 = lane >> 4;
    if (w >= 4) {
        const int lw_ = w - 4;
#define SC_DMA(cc) do { const int cq_ = (cc) < NCH ? (cc) : NCH - 1; const unsigned char* ck_ = ck_ptr(F, cq_, h); LAS unsigned char* sl_ = lds + ((cc) % SC_NS) * SC_SLOT; \
            _Pragma("unroll") for (int i_ = 0; i_ < 2; ++i_) __builtin_amdgcn_global_load_lds((const unsigned*)(ck_ + CK_PL + (size_t)((lw_ * 2 + i_) * 64 + lane) * 16), (LAS unsigned*)(sl_ + (lw_ * 2 + i_) * 1024), 16, 0, 0); \
            if (lw_ < 2) __builtin_amdgcn_global_load_lds((const unsigned*)(ck_ + CK_Q + (size_t)vs * 2048 + (size_t)(lw_ * 64 + lane) * 16), (LAS unsigned*)(sl_ + 8192 + lw_ * 1024), 16, 0, 0); \
            else __builtin_amdgcn_global_load_lds((const unsigned*)(ck_ + CK_GC + (size_t)lane * 4), (LAS unsigned*)(sl_ + 10240 + (lw_ - 2) * 256), 4, 0, 0); } while (0)
        for (int cc = 0; cc < SC_NS - 1; ++cc) SC_DMA(cc);
        asm volatile("s_waitcnt vmcnt(33)" ::: "memory");
        __builtin_amdgcn_s_barrier();
        for (int c = 0; c < NCH; ++c) {
            SC_DMA(c + SC_NS - 1);
            asm volatile("s_waitcnt vmcnt(33)" ::: "memory");
            __builtin_amdgcn_s_barrier();
        }
#undef SC_DMA
    } else if (w == 0) {
        f32x4 Hf[4];
#pragma unroll
        for (int mt = 0; mt < 4; ++mt) Hf[mt] = (f32x4){0.f, 0.f, 0.f, 0.f};
        __builtin_amdgcn_s_barrier();
        f32x4 gqA[4], gqB[4]; u32x2 qqA[4], qqB[4]; bf16x8 pfA[4][2], pfB[4][2];
#define SC_LDS(cc, gq, qq, pf) do { const LAS unsigned char* sl = lds + ((cc) % SC_NS) * SC_SLOT; \
            _Pragma("unroll") for (int mt = 0; mt < 4; ++mt) { gq[mt] = *(const LAS f32x4*)(sl + 10240 + (16 * mt + 4 * g4) * 4); qq[mt] = *(const LAS u32x2*)(sl + 8192 + (size_t)(mt * 64 + lane) * 8); \
                _Pragma("unroll") for (int ks = 0; ks < 2; ++ks) pf[mt][ks] = *(const LAS bf16x8*)(sl + (size_t)((mt * 2 + ks) * 64 + lane) * 16); } } while (0)
#define SC_STEP(c, gq, qq, pf, gqn, qqn, pfn) do { \
            SC_LDS((c) + 1, gqn, qqn, pfn); SB(); \
            f32x4 acc[4]; \
            bf16x8 hb[2]; hb[0] = pack_pi(Hf[0], Hf[1]); hb[1] = pack_pi(Hf[2], Hf[3]); \
            unsigned char* ck = ck_ptr(F, (c), h); \
            _Pragma("unroll") for (int ks = 0; ks < 2; ++ks) *(GAS bf16x8*)(ck + CK_H + (size_t)((vs * 2 + ks) * 64 + lane) * 16) = hb[ks]; \
            _Pragma("unroll") for (int mt = 0; mt < 4; ++mt) { const f32x4 qf = {bflo(qq[mt].x), bfhi(qq[mt].x), bflo(qq[mt].y), bfhi(qq[mt].y)}; acc[mt] = gq[mt] * Hf[mt] + qf; } \
            _Pragma("unroll") for (int ks = 0; ks < 2; ++ks) \
                _Pragma("unroll") for (int mt = 0; mt < 4; ++mt) acc[mt] = __builtin_amdgcn_mfma_f32_16x16x32_bf16(pf[mt][ks], hb[ks], acc[mt], 0, 0, 0); \
            _Pragma("unroll") for (int mt = 0; mt < 4; ++mt) Hf[mt] = acc[mt]; \
            SB(); \
            asm volatile("s_waitcnt lgkmcnt(0)" ::: "memory"); \
            __builtin_amdgcn_s_barrier(); } while (0)
        SC_LDS(0, gqA, qqA, pfA);
        for (int c = 0; c < NCH; c += 2) {
            SC_STEP(c, gqA, qqA, pfA, gqB, qqB, pfB);
            SC_STEP(c + 1, gqB, qqB, pfB, gqA, qqA, pfA);
        }
#undef SC_STEP
#undef SC_LDS
    } else {
        for (int c = 0; c <= NCH; ++c) __builtin_amdgcn_s_barrier();
    }
}

DI float sum16(float v) { v += __builtin_bit_cast(float, __builtin_amdgcn_update_dpp(0, __builtin_bit_cast(int, v), 0xB1, 0xF, 0xF, true));
                          v += __builtin_bit_cast(float, __builtin_amdgcn_update_dpp(0, __builtin_bit_cast(int, v), 0x4E, 0xF, 0xF, true));
                          v += __builtin_bit_cast(float, __builtin_amdgcn_update_dpp(0, __builtin_bit_cast(int, v), 0x141, 0xF, 0xF, true));
                          v += __builtin_bit_cast(float, __builtin_amdgcn_update_dpp(0, __builtin_bit_cast(int, v), 0x140, 0xF, 0xF, true)); return v; }
DI void rwkv_post_phase(const Frame& F, const CAS Args& a, int l) {
    const RwPrep P = rwprep_ptrs(F);
    bf16* ycat = (bf16*)(F.ws + WS_R3);
    const int lane = F.lane, n = lane & 15, g4 = lane >> 4;
    const int gw = F.bid * 8 + F.wave, NGW = F.G * 8;
#define XSUM(v) do { v += __builtin_bit_cast(float, __builtin_amdgcn_ds_bpermute(a16, __builtin_bit_cast(int, v))); v += __builtin_bit_cast(float, __builtin_amdgcn_ds_bpermute(a32, __builtin_bit_cast(int, v))); } while (0)
    for (int it = gw; it < NCH * RH * 4; it += NGW) {
        const int mt = it & 3, ch_ = it >> 2, c = ch_ / RH, h = ch_ - c * RH;
        const unsigned char* ck = ck_ptr(F, c, h);
        bf16x8 af[2], hf[4][2]; f32x4 acc[4], lw4[4], lb4[4]; u32x2 vv[4], gg[4];
        const int t = 64 * c + 16 * mt + n; const size_t po = ((size_t)h * M + t) * 64 + 4 * g4;
        int a16 = (lane ^ 16) << 2, a32 = (lane ^ 32) << 2; asm volatile("" : "+v"(a16), "+v"(a32));
#pragma unroll
        for (int ks = 0; ks < 2; ++ks) af[ks] = *(const GAS bf16x8*)(ck + CK_RP + (size_t)((mt * 2 + ks) * 64 + lane) * 16);
#pragma unroll
        for (int nt = 0; nt < 4; ++nt) { acc[nt] = *(const GAS f32x4*)(ck + CK_O0 + (size_t)((nt * 4 + mt) * 64 + lane) * 16);
#pragma unroll
            for (int ks = 0; ks < 2; ++ks) hf[nt][ks] = *(const GAS bf16x8*)(ck + CK_H + (size_t)((nt * 2 + ks) * 64 + lane) * 16);
            vv[nt] = *(const GAS u32x2*)(P.V + po + 16 * nt); gg[nt] = *(const GAS u32x2*)(P.G + po + 16 * nt); }
        const float bcv = P.BC[(size_t)h * M + t];
#pragma unroll
        for (int nt = 0; nt < 4; ++nt) { lw4[nt] = *(const GAS f32x4*)(a.in[23] + (size_t)l * RW + h * 64 + 16 * nt + 4 * g4); lb4[nt] = *(const GAS f32x4*)(a.in[24] + (size_t)l * RW + h * 64 + 16 * nt + 4 * g4); }
        SB();
#pragma unroll
        for (int nt = 0; nt < 4; ++nt)
#pragma unroll
            for (int ks = 0; ks < 2; ++ks) acc[nt] = __builtin_amdgcn_mfma_f32_16x16x32_bf16(hf[nt][ks], af[ks], acc[nt], 0, 0, 0);
        float s = 0.f;
#pragma unroll
        for (int nt = 0; nt < 4; ++nt) s += (acc[nt][0] + acc[nt][1]) + (acc[nt][2] + acc[nt][3]);
        XSUM(s); const float mean = s * (1.f / 64.f);
        float vs = 0.f;
#pragma unroll
        for (int nt = 0; nt < 4; ++nt)
#pragma unroll
            for (int r = 0; r < 4; ++r) { const float d = acc[nt][r] - mean; vs += d * d; }
        XSUM(vs); const float rstd = 1.f / sqrtf(vs * (1.f / 64.f) + 64e-5f);
#pragma unroll
        for (int nt = 0; nt < 4; ++nt) { const float v0 = bflo(vv[nt].x), v1 = bfhi(vv[nt].x), v2 = bflo(vv[nt].y), v3 = bfhi(vv[nt].y), g0 = bflo(gg[nt].x), g1 = bfhi(gg[nt].x), g2 = bflo(gg[nt].y), g3 = bfhi(gg[nt].y);
            const float y0 = ((acc[nt][0] - mean) * rstd * lw4[nt][0] + lb4[nt][0] + bcv * v0) * g0, y1 = ((acc[nt][1] - mean) * rstd * lw4[nt][1] + lb4[nt][1] + bcv * v1) * g1;
            const float y2 = ((acc[nt][2] - mean) * rstd * lw4[nt][2] + lb4[nt][2] + bcv * v2) * g2, y3 = ((acc[nt][3] - mean) * rstd * lw4[nt][3] + lb4[nt][3] + bcv * v3) * g3;
            u32x2 o; o.x = pk2(y0, y1); o.y = pk2(y2, y3);
            *(GAS u32x2*)(ycat + (size_t)t * D + S5W + h * 64 + 16 * nt + 4 * g4) = o; }
    }
#undef XSUM
}
constexpr size_t GK_E = 0, GK_H = 32768, GK_GC = 49152, GK_SIZE = 49408;
DI unsigned char* gk_ptr(const Frame& F, int c, int h) { return F.ws + WS_GK + ((size_t)c * GH + h) * GK_SIZE; }
constexpr int GP_CUM = 0, GP_SEG = 17408, GP_KDT = GP_SEG + 2048, GP_VT = GP_KDT + 9216, GP_QT = GP_VT + 18432, GP_KT = GP_QT + 9216, GP_ATT = GP_KT + 9216, GP_PART = GP_ATT + 9216, GP_END = GP_PART + 2048;
static_assert(GP_END <= MISC_OFF, "gla LDS");

DI void gla_store_vt(const Frame& F, const u32x4 (&rv)[2], LAS bf16* VT) {
#pragma unroll
    for (int half = 0; half < 2; ++half) { const int t = F.tid >> 3, v0 = 64 * half + 8 * (F.tid & 7); float f[8]; unpack8(rv[half], f);
#pragma unroll
        for (int e = 0; e < 8; ++e) VT[(v0 + e) * RPP + t] = (bf16)(pk2(f[e], 0.f) & 0xffffu); }
}
DI void gla_pre_phase(const Frame& F, const CAS Args& a, int l) {
    const bf16* Z = (const bf16*)(F.ws + WS_R2);
    LAS float* const cum = (LAS float*)(F.lds + GP_CUM); LAS float* const seg = (LAS float*)(F.lds + GP_SEG);
    LAS bf16* const KdT = (LAS bf16*)(F.lds + GP_KDT); LAS bf16* const VT = (LAS bf16*)(F.lds + GP_VT);
    const int lane = F.lane, w = F.wave, n = lane & 15, g4 = lane >> 4;
    const int t = F.tid >> 3, cg = F.tid & 7;
    u32x4 rv[2], rk, rq, ra0, ra1;
#define GP_LOADZ(itx) do { const int c_ = (itx) / GH, h_ = (itx) - c_ * GH; const bf16* zr_ = Z + (size_t)(64 * c_ + t) * ZP; \
        rv[0] = *(const GAS u32x4*)(zr_ + ZC_GV + h_ * 128 + 8 * cg); rv[1] = *(const GAS u32x4*)(zr_ + ZC_GV + h_ * 128 + 64 + 8 * cg); \
        rk = *(const GAS u32x4*)(zr_ + ZC_GKK + h_ * 64 + 8 * cg); rq = *(const GAS u32x4*)(zr_ + ZC_GQ + h_ * 64 + 8 * cg); \
        ra0 = *(const GAS u32x4*)(zr_ + ZC_GA); ra1 = *(const GAS u32x4*)(zr_ + ZC_GA + 8); } while (0)
    if (F.bid < NCH * GH) GP_LOADZ(F.bid);
    for (int it = F.bid; it < NCH * GH; it += F.G) {
        const int c = it / GH, h = it - c * GH;
        unsigned char* const gk = gk_ptr(F, c, h);
        unsigned char* const qkimg = F.ws + WS_GQK + (size_t)it * 16384; unsigned char* const vimg = F.ws + WS_GVP + (size_t)it * 16384;
        { const float* alora = a.in[29] + (size_t)l * 16 * GK + h * 64 + 8 * cg; const float* abias = a.in[30] + (size_t)l * GK + h * 64 + 8 * cg;
          const f32x4 b0 = *(const GAS f32x4*)abias, b1 = *(const GAS f32x4*)(abias + 4);
          f32x4 w0[16], w1[16];
#pragma unroll
          for (int j = 0; j < 16; ++j) { w0[j] = *(const GAS f32x4*)(alora + (size_t)j * GK); w1[j] = *(const GAS f32x4*)(alora + (size_t)j * GK + 4); }
          SB();
          float ain[16]; { float f0[8], f1[8]; unpack8(ra0, f0); unpack8(ra1, f1);
#pragma unroll
              for (int e = 0; e < 8; ++e) { ain[e] = f0[e]; ain[8 + e] = f1[e]; } }
          float x[8]; x[0] = b0[0]; x[1] = b0[1]; x[2] = b0[2]; x[3] = b0[3]; x[4] = b1[0]; x[5] = b1[1]; x[6] = b1[2]; x[7] = b1[3];
#pragma unroll
          for (int j = 0; j < 16; ++j) {
#pragma unroll
              for (int e = 0; e < 4; ++e) { x[e] += ain[j] * w0[j][e]; x[4 + e] += ain[j] * w1[j][e]; } }
          f32x4 o0, o1;
#pragma unroll
          for (int e = 0; e < 4; ++e) { o0[e] = -softplusf_(-x[e]) * (1.f / 16.f); o1[e] = -softplusf_(-x[4 + e]) * (1.f / 16.f); }
          *(LAS f32x4*)(cum + t * 68 + 8 * cg) = o0; *(LAS f32x4*)(cum + t * 68 + 8 * cg + 4) = o1; }
        __syncthreads();
        { const int k = F.tid & 63, tq = F.tid >> 6; float run = 0.f;
#pragma unroll
          for (int i = 0; i < 8; ++i) { run += cum[(8 * tq + i) * 68 + k]; cum[(8 * tq + i) * 68 + k] = run; }
          seg[tq * 64 + k] = run;
          __syncthreads();
          float off = 0.f;
          for (int q = 0; q < tq; ++q) off += seg[q * 64 + k];
#pragma unroll
          for (int i = 0; i < 8; ++i) cum[(8 * tq + i) * 68 + k] += off; }
        __syncthreads();
        { float kf[8], qf[8]; unpack8(rk, kf); unpack8(rq, qf);
          const f32x4 c0 = *(const LAS f32x4*)(cum + t * 68 + 8 * cg), c1 = *(const LAS f32x4*)(cum + t * 68 + 8 * cg + 4), d0 = *(const LAS f32x4*)(cum + 63 * 68 + 8 * cg), d1 = *(const LAS f32x4*)(cum + 63 * 68 + 8 * cg + 4);
          float qt[8], kt[8];
#pragma unroll
          for (int e = 0; e < 8; ++e) { const float cm = (e < 4 ? c0[e] : c1[e - 4]); const float ed = __expf((e < 4 ? d0[e] : d1[e - 4]) - cm); KdT[(8 * cg + e) * RPP + t] = (bf16)(pk2(kf[e] * ed, 0.f) & 0xffffu);
              qt[e] = qf[e] * 0.125f * __expf(cm); kt[e] = kf[e] * __expf(-cm); }
          { const int q3 = cg & 3; unsigned char* const qd = qkimg + (size_t)((((t >> 4) * 2 + (cg >> 2)) * 64 + (2 * (q3 & 1)) * 16 + (t & 15)) * 16 + (q3 >> 1) * 8);
            u32x2 o; o.x = pk2(qt[0], qt[1]); o.y = pk2(qt[2], qt[3]); *(GAS u32x2*)qd = o; o.x = pk2(qt[4], qt[5]); o.y = pk2(qt[6], qt[7]); *(GAS u32x2*)(qd + 256) = o;
            o.x = pk2(kt[0], kt[1]); o.y = pk2(kt[2], kt[3]); *(GAS u32x2*)(qd + 8192) = o; o.x = pk2(kt[4], kt[5]); o.y = pk2(kt[6], kt[7]); *(GAS u32x2*)(qd + 8192 + 256) = o; }
          if (F.tid < 64) ((GAS float*)(gk + GK_GC))[F.tid] = __expf(cum[63 * 68 + F.tid]); }
        gla_store_vt(F, rv, VT);
        SB();
        { const int itn = it + F.G; if (itn < NCH * GH) GP_LOADZ(itn); }
        SB();
        asm volatile("s_waitcnt lgkmcnt(0)" ::: "memory"); __builtin_amdgcn_s_barrier(); SB();
        { bf16x8 vf[2], kf_[4][2];
#pragma unroll
          for (int ks = 0; ks < 2; ++ks) { *(GAS bf16x8*)(vimg + (size_t)((w * 2 + ks) * 64 + lane) * 16) = ld_pi(VT + (16 * w + n) * RPP, ks, g4);
              vf[ks] = *(const LAS bf16x8*)(VT + (16 * w + n) * RPP + 32 * ks + 8 * g4);
#pragma unroll
              for (int mt = 0; mt < 4; ++mt) kf_[mt][ks] = *(const LAS bf16x8*)(KdT + (16 * mt + n) * RPP + 32 * ks + 8 * g4); }
          SB();
#pragma unroll
          for (int mt = 0; mt < 4; ++mt) { f32x4 acc = {0.f, 0.f, 0.f, 0.f};
#pragma unroll
              for (int ks = 0; ks < 2; ++ks) acc = __builtin_amdgcn_mfma_f32_16x16x32_bf16(kf_[mt][ks], vf[ks], acc, 0, 0, 0);
              *(GAS f32x4*)(gk + GK_E + (size_t)((w * 4 + mt) * 64 + lane) * 16) = acc; } }
        asm volatile("s_waitcnt lgkmcnt(0)" ::: "memory"); __builtin_amdgcn_s_barrier(); SB();
    }
#undef GP_LOADZ
}
DI void gla_scan_wave(const Frame& F, int item) {
    const int mt = item & 3, vs = (item >> 2) & 7, h = item >> 5;
    const int lane = F.lane, g4 = lane >> 4;
    f32x4 H = {0.f, 0.f, 0.f, 0.f};
    constexpr int U = 16;
    for (int c0 = 0; c0 < NCH; c0 += U) {
        f32x4 e[U], g[U];
#pragma unroll
        for (int u = 0; u < U; ++u) { const unsigned char* gk = gk_ptr(F, c0 + u, h); e[u] = *(const GAS f32x4*)(gk + GK_E + (size_t)((vs * 4 + mt) * 64 + lane) * 16); g[u] = *(const GAS f32x4*)(gk + GK_GC + (16 * mt + 4 * g4) * 4); }
        SB();
#pragma unroll
        for (int u = 0; u < U; ++u) { unsigned char* gk = gk_ptr(F, c0 + u, h);
            u32x2 o; o.x = pk2(H[0], H[1]); o.y = pk2(H[2], H[3]);
            *(GAS u32x2*)(gk + GK_H + (size_t)((vs * 2 + (mt >> 1)) * 64 + lane) * 16 + (mt & 1) * 8) = o;
            H = g[u] * H + e[u]; }
    }
}
#define GLDU(T, ubase, loff) (*(const GAS T*)((const unsigned char*)(ubase) + (loff)))
DI void gla_post_item(const Frame& F, const CAS Args& a, int l, int item) {
    const bf16* Z = (const bf16*)(F.ws + WS_R2);
    bf16* ycat = (bf16*)(F.ws + WS_R3);
    const int lane = F.lane, n = lane & 15, g4 = lane >> 4;
    const int mt = item & 3, ch_ = item >> 2, c = ch_ / GH, h = ch_ - c * GH;
    const unsigned char* const gk = gk_ptr(F, c, h) + GK_H;
    const unsigned char* const qk = F.ws + WS_GQK + (size_t)ch_ * 16384;
    const unsigned char* const vp = F.ws + WS_GVP + (size_t)ch_ * 16384;
    unsigned lo16 = (unsigned)lane * 16u; asm volatile("" : "+v"(lo16));
    bf16x8 qf[2], kf[4][2], hA[4][2], vA[4][2];
#pragma unroll
    for (int ks = 0; ks < 2; ++ks) qf[ks] = GLDU(bf16x8, qk + (mt * 2 + ks) * 1024, lo16);
#pragma unroll
    for (int ms = 0; ms < 4; ++ms)
#pragma unroll
        for (int ks = 0; ks < 2; ++ks) kf[ms][ks] = GLDU(bf16x8, qk + 8192 + (ms * 2 + ks) * 1024, lo16);
#pragma unroll
    for (int vt = 0; vt < 4; ++vt)
#pragma unroll
        for (int ks = 0; ks < 2; ++ks) { hA[vt][ks] = GLDU(bf16x8, gk + (vt * 2 + ks) * 1024, lo16); vA[vt][ks] = GLDU(bf16x8, vp + (vt * 2 + ks) * 1024, lo16); }
    SB();
    bf16x8 Pb[2];
    { f32x4 att[4];
#pragma unroll
      for (int ms = 0; ms < 4; ++ms) { att[ms] = (f32x4){0.f, 0.f, 0.f, 0.f};
          if (ms <= mt) {
#pragma unroll
              for (int ks = 0; ks < 2; ++ks) att[ms] = __builtin_amdgcn_mfma_f32_16x16x32_bf16(kf[ms][ks], qf[ks], att[ms], 0, 0, 0);
              if (ms == mt) {
#pragma unroll
                  for (int r = 0; r < 4; ++r) att[ms][r] = ((4 * g4 + r) <= n) ? att[ms][r] : 0.f; } } }
      Pb[0] = pack_pi(att[0], att[1]); Pb[1] = pack_pi(att[2], att[3]); }
    SB();
    bf16x8 hB[4][2], vB[4][2]; u32x2 gzr[8];
    const int tl = 64 * c + 16 * mt + n;
#pragma unroll
    for (int vt = 0; vt < 4; ++vt)
#pragma unroll
        for (int ks = 0; ks < 2; ++ks) { hB[vt][ks] = GLDU(bf16x8, gk + ((vt + 4) * 2 + ks) * 1024, lo16); vB[vt][ks] = GLDU(bf16x8, vp + ((vt + 4) * 2 + ks) * 1024, lo16); }
#pragma unroll
    for (int vt = 0; vt < 8; ++vt) gzr[vt] = *(const GAS u32x2*)(Z + (size_t)tl * ZP + ZC_GG + h * 128 + 16 * vt + 4 * g4);
    SB();
    f32x4 acc[8];
#pragma unroll
    for (int vt = 0; vt < 4; ++vt) { acc[vt] = (f32x4){0.f, 0.f, 0.f, 0.f};
#pragma unroll
        for (int ks = 0; ks < 2; ++ks) acc[vt] = __builtin_amdgcn_mfma_f32_16x16x32_bf16(hA[vt][ks], qf[ks], acc[vt], 0, 0, 0);
        acc[vt] = __builtin_amdgcn_mfma_f32_16x16x32_bf16(vA[vt][0], Pb[0], acc[vt], 0, 0, 0);
        if (mt >= 2) acc[vt] = __builtin_amdgcn_mfma_f32_16x16x32_bf16(vA[vt][1], Pb[1], acc[vt], 0, 0, 0); }
    SB();
#pragma unroll
    for (int vt = 0; vt < 4; ++vt) { acc[4 + vt] = (f32x4){0.f, 0.f, 0.f, 0.f};
#pragma unroll
        for (int ks = 0; ks < 2; ++ks) acc[4 + vt] = __builtin_amdgcn_mfma_f32_16x16x32_bf16(hB[vt][ks], qf[ks], acc[4 + vt], 0, 0, 0);
        acc[4 + vt] = __builtin_amdgcn_mfma_f32_16x16x32_bf16(vB[vt][0], Pb[0], acc[4 + vt], 0, 0, 0);
        if (mt >= 2) acc[4 + vt] = __builtin_amdgcn_mfma_f32_16x16x32_bf16(vB[vt][1], Pb[1], acc[4 + vt], 0, 0, 0); }
    SB();
    f32x4 ngv[8];
    { const float* ngp = a.in[31] + (size_t)l * GV + h * 128 + 4 * g4;
#pragma unroll
      for (int vt = 0; vt < 8; ++vt) ngv[vt] = *(const GAS f32x4*)(ngp + 16 * vt); }
    float ss = 0.f;
#pragma unroll
    for (int vt = 0; vt < 8; ++vt)
#pragma unroll
        for (int r = 0; r < 4; ++r) ss += acc[vt][r] * acc[vt][r];
    { int a16 = (lane ^ 16) << 2, a32 = (lane ^ 32) << 2; asm volatile("" : "+v"(a16), "+v"(a32));
      ss += __builtin_bit_cast(float, __builtin_amdgcn_ds_bpermute(a16, __builtin_bit_cast(int, ss)));
      ss += __builtin_bit_cast(float, __builtin_amdgcn_ds_bpermute(a32, __builtin_bit_cast(int, ss))); }
    const float rn = 1.f / sqrtf(ss * (1.f / 128.f) + NORM_EPS);
    SB();
#pragma unroll
    for (int vt = 0; vt < 8; ++vt) { const float g0 = bflo(gzr[vt].x), g1 = bfhi(gzr[vt].x), g2 = bflo(gzr[vt].y), g3 = bfhi(gzr[vt].y);
        const float y0 = acc[vt][0] * rn * ngv[vt][0] * g0 * sigmoidf_(g0), y1 = acc[vt][1] * rn * ngv[vt][1] * g1 * sigmoidf_(g1);
        const float y2 = acc[vt][2] * rn * ngv[vt][2] * g2 * sigmoidf_(g2), y3 = acc[vt][3] * rn * ngv[vt][3] * g3 * sigmoidf_(g3);
        u32x2 o; o.x = pk2(y0, y1); o.y = pk2(y2, y3);
        *(GAS u32x2*)(ycat + (size_t)tl * D + S5W + RW + h * 128 + 16 * vt + 4 * g4) = o; }
}
DI void gla_post_phase(const Frame& F, const CAS Args& a, int l) {
    constexpr int NIT = NCH * GH * 4;
    const int NGW = F.G * 8, rounds = NIT / NGW, rem = NIT - rounds * NGW, per = rem / F.G, left = rem - per * F.G;
    const int wv = __builtin_amdgcn_readfirstlane(F.wave);
    for (int r = 0; r < rounds; ++r) gla_post_item(F, a, l, r * NGW + F.bid * 8 + wv);
    if (wv < per) gla_post_item(F, a, l, rounds * NGW + F.bid * per + wv);
    else if (wv == per && F.bid < left) gla_post_item(F, a, l, rounds * NGW + F.G * per + F.bid);
}
constexpr size_t ALG_BYTES_C = (size_t)64 * 552 * 2;
constexpr size_t S5T_G = 0, S5T_K = 32768, S5T_F = 65536, S5T_L8 = 98304, S5T_LN = 98816, S5T_PN = 99328, S5T_SIZE = 99328 + 8192;
constexpr size_t WS_S5X = WS_S5XA;
static_assert(256 * ALG_BYTES_C <= SZ_HB && (size_t)DEPTH * 48 * S5T_SIZE <= 2 * SZ_HB && WS_S5TA >= WS_R4 + 3 * SZ_HB, "scratch overlays");
constexpr int S5_TW = 0, S5_X0 = 2 * 8 * 128 * 4, S5_END = S5_X0 + 2 * 128 * 4;
static_assert(S5_END <= MISC_OFF, "s5 LDS");

DI void s5_tables(const Frame& F, const CAS Args& a, int l, int g) {
    LAS float* PWr = (LAS float*)F.lds;
    LAS float* PWi = PWr + 9 * 64;
    LAS float* Bbr = PWi + 9 * 64;
    LAS float* Bbi = Bbr + 1024;
    LAS float* Cr = Bbi + 1024;
    LAS float* Ci = Cr + 1024;
    LAS float* Kt = Ci + 1024;
    unsigned char* tb = F.ws + WS_S5TA + ((size_t)l * S5G + g) * S5T_SIZE;
    if (F.tid < 64) { const int p = F.tid; const size_t gp = ((size_t)l * S5G + g) * S5P + p;
        const float lre = fminf(a.in[4][gp], -1e-4f), lim = a.in[5][gp], dt = expf(a.in[6][(size_t)l * S5G + g]);
        const float er = expf(lre * dt); float sn, cs; sincosf(lim * dt, &sn, &cs);
        const float lbr = er * cs, lbi = er * sn;
        const float nr = lbr - 1.f, ni = lbi, den = 1.f / (lre * lre + lim * lim);
        const float fr_ = (nr * lre + ni * lim) * den, fi_ = (ni * lre - nr * lim) * den;
#pragma unroll
        for (int jj = 0; jj < 16; ++jj) { const float br = a.in[7][gp * 16 + jj], bi = a.in[8][gp * 16 + jj]; Bbr[p * 16 + jj] = fr_ * br - fi_ * bi; Bbi[p * 16 + jj] = fr_ * bi + fi_ * br; }
        float pr = 1.f, pi = 0.f;
#pragma unroll
        for (int nn = 0; nn < 9; ++nn) { PWr[nn * 64 + p] = pr; PWi[nn * 64 + p] = pi; const float t0 = pr * lbr - pi * lbi, t1 = pr * lbi + pi * lbr; pr = t0; pi = t1; }
        float qr = PWr[8 * 64 + p], qi = PWi[8 * 64 + p];
        ((GAS float*)(tb + S5T_L8))[p] = qr; ((GAS float*)(tb + S5T_L8))[64 + p] = qi;
        { float ur = 1.f, ui = 0.f;
#pragma unroll
          for (int nn = 0; nn < 16; ++nn) { ((GAS float*)(tb + S5T_PN))[nn * 128 + p] = ur; ((GAS float*)(tb + S5T_PN))[nn * 128 + 64 + p] = ui; const float t0 = ur * qr - ui * qi, t1 = ur * qi + ui * qr; ur = t0; ui = t1; } }
#pragma unroll
        for (int s = 0; s < 7; ++s) { const float t0 = qr * qr - qi * qi, t1 = 2.f * qr * qi; qr = t0; qi = t1; }
        ((GAS float*)(tb + S5T_LN))[p] = qr; ((GAS float*)(tb + S5T_LN))[64 + p] = qi; }
    for (int q = F.tid; q < 1024; q += 512) { const int i = q >> 6, pp = q & 63; const size_t ci = (((size_t)l * S5G + g) * 16 + i) * S5P + pp; Cr[q] = a.in[9][ci]; Ci[q] = a.in[10][ci]; }
    __syncthreads();
    { const int tau = F.tid >> 6, i = (F.tid >> 2) & 15, j0 = (F.tid & 3) * 4; float s[4] = {0.f, 0.f, 0.f, 0.f};
      for (int p = 0; p < 64; ++p) { const float cr = Cr[i * 64 + p], ci = Ci[i * 64 + p], wr = PWr[tau * 64 + p], wi = PWi[tau * 64 + p];
          const float mr = cr * wr - ci * wi, mi = cr * wi + ci * wr;
#pragma unroll
          for (int e = 0; e < 4; ++e) s[e] += mr * Bbr[p * 16 + j0 + e] - mi * Bbi[p * 16 + j0 + e]; }
#pragma unroll
      for (int e = 0; e < 4; ++e) Kt[(tau * 16 + i) * 16 + j0 + e] = s[e]; }
    __syncthreads();
    { const int row = F.tid >> 2, c0 = (F.tid & 3) * 32;
#pragma unroll
      for (int q8 = 0; q8 < 4; ++q8) { float gv[8], kv[8], fv[8];
#pragma unroll
          for (int e = 0; e < 8; ++e) { const int col = c0 + 8 * q8 + e;
              { const int p = row & 63, part = row >> 6, b = col >> 4, j = col & 15; const float wr = PWr[(7 - b) * 64 + p], wi = PWi[(7 - b) * 64 + p], br = Bbr[p * 16 + j], bi = Bbi[p * 16 + j];
                gv[e] = part == 0 ? (wr * br - wi * bi) : (wr * bi + wi * br); }
              { const int bt = row >> 4, i = row & 15, bs = col >> 4, j = col & 15; kv[e] = (bs <= bt) ? Kt[((bt - bs) * 16 + i) * 16 + j] : 0.f; }
              { const int b = row >> 4, i = row & 15; const int pks = col >> 5, pkg = (col >> 3) & 3, pj = col & 7, pp = 16 * (2 * pks + (pj >> 2)) + 4 * pkg + (pj & 3);
                const int p = pp & 63, part = pp >> 6; const float cr = Cr[i * 64 + p], ci = Ci[i * 64 + p], wr = PWr[(b + 1) * 64 + p], wi = PWi[(b + 1) * 64 + p];
                fv[e] = part == 0 ? (cr * wr - ci * wi) : -(cr * wi + ci * wr); } }
          const int colb = c0 + 8 * q8; const size_t fo = ((size_t)(((row >> 4) * 4 + (colb >> 5)) * 64 + ((colb >> 3) & 3) * 16 + (row & 15))) * 16;
          *(GAS u32x4*)(tb + S5T_G + fo) = pack8(gv); *(GAS u32x4*)(tb + S5T_K + fo) = pack8(kv); *(GAS u32x4*)(tb + S5T_F + fo) = pack8(fv); } }
    __syncthreads();
}

#define LDU(T, ubase, loff) (*(const GAS T*)((const unsigned char*)(ubase) + (loff)))
#define DPPF(v, ctrl) __builtin_bit_cast(float, __builtin_amdgcn_update_dpp(0, __builtin_bit_cast(int, (v)), (ctrl), 0xF, 0xF, true))
template <int CTRL> DI f32x4 dpp4(const f32x4 v) { const float a0 = v[0], a1 = v[1], a2 = v[2], a3 = v[3]; const float b0 = DPPF(a0, CTRL), b1 = DPPF(a1, CTRL), b2 = DPPF(a2, CTRL), b3 = DPPF(a3, CTRL); return (f32x4){b0, b1, b2, b3}; }
template <int D>
DI void s5_scan_step(f32x4 (&Yr)[4], f32x4 (&Yi)[4], f32x4 (&Ar)[4], f32x4 (&Ai)[4]) {
#pragma unroll
    for (int m = 0; m < 4; ++m) {
        const f32x4 sr = dpp4<0x110 + D>(Yr[m]), si = dpp4<0x110 + D>(Yi[m]);
        Yr[m] += Ar[m] * sr - Ai[m] * si; Yi[m] += Ar[m] * si + Ai[m] * sr;
        const f32x4 a2r = Ar[m] * Ar[m] - Ai[m] * Ai[m], a2i = 2.f * Ar[m] * Ai[m]; Ar[m] = a2r; Ai[m] = a2i; }
}
template <bool POST>
DI void s5_phase(const Frame& F, const CAS Args& a, int l, int first, int stride) {
    const bf16* Z = (const bf16*)(F.ws + WS_R2);
    bf16* ypre = (bf16*)(F.ws + WS_R1 + (size_t)M * RW * 4);
    const int lane = F.lane, w = F.wave, n = lane & 15, kg = lane >> 4;
    int par = 0;
    for (int it = first; it < S5G * 16; it += stride, par ^= 1) {
        const int g = it >> 4, ib = it & 15;
        const unsigned char* tb = F.ws + WS_S5TA + ((size_t)l * S5G + g) * S5T_SIZE;
        float* TOT = (float*)(F.ws + WS_S5X) + (size_t)(g * 16) * 128;
        LAS float* const TW = (LAS float*)(F.lds + S5_TW) + par * 8 * 128;
        LAS float* const X0 = (LAS float*)(F.lds + S5_X0) + par * 128;
        const int sb = 128 * ib + 16 * w + n;
        const unsigned char* zb = F.ws + WS_ZS5 + ((size_t)g * M + 8 * (128 * ib + 16 * w)) * 32;
        unsigned lzu = (unsigned)((8 * n + (kg >> 1)) * 32 + (kg & 1) * 16);
        unsigned lzo = (unsigned)(8 * n * 32 + 8 * kg);
        unsigned ltab = (unsigned)lane * 16u;
        unsigned lyo = (unsigned)(8 * n * S5W + 4 * kg) * 2u;
        asm volatile("" : "+v"(lzu), "+v"(lzo), "+v"(ltab), "+v"(lyo));
        bf16x8 uf[4];
#pragma unroll
        for (int ks = 0; ks < 4; ++ks) uf[ks] = LDU(bf16x8, zb + 64 * ks, lzu);
        f32x4 Ar[4], Ai[4];
#pragma unroll
        for (int m = 0; m < 4; ++m) { Ar[m] = *(const GAS f32x4*)((const float*)(tb + S5T_L8) + 16 * m + 4 * kg); Ai[m] = *(const GAS f32x4*)((const float*)(tb + S5T_L8) + 64 + 16 * m + 4 * kg); }
        if (POST && w == 0) { const int p = lane; const float lnr = ((const GAS float*)(tb + S5T_LN))[p], lni = ((const GAS float*)(tb + S5T_LN))[64 + p];
            float xr = 0.f, xi = 0.f;
            for (int q0 = 0; q0 < ib; q0 += 4) { float tr[4], ti[4];
#pragma unroll
                for (int u = 0; u < 4; ++u) { const int q = (q0 + u < ib) ? q0 + u : q0; tr[u] = TOT[q * 128 + p]; ti[u] = TOT[q * 128 + 64 + p]; }
                SB();
#pragma unroll
                for (int u = 0; u < 4; ++u) if (q0 + u < ib) { const float t0 = lnr * xr - lni * xi + tr[u], t1 = lnr * xi + lni * xr + ti[u]; xr = t0; xi = t1; }
                SB(); }
            X0[p] = xr; X0[64 + p] = xi; }
        SB();
        f32x4 Yr[4], Yi[4];
        { bf16x8 gf[2][4];
#pragma unroll
          for (int ks = 0; ks < 4; ++ks) gf[0][ks] = LDU(bf16x8, tb + S5T_G + (0 * 4 + ks) * 1024, ltab);
#pragma unroll
          for (int mt = 0; mt < 8; ++mt) {
              if (mt + 1 < 8) {
#pragma unroll
                  for (int ks = 0; ks < 4; ++ks) gf[(mt + 1) & 1][ks] = LDU(bf16x8, tb + S5T_G + ((mt + 1) * 4 + ks) * 1024, ltab); }
              SB();
              f32x4 acc = {0.f, 0.f, 0.f, 0.f};
#pragma unroll
              for (int ks = 0; ks < 4; ++ks) acc = __builtin_amdgcn_mfma_f32_16x16x32_bf16(gf[mt & 1][ks], uf[ks], acc, 0, 0, 0);
              if (mt < 4) Yr[mt] = acc; else Yi[mt - 4] = acc;
              SB(); } }
        SB();
        s5_scan_step<1>(Yr, Yi, Ar, Ai); SB(); s5_scan_step<2>(Yr, Yi, Ar, Ai); SB(); s5_scan_step<4>(Yr, Yi, Ar, Ai); SB(); s5_scan_step<8>(Yr, Yi, Ar, Ai); SB();
        if (n == 15) {
#pragma unroll
            for (int m = 0; m < 4; ++m) { *(LAS f32x4*)(TW + w * 128 + 16 * m + 4 * kg) = Yr[m]; *(LAS f32x4*)(TW + w * 128 + 64 + 16 * m + 4 * kg) = Yi[m]; } }
        __syncthreads();
        f32x4 Sr[4], Si[4];
#pragma unroll
        for (int m = 0; m < 4; ++m) { Sr[m] = POST ? *(const LAS f32x4*)(X0 + 16 * m + 4 * kg) : (f32x4){0.f, 0.f, 0.f, 0.f}; Si[m] = POST ? *(const LAS f32x4*)(X0 + 64 + 16 * m + 4 * kg) : (f32x4){0.f, 0.f, 0.f, 0.f}; }
        const int nprev = POST ? w : 8;
        for (int q = 0; q < nprev; ++q) {
#pragma unroll
            for (int m = 0; m < 4; ++m) { const f32x4 tr = *(const LAS f32x4*)(TW + q * 128 + 16 * m + 4 * kg), ti = *(const LAS f32x4*)(TW + q * 128 + 64 + 16 * m + 4 * kg);
                const f32x4 nr = Ar[m] * Sr[m] - Ai[m] * Si[m] + tr, ni = Ar[m] * Si[m] + Ai[m] * Sr[m] + ti; Sr[m] = nr; Si[m] = ni; } }
        if (!POST) { if (w == 0 && n == 0) {
#pragma unroll
                for (int m = 0; m < 4; ++m) { *(GAS f32x4*)(TOT + ib * 128 + 16 * m + 4 * kg) = Sr[m]; *(GAS f32x4*)(TOT + ib * 128 + 64 + 16 * m + 4 * kg) = Si[m]; } } }
        if (POST) {
            f32x4 Xr[4], Xi[4], Pr[4], Pi[4];
#pragma unroll
            for (int m = 0; m < 4; ++m) { Pr[m] = *(const GAS f32x4*)((const float*)(tb + S5T_PN) + n * 128 + 16 * m + 4 * kg); Pi[m] = *(const GAS f32x4*)((const float*)(tb + S5T_PN) + n * 128 + 64 + 16 * m + 4 * kg); }
            SB();
#pragma unroll
            for (int m = 0; m < 4; ++m) { const f32x4 yr = dpp4<0x111>(Yr[m]), yi = dpp4<0x111>(Yi[m]); Xr[m] = Pr[m] * Sr[m] - Pi[m] * Si[m] + yr; Xi[m] = Pr[m] * Si[m] + Pi[m] * Sr[m] + yi; }
            bf16x8 xf[4]; xf[0] = pack_pi(Xr[0], Xr[1]); xf[1] = pack_pi(Xr[2], Xr[3]); xf[2] = pack_pi(Xi[0], Xi[1]); xf[3] = pack_pi(Xi[2], Xi[3]);
            SB();
            u32x2 uu[8]; bf16x8 uf2[4];
#pragma unroll
            for (int ks = 0; ks < 4; ++ks) uf2[ks] = LDU(bf16x8, zb + 64 * ks, lzu);
            const f32x4 dv = *(const GAS f32x4*)(a.in[11] + (size_t)l * S5W + 16 * g + 4 * kg);
#pragma unroll
            for (int mt = 0; mt < 8; ++mt) uu[mt] = LDU(u32x2, zb + 32 * mt, lzo);
            { bf16x8 kf[2][4], ff[2][4];
#pragma unroll
              for (int ks = 0; ks < 4; ++ks) { if (2 * ks <= 0) kf[0][ks] = LDU(bf16x8, tb + S5T_K + (0 * 4 + ks) * 1024, ltab); ff[0][ks] = LDU(bf16x8, tb + S5T_F + (0 * 4 + ks) * 1024, ltab); }
#pragma unroll
              for (int mt = 0; mt < 8; ++mt) {
                  if (mt + 1 < 8) {
#pragma unroll
                      for (int ks = 0; ks < 4; ++ks) { if (2 * ks <= mt + 1) kf[(mt + 1) & 1][ks] = LDU(bf16x8, tb + S5T_K + ((mt + 1) * 4 + ks) * 1024, ltab);
                          ff[(mt + 1) & 1][ks] = LDU(bf16x8, tb + S5T_F + ((mt + 1) * 4 + ks) * 1024, ltab); } }
                  SB();
                  f32x4 acc = {0.f, 0.f, 0.f, 0.f};
#pragma unroll
                  for (int ks = 0; ks < 4; ++ks) { if (2 * ks <= mt) acc = __builtin_amdgcn_mfma_f32_16x16x32_bf16(kf[mt & 1][ks], uf2[ks], acc, 0, 0, 0); }
#pragma unroll
                  for (int ks = 0; ks < 4; ++ks) acc = __builtin_amdgcn_mfma_f32_16x16x32_bf16(ff[mt & 1][ks], xf[ks], acc, 0, 0, 0);
                  const float y0 = acc[0] + dv[0] * bflo(uu[mt].x), y1 = acc[1] + dv[1] * bfhi(uu[mt].x), y2 = acc[2] + dv[2] * bflo(uu[mt].y), y3 = acc[3] + dv[3] * bfhi(uu[mt].y);
                  u32x2 o; o.x = pk2(gelu_tanh(y0), gelu_tanh(y1)); o.y = pk2(gelu_tanh(y2), gelu_tanh(y3));
                  *(GAS u32x2*)((unsigned char*)(ypre + (size_t)(8 * (128 * ib + 16 * w) + mt) * S5W + 16 * g) + lyo) = o;
                  SB(); } }
        }
    }
}
constexpr int NPH = 12, NSTEPS = 1 + DEPTH * NPH + 1;
#ifndef MK_PER_STEP
#define MK_PER_STEP 0
#endif
__global__ void __launch_bounds__(512, 2) trunk_fwd(Args args_unused) {
    extern __shared__ __attribute__((aligned(16))) unsigned char lds_raw[];
    LAS unsigned char* const lds = (LAS unsigned char*)lds_raw;
    volatile LAS unsigned* MISC = (volatile LAS unsigned*)(lds + MISC_OFF);
    for (int u = threadIdx.x; u < 128; u += 512) MISC[u] = 0u;
    int wv = __builtin_amdgcn_readfirstlane(threadIdx.x >> 6); asm volatile("" : "+s"(wv));
    __syncthreads();
    const CAS Args* ap0 = (const CAS Args*)__builtin_amdgcn_kernarg_segment_ptr();
    const int lo = ap0->lo, hi = ap0->hi;
    XcdBarrier bar; bar.bar = (unsigned*)(ap0->ws + WS_CTL) + CW_BAR; bar.x = 0; bar.st = MISC + 8; bar.w0 = (wv == 0);
    if ((hi - lo) > 1) bar = xcd_barrier_post(bar.bar, MISC + 8, wv == 0);
#ifndef ONLY_PH
#define ONLY_PH 0xFFFF
#endif
#define PHEN(ph) ((ONLY_PH >> (ph)) & 1)
#define IN(k) (lo <= (k) && (k) < hi)
#define SEAM(k) do { if (IN((k) + 1) && IN(k)) xcd_barrier(bar); } while (0)
#define FRAME() const CAS Args* ap; const Frame F = make_frame(lds, ap, wv); const CAS Args& A = *ap; (void)A
#ifndef REPEAT_MASK
#define REPEAT_MASK 0
#endif
#define REP(ph) ((REPEAT_MASK >> (ph)) & 1)
#ifndef REP2_MASK
#define REP2_MASK 0
#endif
#define REP2(k) ((REP2_MASK >> (k)) & 1)

    if (PHEN(12) && IN(0)) { { FRAME(); float* prm = (float*)(F.ws + WS_PRM);
            for (int e = F.bid * 512 + F.tid; e < DEPTH * RH * 576; e += F.G * 512) { const int i = e & 63, pi = (e >> 6) % 9, lh = e / 576, hh = lh % RH, ll = lh / RH; float val;
                if (pi < 3) val = A.in[14][(size_t)ll * RWCOLS + (pi == 0 ? ZC_R : (pi == 1 ? ZC_K : ZC_V)) - ZC_R + hh * 64 + i];
                else if (pi == 3) val = A.in[16][(size_t)ll * RW + hh * 64 + i]; else if (pi == 4) val = A.in[18][(size_t)ll * RW + hh * 64 + i]; else if (pi == 5) val = A.in[20][(size_t)ll * RW + hh * 64 + i];
                else if (pi == 6) val = A.in[21][(size_t)ll * RW + hh * 64 + i]; else if (pi == 7) val = A.in[22][(size_t)ll * RW + hh * 64 + i];
                else val = (ll > 0) ? A.in[28][(size_t)(ll - 1) * RW + hh * 64 + i] : 0.f;
                prm[e] = val; } }
        { FRAME(); p0_prologue(F, A); __syncthreads(); } { FRAME(); for (int it = F.bid; it < DEPTH * S5G; it += F.G) s5_tables(F, A, it / S5G, it % S5G); } SEAM(0); }

    for (int l = 0; l < DEPTH; ++l) {
        const int s0 = 1 + l * NPH;
        if (REP(0) && PHEN(0) && IN(s0 + 0)) { if (l == 0) { FRAME(); x0_phase(F, A.in[0], (bf16*)F.out, (float*)(F.ws + WS_SSQ)); xcd_barrier(bar); } }
        if (PHEN(0) && IN(s0 + 0)) { if (l == 0) { FRAME(); x0_phase(F, A.in[0], (bf16*)F.out, (float*)(F.ws + WS_SSQ)); SEAM(s0 + 0); } }
        if (REP(1) && PHEN(1) && IN(s0 + 1)) { FRAME();
            const int nN = (l == 0) ? 44 : 45;
            const LAS float* rs = rstd_table(F);
            SchedPlain S; S.init((const bf16*)F.out, XP, (const bf16*)lw(F, l, LW_WIN), D, M / BM, nN, D, F.G, F.bid);
            EpiInproj E{(bf16*)(F.ws + WS_R2), A.in[3] + (size_t)l * 6144, (bf16*)(F.ws + WS_ZS5), rs};
            gemm_phase<EpiInproj, SchedPlain>(F.lds, F.wave, XP, D, S, E);
            xcd_barrier(bar);
        }
        if (PHEN(1) && IN(s0 + 1)) { FRAME();
            const int nN = (l == 0) ? 44 : 45;
            const LAS float* rs = rstd_table(F);
            SchedPlain S; S.init((const bf16*)F.out, XP, (const bf16*)lw(F, l, LW_WIN), D, M / BM, nN, D, F.G, F.bid);
            EpiInproj E{(bf16*)(F.ws + WS_R2), A.in[3] + (size_t)l * 6144, (bf16*)(F.ws + WS_ZS5), rs};
            gemm_phase<EpiInproj, SchedPlain>(F.lds, F.wave, XP, D, S, E);
            SEAM(s0 + 1);
        }
        if (REP(2) && PHEN(2) && IN(s0 + 2)) { FRAME(); rwkv_fused_phase(F, A, l); gla_pre_phase(F, A, l); s5_phase<false>(F, A, l, F.bid, F.G); xcd_barrier(bar); }
        if (PHEN(2) && IN(s0 + 2)) { FRAME(); if (REP2(0)) rwkv_fused_phase(F, A, l); rwkv_fused_phase(F, A, l); if (REP2(1)) gla_pre_phase(F, A, l); gla_pre_phase(F, A, l); if (REP2(2)) s5_phase<false>(F, A, l, F.bid, F.G); s5_phase<false>(F, A, l, F.bid, F.G); SEAM(s0 + 2); }
        if (REP(4) && PHEN(4) && IN(s0 + 4)) { FRAME();
            if (F.bid < 40) rwkv_scan_phase(F, F.bid >> 2, F.bid & 3);
            else if (F.bid < 60) gla_scan_wave(F, (F.bid - 40) * 8 + F.wave);
            else s5_phase<true>(F, A, l, F.bid - 60, F.G - 60);
            xcd_barrier(bar);
        }
        if (PHEN(4) && IN(s0 + 4)) { FRAME();
            if (F.bid < 40) { if (REP2(3)) rwkv_scan_phase(F, F.bid >> 2, F.bid & 3); rwkv_scan_phase(F, F.bid >> 2, F.bid & 3); }
            else if (F.bid < 60) { if (REP2(4)) gla_scan_wave(F, (F.bid - 40) * 8 + F.wave); gla_scan_wave(F, (F.bid - 40) * 8 + F.wave); }
            else { if (REP2(5)) s5_phase<true>(F, A, l, F.bid - 60, F.G - 60); s5_phase<true>(F, A, l, F.bid - 60, F.G - 60); }
            SEAM(s0 + 4);
        }
        if (REP(5) && PHEN(5) && IN(s0 + 5)) { FRAME(); gla_post_phase(F, A, l); rwkv_post_phase(F, A, l); xcd_barrier(bar); }
        if (PHEN(5) && IN(s0 + 5)) { FRAME(); if (REP2(7)) gla_post_phase(F, A, l); gla_post_phase(F, A, l); if (REP2(6)) rwkv_post_phase(F, A, l); rwkv_post_phase(F, A, l); SEAM(s0 + 5); }
        if (REP(6) && PHEN(6) && IN(s0 + 6)) { FRAME();
            const bf16* ypre = (const bf16*)(F.ws + WS_R1 + (size_t)M * RW * 4);
            SchedPlain S; S.init(ypre, S5W, (const bf16*)lw(F, l, LW_GLU), S5W, M / BM, 3, S5W, F.G, F.bid);
            EpiGlu E{ypre, (bf16*)(F.ws + WS_R3), A.in[13] + (size_t)l * S5W};
            gemm_phase<EpiGlu, SchedPlain>(F.lds, F.wave, S5W, S5W, S, E);
            xcd_barrier(bar);
        }
        if (PHEN(6) && IN(s0 + 6)) { FRAME();
            const bf16* ypre = (const bf16*)(F.ws + WS_R1 + (size_t)M * RW * 4);
            SchedPlain S; S.init(ypre, S5W, (const bf16*)lw(F, l, LW_GLU), S5W, M / BM, 3, S5W, F.G, F.bid);
            EpiGlu E{ypre, (bf16*)(F.ws + WS_R3), A.in[13] + (size_t)l * S5W};
            gemm_phase<EpiGlu, SchedPlain>(F.lds, F.wave, S5W, S5W, S, E);
            SEAM(s0 + 6);
        }
        if (REP(7) && PHEN(7) && IN(s0 + 7)) { FRAME();
            SchedSeg3 S; S.init((const bf16*)(F.ws + WS_R3), D, (const bf16*)lw(F, l, LW_WUP), D, M / BM, D / BM, F.G, F.bid);
            EpiMerged E{(const bf16*)(F.ws + WS_R2), (bf16*)(F.ws + WS_R1)};
            gemm_phase<EpiMerged, SchedSeg3>(F.lds, F.wave, D, D, S, E);
            xcd_barrier(bar);
        }
        if (PHEN(7) && IN(s0 + 7)) { FRAME();
            SchedSeg3 S; S.init((const bf16*)(F.ws + WS_R3), D, (const bf16*)lw(F, l, LW_WUP), D, M / BM, D / BM, F.G, F.bid);
            EpiMerged E{(const bf16*)(F.ws + WS_R2), (bf16*)(F.ws + WS_R1)};
            gemm_phase<EpiMerged, SchedSeg3>(F.lds, F.wave, D, D, S, E);
            SEAM(s0 + 7);
        }
        if (REP(8) && PHEN(8) && IN(s0 + 8)) { FRAME();
            SchedPlain S; S.init((const bf16*)(F.ws + WS_R1), D, (const bf16*)lw(F, l, LW_WOUT), D, M / BM, D / BM, D, F.G, F.bid);
            EpiResid E{(const bf16*)F.out, (bf16*)F.out, (float*)(F.ws + WS_SSQ)};
            gemm_phase<EpiResid, SchedPlain>(F.lds, F.wave, D, D, S, E);
            xcd_barrier(bar);
        }
        if (PHEN(8) && IN(s0 + 8)) { FRAME();
            SchedPlain S; S.init((const bf16*)(F.ws + WS_R1), D, (const bf16*)lw(F, l, LW_WOUT), D, M / BM, D / BM, D, F.G, F.bid);
            EpiResid E{(const bf16*)F.out, (bf16*)F.out, (float*)(F.ws + WS_SSQ)};
            gemm_phase<EpiResid, SchedPlain>(F.lds, F.wave, D, D, S, E);
            SEAM(s0 + 8);
        }
        if (REP(10) && PHEN(10) && IN(s0 + 10)) { FRAME();
            const LAS float* rs = rstd_table(F);
            SchedPlain S; S.init((const bf16*)F.out, XP, (const bf16*)lw(F, l, LW_W1), D, M / BM, DFF / BM, D, F.G, F.bid);
            EpiRelu2 E{(bf16*)(F.ws + WS_R2), rs};
            gemm_phase<EpiRelu2, SchedPlain>(F.lds, F.wave, XP, D, S, E);
            xcd_barrier(bar);
        }
        if (PHEN(10) && IN(s0 + 10)) { FRAME();
            const LAS float* rs = rstd_table(F);
            SchedPlain S; S.init((const bf16*)F.out, XP, (const bf16*)lw(F, l, LW_W1), D, M / BM, DFF / BM, D, F.G, F.bid);
            EpiRelu2 E{(bf16*)(F.ws + WS_R2), rs};
            gemm_phase<EpiRelu2, SchedPlain>(F.lds, F.wave, XP, D, S, E);
            SEAM(s0 + 10);
        }
        if (REP(11) && PHEN(11) && IN(s0 + 11)) { FRAME();
            SchedPlain S; S.init((const bf16*)(F.ws + WS_R2), DFF, (const bf16*)lw(F, l, LW_W2), DFF, M / BM, D / BM, DFF, F.G, F.bid);
            EpiResid E{(const bf16*)F.out, (l == DEPTH - 1) ? (bf16*)(F.ws + WS_R1) : (bf16*)F.out, (float*)(F.ws + WS_SSQ)};
            gemm_phase<EpiResid, SchedPlain>(F.lds, F.wave, DFF, DFF, S, E);
            xcd_barrier(bar);
        }
        if (PHEN(11) && IN(s0 + 11)) { FRAME();
            SchedPlain S; S.init((const bf16*)(F.ws + WS_R2), DFF, (const bf16*)lw(F, l, LW_W2), DFF, M / BM, D / BM, DFF, F.G, F.bid);
            EpiResid E{(const bf16*)F.out, (l == DEPTH - 1) ? (bf16*)(F.ws + WS_R1) : (bf16*)F.out, (float*)(F.ws + WS_SSQ)};
            gemm_phase<EpiResid, SchedPlain>(F.lds, F.wave, DFF, DFF, S, E);
            SEAM(s0 + 11);
        }
    }
    if (PHEN(13) && IN(NSTEPS - 1)) { FRAME(); rmsnorm_phase<true, true>(F, F.ws + WS_R1, A.in[37], F.out); }
#undef IN
#undef SEAM
}

extern "C" void kernel_launch(void* const* d_in, const int* in_sizes, int n_in, void* d_out, int out_size, void* d_ws, size_t ws_size, hipStream_t stream) {
    static int grid = 0;
    if (grid == 0) {
        if (n_in != 38 || out_size != M * D || ws_size < WS_END) { fprintf(stderr, "kernel_launch: unexpected shapes (n_in %d, out %d, ws %zu < %zu)\n", n_in, out_size, ws_size, (size_t)WS_END); grid = -1; return; }
        int dev = 0, cus = 0, per_cu = 0;
        if (hipGetDevice(&dev) != hipSuccess || hipDeviceGetAttribute(&cus, hipDeviceAttributeMultiprocessorCount, dev) != hipSuccess) { grid = -1; return; }
        if (hipFuncSetAttribute((const void*)trunk_fwd, hipFuncAttributeMaxDynamicSharedMemorySize, LDS_BYTES) != hipSuccess) { fprintf(stderr, "kernel_launch: hipFuncSetAttribute failed\n"); grid = -1; return; }
        if (hipOccupancyMaxActiveBlocksPerMultiprocessor(&per_cu, (const void*)trunk_fwd, 512, LDS_BYTES) != hipSuccess || per_cu < 1) { fprintf(stderr, "kernel_launch: occupancy query says %d\n", per_cu); }
        (void)hipGetLastError();
        grid = (cus / 8) * 8;
        if (grid < 64) { fprintf(stderr, "kernel_launch: %d CUs\n", cus); grid = -1; return; }
    }
    if (grid < 0) return;
    if (hipMemsetAsync((char*)d_ws + WS_CTL, 0, CTL_ZERO_BYTES, stream) != hipSuccess) return;
    Args a{};
    for (int i = 0; i < 38; ++i) a.in[i] = (const float*)d_in[i];
    a.out = (float*)d_out; a.ws = (unsigned char*)d_ws;
#if MK_PER_STEP
    for (int s = 0; s < NSTEPS; ++s) { a.lo = s; a.hi = s + 1; hipLaunchKernelGGL(trunk_fwd, dim3(grid), dim3(512), LDS_BYTES, stream, a); }
#else
    a.lo = 0; a.hi = NSTEPS;
    hipLaunchKernelGGL(trunk_fwd, dim3(grid), dim3(512), LDS_BYTES, stream, a);
#endif
}
```

```cpp
#include <hip/hip_runtime.h>
#include <cstdio>
#include <cstdint>

#define GAS __attribute__((address_space(1)))
#define LAS __attribute__((address_space(3)))
typedef unsigned short bf16;
typedef short bf16x8 __attribute__((ext_vector_type(8)));
typedef float f32x4 __attribute__((ext_vector_type(4)));
typedef float f32x2 __attribute__((ext_vector_type(2)));
typedef unsigned u32x4 __attribute__((ext_vector_type(4)));
typedef unsigned u32x2 __attribute__((ext_vector_type(2)));
typedef __bf16 bf16x2_t __attribute__((ext_vector_type(2)));
#define DI __device__ __forceinline__

constexpr int M = 16384, D = 2048, DEPTH = 4, DFF = 8192;
constexpr int S5W = 768, S5G = 48, S5P = 64;
constexpr int RW = 640, RH = 10, RN = 64, RWCOLS = 2400;
constexpr int GV = 640, GH = 5, GK = 320, GDK = 64, GDV = 128;
constexpr int INCOLS = 11248, ZP = 11520;
constexpr int ZC_R = 768, ZC_K = 1408, ZC_V = 2048, ZC_WIN = 2688, ZC_AIN = 2784, ZC_GIN = 2912;
constexpr int ZC_GQ = 3168, ZC_GKK = 3488, ZC_GV = 3808, ZC_GG = 4448, ZC_GA = 5088, ZC_GATE = 5104, ZC_VRES = 11248;
constexpr float NORM_EPS = 1e-6f;

DI unsigned pk2(float lo, float hi) { f32x2 v = {lo, hi}; bf16x2_t r = __builtin_convertvector(v, bf16x2_t); return __builtin_bit_cast(unsigned, r); }
DI float bflo(unsigned u) { return __builtin_bit_cast(float, u << 16); }
DI float bfhi(unsigned u) { return __builtin_bit_cast(float, u & 0xffff0000u); }
DI float bf2f(bf16 b) { return __builtin_bit_cast(float, ((unsigned)b) << 16); }
DI void unpack8(const u32x4 v, float (&f)[8]) { f[0] = bflo(v.x); f[1] = bfhi(v.x); f[2] = bflo(v.y); f[3] = bfhi(v.y); f[4] = bflo(v.z); f[5] = bfhi(v.z); f[6] = bflo(v.w); f[7] = bfhi(v.w); }
DI u32x4 pack8(const float (&f)[8]) { u32x4 o; o.x = pk2(f[0], f[1]); o.y = pk2(f[2], f[3]); o.z = pk2(f[4], f[5]); o.w = pk2(f[6], f[7]); return o; }
DI float sigmoidf_(float x) { return __builtin_amdgcn_rcpf(1.f + __expf(-x)); }
DI float softplusf_(float x) { return fmaxf(x, 0.f) + __logf(1.f + __expf(-fabsf(x))); }
DI float wave_sum(float v) {
    v += __builtin_bit_cast(float, __builtin_amdgcn_update_dpp(0, __builtin_bit_cast(int, v), 0xB1, 0xF, 0xF, true));
    v += __builtin_bit_cast(float, __builtin_amdgcn_update_dpp(0, __builtin_bit_cast(int, v), 0x4E, 0xF, 0xF, true));
    v += __builtin_bit_cast(float, __builtin_amdgcn_update_dpp(0, __builtin_bit_cast(int, v), 0x141, 0xF, 0xF, true));
    v += __builtin_bit_cast(float, __builtin_amdgcn_update_dpp(0, __builtin_bit_cast(int, v), 0x140, 0xF, 0xF, true));
    const int iv = __builtin_bit_cast(int, v);
    const float a0 = __builtin_bit_cast(float, __builtin_amdgcn_readlane(iv, 0)), a1 = __builtin_bit_cast(float, __builtin_amdgcn_readlane(iv, 16)),
                a2 = __builtin_bit_cast(float, __builtin_amdgcn_readlane(iv, 32)), a3 = __builtin_bit_cast(float, __builtin_amdgcn_readlane(iv, 48));
    return (a0 + a1) + (a2 + a3);
}
DI float sum8(float v) { v += __builtin_bit_cast(float, __builtin_amdgcn_update_dpp(0, __builtin_bit_cast(int, v), 0xB1, 0xF, 0xF, true));
                         v += __builtin_bit_cast(float, __builtin_amdgcn_update_dpp(0, __builtin_bit_cast(int, v), 0x4E, 0xF, 0xF, true));
                         v += __builtin_bit_cast(float, __builtin_amdgcn_update_dpp(0, __builtin_bit_cast(int, v), 0x141, 0xF, 0xF, true)); return v; }
#define LDS_WAIT() asm volatile("s_waitcnt lgkmcnt(0)" ::: "memory")
#define VM_WAIT() asm volatile("s_waitcnt vmcnt(0)" ::: "memory")

DI int lane_id_fresh() { int l; asm volatile("v_mbcnt_lo_u32_b32 %0, -1, 0\n\tv_mbcnt_hi_u32_b32 %0, -1, %0" : "=v"(l)); return l; }
#define XB_TMO      128
#define XB_XCNT(j)  (256  + 64 * (j))
#define XB_XSUB(j)  (1280 + 64 * (j))
#define XB_XGEN(j)  (2304 + 64 * (j))
#define XB_TOP      3328
#define XB_TOPGEN   3392
#define XCD_BAR_WORDS 3456
#define XB_SPIN_CAP (1u << 20)
__device__ __forceinline__ unsigned xb_ld(unsigned* p)              { return __hip_atomic_load(p, __ATOMIC_RELAXED, __HIP_MEMORY_SCOPE_AGENT); }
__device__ __forceinline__ unsigned xb_add(unsigned* p, unsigned v) { return __hip_atomic_fetch_add(p, v, __ATOMIC_RELAXED, __HIP_MEMORY_SCOPE_AGENT); }
__device__ __forceinline__ unsigned xb_xcc_id() { return (unsigned)__builtin_amdgcn_s_getreg((3 << 11) | 20) & 0xFu; }
#define XB_SPIN(cond, bar) do { unsigned _sp = 0; while (cond) { __builtin_amdgcn_s_sleep(1); \
    if ((++_sp & 255u) == 0u) { if (xb_ld(&(bar)[XB_TMO])) break; if (_sp > XB_SPIN_CAP) { atomicAdd(&(bar)[XB_TMO], 1u); break; } } } } while (0)
struct XcdBarrier { unsigned* bar; unsigned x; volatile LAS unsigned* st; unsigned w0; };
__device__ __forceinline__ XcdBarrier xcd_barrier_post(unsigned* bar, volatile LAS unsigned* st, unsigned w0) {
    XcdBarrier b; b.bar = bar; b.x = xb_xcc_id(); b.st = st; b.w0 = w0;
    if (w0 && lane_id_fresh() == 0) (void)xb_add(&bar[XB_XCNT(b.x)], 1u);
    return b;
}
__device__ __forceinline__ void xcd_barrier_complete(unsigned* bar, unsigned x, unsigned& nloc, unsigned& nx) {
    const unsigned G = gridDim.x * gridDim.y * gridDim.z;
    unsigned sum, cnt, mine, sp = 0u;
    for (;;) {
        sum = 0u; cnt = 0u; mine = 0u;
#pragma unroll
        for (unsigned j = 0; j < 16; ++j) { const unsigned c = xb_ld(&bar[XB_XCNT(j)]); sum += c; cnt += (c > 0u) ? 1u : 0u; mine = (j == x) ? c : mine; }
        if (sum == G) break;
        __builtin_amdgcn_s_sleep(1);
        if ((++sp & 255u) == 0u) { if (xb_ld(&bar[XB_TMO])) break; if (sp > XB_SPIN_CAP) { atomicAdd(&bar[XB_TMO], 1u); break; } }
    }
    nloc = mine > 0u ? mine : 1u; nx = cnt > 0u ? cnt : 1u;
}
__device__ __forceinline__ void xcd_barrier(const XcdBarrier& b) {
    asm volatile("s_waitcnt vmcnt(0)" ::: "memory");
    __syncthreads();
    if (b.w0 && lane_id_fresh() == 0) {
        unsigned* bar = b.bar;
        __builtin_amdgcn_s_waitcnt(0);
        unsigned nloc = b.st[0], nx = b.st[1];
        if (nloc == 0u) { xcd_barrier_complete(bar, b.x, nloc, nx); b.st[0] = nloc; b.st[1] = nx; }
        const unsigned old = xb_add(&bar[XB_XSUB(b.x)], 1u);
        const unsigned gen = old / nloc;
        if (old + 1u == (gen + 1u) * nloc) {
            __builtin_amdgcn_fence(__ATOMIC_RELEASE, "agent");
            asm volatile("s_waitcnt vmcnt(0)" ::: "memory");
            const unsigned og = xb_add(&bar[XB_TOP], 1u);
            const unsigned tg = og / nx;
            if (og + 1u == (tg + 1u) * nx) xb_add(&bar[XB_TOPGEN], 1u);
            else XB_SPIN(xb_ld(&bar[XB_TOPGEN]) == tg, bar);
            __builtin_amdgcn_fence(__ATOMIC_ACQUIRE, "agent");
            xb_add(&bar[XB_XGEN(b.x)], 1u);
            asm volatile("s_waitcnt vmcnt(0)" ::: "memory");
        } else {
            XB_SPIN(xb_ld(&bar[XB_XGEN(b.x)]) == gen, bar);
            __builtin_amdgcn_fence(__ATOMIC_ACQUIRE, "agent");
            asm volatile("s_waitcnt vmcnt(0)" ::: "memory");
        }
    }
    __syncthreads();
}
constexpr int BM = 256, BK = 64, HALF = 128, HTB = HALF * BK * 2, STAGE_BYTES = 8 * HTB;
DI int lds_byte(int r, int c) { const int st = (r >> 4) * 2 + (c >> 5), rr = r & 15, cc = c & 31, ob = rr * 64 + cc * 2; return st * 1024 + (ob ^ (((ob >> 9) & 1) << 5)); }
DI void stage_rc(int b, int& R, int& C) { const int st = b / 1024, sb = b % 1024, swz = sb ^ (((sb >> 9) & 1) << 5); R = (st >> 1) * 16 + swz / 64; C = (st & 1) * 32 + (swz % 64) / 2; }
DI int perm32(int rho) { const int n = rho >> 4, i = rho & 15; return 8 * (i >> 2) + 4 * n + (i & 3); }
struct Unit { int pm, pn, seg; };
struct TileOrder {
    int nM, nN, nwg;
    DI void init(int nM_, int nN_) { nM = nM_; nN = nN_; nwg = nM_ * nN_; }
    DI void map(int L, int& pm, int& pn) const {
        int wgid = L; { const int q = nwg / 8, r = nwg % 8, xcd = wgid % 8, off = wgid / 8; wgid = (xcd < r ? xcd * (q + 1) : r * (q + 1) + (xcd - r) * q) + off; }
        const int nig = 8 * nN, gid = wgid / nig, fm = gid * 8, gsz = (nM - fm) < 8 ? (nM - fm) : 8;
        pm = fm + ((wgid % nig) % gsz); pn = (wgid % nig) / gsz;
    }
};
struct SchedPlain {
    TileOrder T; int G, c, nt; const char* A; const char* B; size_t ta, tb;
    DI void init(const bf16* A_, int lda, const bf16* B_, int ldb, int nM, int nN, int K, int G_, int c_) { T.init(nM, nN); G = G_; c = c_; nt = K / BK; A = (const char*)A_; B = (const char*)B_; ta = (size_t)BM * lda * 2; tb = (size_t)BM * ldb * 2; }
    DI bool next(int i, Unit& u) const { const long L = (long)i * G + c; if (L >= T.nwg) return false; T.map((int)L, u.pm, u.pn); u.seg = 0; return true; }
    DI const char* aptr(const Unit& u) const { return A + (size_t)u.pm * ta; }
    DI const char* bptr(const Unit& u) const { return B + (size_t)u.pn * tb; }
    DI int ntiles(const Unit&) const { return nt; }
};
struct SchedSeg3 {
    TileOrder T; int G, c; const char* A; const char* B; size_t ta, tb;
    DI void init(const bf16* A_, int lda, const bf16* B_, int ldb, int nM, int nN, int G_, int c_) { T.init(nM, nN); G = G_; c = c_; A = (const char*)A_; B = (const char*)B_; ta = (size_t)BM * lda * 2; tb = (size_t)BM * ldb * 2; }
    DI bool next(int i, Unit& u) const { const int ti = i / 3; const long L = (long)ti * G + c; if (L >= T.nwg) return false; T.map((int)L, u.pm, u.pn); u.seg = i - 3 * ti; return true; }
    DI int kofs(int seg) const { return seg == 0 ? 0 : (seg == 1 ? 768 : 1408); }
    DI const char* aptr(const Unit& u) const { return A + (size_t)u.pm * ta + (size_t)kofs(u.seg) * 2; }
    DI const char* bptr(const Unit& u) const { return B + (size_t)u.pn * tb + (size_t)kofs(u.seg) * 2; }
    DI int ntiles(const Unit& u) const { return u.seg == 0 ? 12 : 10; }
};

template <class Epi, class Sched>
DI void gemm_phase(LAS unsigned char* lds, const int wv, const int lda, const int ldb, const Sched& S, const Epi& E) {
    int tid_ = wv * 64 + lane_id_fresh(); asm volatile("" : "+v"(tid_));
    const int tid = tid_, wid = __builtin_amdgcn_readfirstlane(tid >> 6), lane = tid & 63, wr = wid >> 2, wc = wid & 3, fr = lane & 15, fq = lane >> 4;
    unsigned voffA[2], voffB[2];
#pragma unroll
    for (int i = 0; i < 2; ++i) { int R, C; stage_rc(tid * 16 + i * 8192, R, C); const int Rb = Epi::PERM ? ((R & ~31) + perm32(R & 31)) : R;
        voffA[i] = (unsigned)(R * lda + C) * 2u; voffB[i] = (unsigned)(Rb * ldb + C) * 2u; }
    const size_t kstep = (size_t)(BK * 2);
    const size_t hstepA = (size_t)HALF * lda * 2, hstepB = (size_t)HALF * ldb * 2;
    const unsigned ldsw = (unsigned)wid * 1024u;
    const int aoff = lds_byte(wr * 64 + fr, fq * 8), boff = lds_byte(wc * 32 + fr, fq * 8);
#define PG8_SA(b, h) (((b) * 2 + (h)) * HTB)
#define PG8_SB(b, h) ((4 + (b) * 2 + (h)) * HTB)
#define PG8_STAGE(bufoff, gbase, voff) do { _Pragma("unroll") for (int _i = 0; _i < 2; ++_i) \
        __builtin_amdgcn_global_load_lds((const unsigned*)((const char*)(gbase) + (voff)[_i]), (LAS unsigned*)(lds + (bufoff) + ldsw + _i * 8192), 16, 0, 0); } while (0)
#define PG8_LDA(dst, b, h) do { _Pragma("unroll") for (int m = 0; m < 4; ++m) _Pragma("unroll") for (int k = 0; k < 2; ++k) dst[m][k] = *(const LAS bf16x8*)(lds + PG8_SA(b, h) + aoff + m * 2048 + k * 1024); } while (0)
#define PG8_LDB(dst, b, h) do { _Pragma("unroll") for (int n = 0; n < 2; ++n) _Pragma("unroll") for (int k = 0; k < 2; ++k) dst[n][k] = *(const LAS bf16x8*)(lds + PG8_SB(b, h) + boff + n * 2048 + k * 1024); } while (0)
#define PG8_MMA(ai, bj, At, Bt) do { __builtin_amdgcn_s_setprio(1); _Pragma("unroll") for (int m = 0; m < 4; ++m) _Pragma("unroll") for (int n = 0; n < 2; ++n) _Pragma("unroll") for (int k = 0; k < 2; ++k) \
        acc[ai][bj][m][n] = __builtin_amdgcn_mfma_f32_16x16x32_bf16(Bt[n][k], At[m][k], acc[ai][bj][m][n], 0, 0, 0); __builtin_amdgcn_s_setprio(0); } while (0)
#define PG8_WAIT_V(n) asm volatile("s_waitcnt vmcnt(" #n ")" ::: "memory")
#define PG8_WAIT_L(n) asm volatile("s_waitcnt lgkmcnt(" #n ")" ::: "memory")
#define PG8_BAR __builtin_amdgcn_s_barrier()
#define PG8_SCHED __builtin_amdgcn_sched_barrier(0)
    Unit cur, nxt; int ui = 0;
    if (!S.next(0, cur)) return;
    f32x4 acc[2][2][4][2];
#pragma unroll
    for (int a = 0; a < 2; ++a)
#pragma unroll
        for (int b = 0; b < 2; ++b)
#pragma unroll
            for (int m = 0; m < 4; ++m)
#pragma unroll
                for (int n = 0; n < 2; ++n) acc[a][b][m][n] = (f32x4){0.f, 0.f, 0.f, 0.f};
    bf16x8 At[4][2], B0[2][2], B1[2][2];
    const char* cA = S.aptr(cur); const char* cB = S.bptr(cur); int nt = S.ntiles(cur);
    PG8_STAGE(PG8_SB(0, 0), cB, voffB); PG8_STAGE(PG8_SB(0, 1), cB + hstepB, voffB); PG8_STAGE(PG8_SA(0, 0), cA, voffA); PG8_STAGE(PG8_SA(0, 1), cA + hstepA, voffA);
    if (wr == 1) PG8_BAR;
    PG8_WAIT_V(2); PG8_BAR;
    PG8_STAGE(PG8_SB(1, 0), cB + kstep, voffB); PG8_STAGE(PG8_SA(1, 0), cA + kstep, voffA); PG8_STAGE(PG8_SB(1, 1), cB + hstepB + kstep, voffB);
    PG8_WAIT_V(6); PG8_BAR;
    for (;;) {
        const bool has_next = S.next(ui + 1, nxt);
        const char* nA = has_next ? S.aptr(nxt) : cA; const char* nB = has_next ? S.bptr(nxt) : cB;
        for (int t = 0; t < nt; t += 2) {
            const bool last = (t == nt - 2);
            const char* a1 = cA + (size_t)(t + 1) * kstep;
            const char* a2 = last ? nA : cA + (size_t)(t + 2) * kstep; const char* b2 = last ? nB : cB + (size_t)(t + 2) * kstep;
            const char* a3 = a2 + kstep; const char* b3 = b2 + kstep;
            PG8_LDB(B0, 0, 0); PG8_LDB(B1, 0, 1); PG8_SCHED; PG8_LDA(At, 0, 0); PG8_STAGE(PG8_SA(1, 1), a1 + hstepA, voffA);
            PG8_WAIT_V(8); PG8_WAIT_L(0); PG8_BAR; PG8_MMA(0, 0, At, B0); PG8_MMA(0, 1, At, B1); PG8_BAR; PG8_SCHED;
            PG8_LDA(At, 0, 1); PG8_STAGE(PG8_SB(0, 0), b2, voffB); PG8_STAGE(PG8_SB(0, 1), b2 + hstepB, voffB); PG8_STAGE(PG8_SA(0, 0), a2, voffA);
            PG8_WAIT_V(8); PG8_WAIT_L(0); PG8_BAR; PG8_MMA(1, 0, At, B0); PG8_MMA(1, 1, At, B1); PG8_BAR; PG8_SCHED;
            PG8_LDB(B0, 1, 0); PG8_LDB(B1, 1, 1); PG8_SCHED; PG8_LDA(At, 1, 0); PG8_STAGE(PG8_SA(0, 1), a2 + hstepA, voffA);
            PG8_WAIT_V(8); PG8_WAIT_L(0); PG8_BAR; PG8_MMA(0, 0, At, B0); PG8_MMA(0, 1, At, B1); PG8_BAR; PG8_SCHED;
            PG8_LDA(At, 1, 1); PG8_STAGE(PG8_SB(1, 0), b3, voffB); PG8_STAGE(PG8_SB(1, 1), b3 + hstepB, voffB); PG8_STAGE(PG8_SA(1, 0), a3, voffA);
            PG8_WAIT_V(8); PG8_WAIT_L(0); PG8_BAR; PG8_MMA(1, 0, At, B0); PG8_MMA(1, 1, At, B1); PG8_BAR; PG8_SCHED;
        }
        if (wr == 0) PG8_BAR;
        const bool clr = E(acc, cur, wr, wc, fr, fq);
        if (!has_next) break;
        if (clr) {
#pragma unroll
            for (int a = 0; a < 2; ++a)
#pragma unroll
                for (int b = 0; b < 2; ++b)
#pragma unroll
                    for (int m = 0; m < 4; ++m)
#pragma unroll
                        for (int n = 0; n < 2; ++n) acc[a][b][m][n] = (f32x4){0.f, 0.f, 0.f, 0.f};
        }
        cur = nxt; cA = nA; cB = nB; nt = S.ntiles(cur); ++ui;
        if (wr == 1) PG8_BAR;
    }
    PG8_WAIT_V(0);
    PG8_BAR;
#undef PG8_SA
#undef PG8_SB
#undef PG8_STAGE
#undef PG8_LDA
#undef PG8_LDB
#undef PG8_MMA
#undef PG8_WAIT_V
#undef PG8_WAIT_L
#undef PG8_BAR
#undef PG8_SCHED
}

typedef f32x4 AccT[2][2][4][2];
struct EpiInproj {
    static constexpr bool PERM = true;
    bf16* Z; const float* gbias; bf16* ZS5; const LAS float* rs;
    DI bool operator()(AccT& acc, const Unit& u, int wr, int wc, int fr, int fq) const {
        const int row0 = u.pm * BM + wr * 64 + fr, col0 = u.pn * BM + wc * 32 + 8 * fq;
        float rsv[2][4];
#pragma unroll
        for (int ai = 0; ai < 2; ++ai)
#pragma unroll
            for (int m = 0; m < 4; ++m) rsv[ai][m] = rs[row0 + ai * HALF + m * 16];
#pragma unroll
        for (int bj = 0; bj < 2; ++bj) {
            const int col = col0 + bj * HALF; const bool gate = (col >= ZC_GATE) && (col < ZC_VRES); const bool s5c = col < S5W;
            f32x4 b0 = {0.f, 0.f, 0.f, 0.f}, b1 = b0;
            if (gate) { b0 = *(const GAS f32x4*)(gbias + (col - ZC_GATE)); b1 = *(const GAS f32x4*)(gbias + (col - ZC_GATE) + 4); }
#pragma unroll
            for (int ai = 0; ai < 2; ++ai)
#pragma unroll
                for (int m = 0; m < 4; ++m) {
                    f32x4 v0 = acc[ai][bj][m][0] * rsv[ai][m], v1 = acc[ai][bj][m][1] * rsv[ai][m];
                    if (gate) { v0 += b0; v1 += b1;
#pragma unroll
                        for (int e = 0; e < 4; ++e) { v0[e] = sigmoidf_(v0[e]); v1[e] = sigmoidf_(v1[e]); } }
                    u32x4 w; w.x = pk2(v0[0], v0[1]); w.y = pk2(v0[2], v0[3]); w.z = pk2(v1[0], v1[1]); w.w = pk2(v1[2], v1[3]);
                    if (s5c) *(GAS u32x4*)(ZS5 + ((size_t)(col >> 4) * M + (row0 + ai * HALF + m * 16)) * 16 + (col & 8)) = w;
                    else *(GAS u32x4*)(Z + (size_t)(row0 + ai * HALF + m * 16) * ZP + col) = w;
                }
        }
        return true;
    }
};
struct EpiGlu {
    static constexpr bool PERM = true;
    const bf16* ypre; bf16* ycat; const float* gb;
    DI bool operator()(AccT& acc, const Unit& u, int wr, int wc, int fr, int fq) const {
        const int row0 = u.pm * BM + wr * 64 + fr, col0 = u.pn * BM + wc * 32 + 8 * fq;
        f32x4 b0[2], b1[2];
#pragma unroll
        for (int bj = 0; bj < 2; ++bj) { b0[bj] = *(const GAS f32x4*)(gb + col0 + bj * HALF); b1[bj] = *(const GAS f32x4*)(gb + col0 + bj * HALF + 4); }
#pragma unroll
        for (int ai = 0; ai < 2; ++ai) {
            u32x4 yv[2][4];
#pragma unroll
            for (int bj = 0; bj < 2; ++bj)
#pragma unroll
                for (int m = 0; m < 4; ++m) yv[bj][m] = *(const GAS u32x4*)(ypre + (size_t)(row0 + ai * HALF + m * 16) * S5W + col0 + bj * HALF);
            __builtin_amdgcn_sched_barrier(0);
#pragma unroll
            for (int bj = 0; bj < 2; ++bj)
#pragma unroll
                for (int m = 0; m < 4; ++m) { float y[8]; unpack8(yv[bj][m], y);
                    const f32x4 v0 = acc[ai][bj][m][0] + b0[bj], v1 = acc[ai][bj][m][1] + b1[bj];
                    float o[8];
#pragma unroll
                    for (int e = 0; e < 4; ++e) { o[e] = y[e] * sigmoidf_(v0[e]); o[4 + e] = y[4 + e] * sigmoidf_(v1[e]); }
                    *(GAS u32x4*)(ycat + (size_t)(row0 + ai * HALF + m * 16) * D + col0 + bj * HALF) = pack8(o); }
            __builtin_amdgcn_sched_barrier(0);
        }
        return true;
    }
};
struct EpiMerged {
    static constexpr bool PERM = true;
    const bf16* Z; bf16* out;
    DI bool operator()(AccT& acc, const Unit& u, int wr, int wc, int fr, int fq) const {
        const int row0 = u.pm * BM + wr * 64 + fr, col0 = u.pn * BM + wc * 32 + 8 * fq;
        const int seg = u.seg;
#pragma unroll
        for (int ai = 0; ai < 2; ++ai) {
            u32x4 ga[2][4], gb[2][4];
#pragma unroll
            for (int bj = 0; bj < 2; ++bj)
#pragma unroll
                for (int m = 0; m < 4; ++m) { const bf16* zr = Z + (size_t)(row0 + ai * HALF + m * 16) * ZP + ZC_GATE + col0 + bj * HALF;
                    ga[bj][m] = *(const GAS u32x4*)(zr + seg * D); if (seg < 2) gb[bj][m] = *(const GAS u32x4*)(zr + (seg + 1) * D); else gb[bj][m] = ga[bj][m]; }
            __builtin_amdgcn_sched_barrier(0);
#pragma unroll
            for (int bj = 0; bj < 2; ++bj)
#pragma unroll
                for (int m = 0; m < 4; ++m) {
                    float g0[8], g1[8], s[8]; unpack8(ga[bj][m], g0); unpack8(gb[bj][m], g1);
#pragma unroll
                    for (int e = 0; e < 8; ++e) { const float a = fmaxf(g0[e], 1e-20f); s[e] = (seg < 2) ? a * __builtin_amdgcn_rcpf(fmaxf(g1[e], 1e-20f)) : a; }
                    f32x4 v0 = acc[ai][bj][m][0], v1 = acc[ai][bj][m][1];
#pragma unroll
                    for (int e = 0; e < 4; ++e) { v0[e] *= s[e]; v1[e] *= s[4 + e]; }
                    acc[ai][bj][m][0] = v0; acc[ai][bj][m][1] = v1;
                    if (seg == 2) { u32x4 w; w.x = pk2(v0[0], v0[1]); w.y = pk2(v0[2], v0[3]); w.z = pk2(v1[0], v1[1]); w.w = pk2(v1[2], v1[3]);
                        *(GAS u32x4*)(out + (size_t)(row0 + ai * HALF + m * 16) * D + col0 + bj * HALF) = w; } }
            __builtin_amdgcn_sched_barrier(0);
        }
        return seg == 2;
    }
};
constexpr int XP = D;
struct EpiResid {
    static constexpr bool PERM = true;
    const bf16* xb; bf16* xo; float* ssq;
    DI bool operator()(AccT& acc, const Unit& u, int wr, int wc, int fr, int fq) const {
        const int row0 = u.pm * BM + wr * 64 + fr, col0 = u.pn * BM + wc * 32 + 8 * fq;
        float ps[2][4];
#pragma unroll
        for (int ai = 0; ai < 2; ++ai) {
            u32x4 xv[4][2];
#pragma unroll
            for (int m = 0; m < 4; ++m) { const bf16* rowp = xb + (size_t)(row0 + ai * HALF + m * 16) * XP + col0;
#pragma unroll
                for (int bj = 0; bj < 2; ++bj) xv[m][bj] = *(const GAS u32x4*)(rowp + bj * HALF); }
            __builtin_amdgcn_sched_barrier(0);
#pragma unroll
            for (int m = 0; m < 4; ++m) { bf16* rowp = xo + (size_t)(row0 + ai * HALF + m * 16) * XP + col0; float s = 0.f;
#pragma unroll
                for (int bj = 0; bj < 2; ++bj) { const u32x4 x = xv[m][bj]; const f32x4 a0 = acc[ai][bj][m][0], a1 = acc[ai][bj][m][1];
                    const float y0 = bflo(x.x) + a0[0], y1 = bfhi(x.x) + a0[1], y2 = bflo(x.y) + a0[2], y3 = bfhi(x.y) + a0[3], y4 = bflo(x.z) + a1[0], y5 = bfhi(x.z) + a1[1], y6 = bflo(x.w) + a1[2], y7 = bfhi(x.w) + a1[3];
                    s += (y0 * y0 + y1 * y1) + (y2 * y2 + y3 * y3) + (y4 * y4 + y5 * y5) + (y6 * y6 + y7 * y7);
                    u32x4 w; w.x = pk2(y0, y1); w.y = pk2(y2, y3); w.z = pk2(y4, y5); w.w = pk2(y6, y7);
                    *(GAS u32x4*)(rowp + bj * HALF) = w; }
                ps[ai][m] = s; }
            __builtin_amdgcn_sched_barrier(0);
        }
        { int a16 = ((fr + 16 * fq) ^ 16) << 2, a32 = ((fr + 16 * fq) ^ 32) << 2;
#pragma unroll
          for (int ai = 0; ai < 2; ++ai)
#pragma unroll
              for (int m = 0; m < 4; ++m) { float s = ps[ai][m];
                  s += __builtin_bit_cast(float, __builtin_amdgcn_ds_bpermute(a16, __builtin_bit_cast(int, s)));
                  s += __builtin_bit_cast(float, __builtin_amdgcn_ds_bpermute(a32, __builtin_bit_cast(int, s)));
                  if (fq == 0) ssq[(size_t)(row0 + ai * HALF + m * 16) * 32 + u.pn * 4 + wc] = s; } }
        return true;
    }
};
struct EpiRelu2 {
    static constexpr bool PERM = true;
    bf16* out; const LAS float* rs;
    DI bool operator()(AccT& acc, const Unit& u, int wr, int wc, int fr, int fq) const {
        const int row0 = u.pm * BM + wr * 64 + fr, col0 = u.pn * BM + wc * 32 + 8 * fq;
#pragma unroll
        for (int ai = 0; ai < 2; ++ai)
#pragma unroll
            for (int m = 0; m < 4; ++m) { bf16* rowp = out + (size_t)(row0 + ai * HALF + m * 16) * DFF + col0; const float rsv = rs[row0 + ai * HALF + m * 16];
#pragma unroll
                for (int bj = 0; bj < 2; ++bj) { f32x4 v0 = acc[ai][bj][m][0] * rsv, v1 = acc[ai][bj][m][1] * rsv;
#pragma unroll
                    for (int e = 0; e < 4; ++e) { const float a = fmaxf(v0[e], 0.f), b = fmaxf(v1[e], 0.f); v0[e] = a * a; v1[e] = b * b; }
                    u32x4 w; w.x = pk2(v0[0], v0[1]); w.y = pk2(v0[2], v0[3]); w.z = pk2(v1[0], v1[1]); w.w = pk2(v1[2], v1[3]);
                    *(GAS u32x4*)(rowp + bj * HALF) = w; } }
        return true;
    }
};
constexpr size_t MiB = 1u << 20;
constexpr size_t WS_CTL = 0, CTL_ZERO_BYTES = 1 * MiB;
constexpr size_t SZ_WIN = (size_t)ZP * D * 2, SZ_WSQ = (size_t)D * D * 2, SZ_W1 = (size_t)DFF * D * 2, SZ_GLU = (size_t)S5W * S5W * 2;
constexpr size_t SZ_WL = (size_t)RW * 96 * 2, SZ_AL = (size_t)RW * 128 * 2, SZ_GL = (size_t)RW * 256 * 2, SZ_VB = (size_t)RW * 64 * 2;
constexpr size_t LW_WIN = 0, LW_WUP = LW_WIN + SZ_WIN, LW_WOUT = LW_WUP + SZ_WSQ, LW_W1 = LW_WOUT + SZ_WSQ, LW_W2 = LW_W1 + SZ_W1, LW_GLU = LW_W2 + SZ_W1,
                 LW_WL = LW_GLU + SZ_GLU, LW_AL = LW_WL + SZ_WL, LW_GL = LW_AL + SZ_AL, LW_VB = LW_GL + SZ_GL, LW_SIZE = LW_VB + SZ_VB;
constexpr size_t WS_W = 1 * MiB;
constexpr size_t WS_R1 = WS_W + DEPTH * LW_SIZE;
constexpr size_t SZ_R1 = (size_t)M * D * 2;
constexpr size_t WS_R2 = WS_R1 + SZ_R1;
constexpr size_t SZ_R2 = (size_t)M * ZP * 2;
constexpr size_t WS_R3 = WS_R2 + SZ_R2;
constexpr size_t WS_R5 = WS_R3 + SZ_R1;
constexpr size_t SZ_HT = (size_t)RH * M * 64 * 4;
constexpr size_t SZ_HB = (size_t)RH * M * 64 * 2;
constexpr size_t WS_R4 = WS_R5 + SZ_HT;
constexpr size_t WS_LW = WS_R4 + 6 * SZ_HB, WS_BC = WS_LW + SZ_HT;
constexpr size_t WS_ALG = WS_R4;
constexpr size_t WS_S5TA = WS_R4 + 3 * SZ_HB;
constexpr size_t WS_S5XA = WS_LW;
constexpr int NCH = M / 64;
constexpr size_t CK_PL = 0, CK_RP = 8192, CK_Q = 16384, CK_O0 = 24576, CK_H = 40960, CK_GC = 49152, CK_SIZE = 49408;
constexpr size_t WS_CK = WS_BC + (size_t)RH * M * 4;
constexpr size_t WS_GK = WS_CK + (size_t)NCH * RH * CK_SIZE;
constexpr size_t WS_ZS5 = WS_GK + (size_t)NCH * GH * 49408;
constexpr size_t WS_END = WS_ZS5 + (size_t)M * S5W * 2;
constexpr size_t WS_GQK = WS_R4 + SZ_HB;
constexpr size_t WS_GVP = WS_LW + 4 * MiB;
static_assert((size_t)NCH * GH * 16384 <= SZ_HB && 4 * MiB + (size_t)NCH * GH * 16384 <= SZ_HT && (size_t)48 * 16 * 128 * 4 * 2 <= 4 * MiB, "gla images");
constexpr size_t WS_SSQ = WS_GVP + (size_t)NCH * GH * 16384;
static_assert(WS_SSQ + (size_t)M * 32 * 4 <= WS_LW + SZ_HT, "ssq");
static_assert(WS_END <= 1474297856ull, "workspace map exceeds 4 x largest input");
static_assert((size_t)M * RW * 4 + (size_t)M * S5W * 2 <= SZ_R1 && (size_t)M * DFF * 2 <= SZ_R2, "overlays");
constexpr int CW_BAR = 4096;
constexpr size_t WS_PRM = WS_CTL + 131072;
static_assert(131072 + (size_t)DEPTH * RH * 576 * 4 <= CTL_ZERO_BYTES, "prm");

constexpr int LDS_BYTES = 155648;
constexpr int MISC_OFF = LDS_BYTES - 512;

struct Args { const float* in[38]; float* out; unsigned char* ws; int lo, hi; };

#define CAS __attribute__((address_space(4)))
struct Frame {
    LAS unsigned char* lds; int tid, lane, wave, G, bid;
    unsigned char* ws; float* out;
};
DI Frame make_frame(LAS unsigned char* lds, const CAS Args*& ap, const int wv) {
    Frame F; F.lds = lds;
    int tid = wv * 64 + lane_id_fresh(); asm volatile("" : "+v"(tid));
    int bid = blockIdx.x, G = gridDim.x; asm volatile("" : "+s"(bid), "+s"(G));
    const CAS Args* p = (const CAS Args*)__builtin_amdgcn_kernarg_segment_ptr(); asm volatile("" : "+s"(p));
    F.tid = tid; F.lane = tid & 63; F.wave = wv; F.G = G; F.bid = bid;
    F.ws = p->ws; F.out = p->out; ap = p; return F;
}
DI unsigned char* lw(const Frame& F, int l, size_t off) { return F.ws + WS_W + (size_t)l * LW_SIZE + off; }

DI void transpose_item(const float* W, int K, int N, bf16* WT, int ldt, int row_off, LAS float* scr, int item, int lane, const float* kscale = nullptr, int frag_nk = 0) {
    const int nblk = (N + 31) / 32, kb = item / nblk, nb = item % nblk, k0 = 64 * kb, n0 = 32 * nb;
    const int lr = lane >> 3, c4 = (lane & 7) * 4; const bool nok = (n0 + c4) < N;
    f32x4 v[8];
#pragma unroll
    for (int i = 0; i < 8; ++i) { const int row = lr + 8 * i; const bool ok = nok && (k0 + row) < K; v[i] = ok ? *(const GAS f32x4*)(W + (size_t)(k0 + row) * N + n0 + c4) : (f32x4){0.f, 0.f, 0.f, 0.f}; }
    if (kscale) { float ks[8];
#pragma unroll
        for (int i = 0; i < 8; ++i) ks[i] = kscale[(k0 + lr + 8 * i) < K ? (k0 + lr + 8 * i) : 0];
#pragma unroll
        for (int i = 0; i < 8; ++i) v[i] = v[i] * ks[i]; }
    __builtin_amdgcn_sched_barrier(0);
#pragma unroll
    for (int i = 0; i < 8; ++i) { LAS float* d = scr + (lr + 8 * i) * 33 + c4; d[0] = v[i][0]; d[1] = v[i][1]; d[2] = v[i][2]; d[3] = v[i][3]; }
    LDS_WAIT(); asm volatile("" ::: "memory");
    const int c = lane & 7;
    u32x4 o[4];
#pragma unroll
    for (int j = 0; j < 4; ++j) { const int n = (lane >> 3) + 8 * j; const LAS float* s = scr + (8 * c) * 33 + n;
        o[j].x = pk2(s[0 * 33], s[1 * 33]); o[j].y = pk2(s[2 * 33], s[3 * 33]); o[j].z = pk2(s[4 * 33], s[5 * 33]); o[j].w = pk2(s[6 * 33], s[7 * 33]); }
#pragma unroll
    for (int j = 0; j < 4; ++j) { const int n = (lane >> 3) + 8 * j; if ((n0 + n) < N && (k0 + 8 * c) < K) {
            if (frag_nk) { const int nn = n0 + n, kk = k0 + 8 * c; *(GAS u32x4*)(WT + ((size_t)((nn >> 4) * frag_nk + (kk >> 5)) * 64 + (nn & 15) + 16 * ((kk & 31) >> 3)) * 8) = o[j]; }
            else *(GAS u32x4*)(WT + (size_t)(row_off + n0 + n) * ldt + k0 + 8 * c) = o[j]; } }
    LDS_WAIT(); asm volatile("" ::: "memory");
}
DI int titems(int K, int N) { return ((K + 63) / 64) * ((N + 31) / 32); }
DI void p0_prologue(const Frame& F, const CAS Args& a) {
    LAS float* scr = (LAS float*)(F.lds + F.wave * 16384);
    const int gw = F.bid * 8 + F.wave, NGW = F.G * 8;
    constexpr int I_IN = (D / 64) * ((INCOLS + 31) / 32), I_VA = (D / 64) * 2, I_SQ = (D / 64) * (D / 32), I_1 = (D / 64) * (DFF / 32), I_2 = (DFF / 64) * (D / 32),
                  I_GLU = (S5W / 64) * (S5W / 32), I_WL = 2 * 20, I_AL = 2 * 20, I_GL = 4 * 20, I_VB = 1 * 20;
    constexpr int PER_LAYER = I_IN + I_VA + 2 * I_SQ + I_1 + I_2 + I_GLU + I_WL + I_AL + I_GL + I_VB;
    for (int it = gw; it < DEPTH * PER_LAYER; it += NGW) {
        const int l = it / PER_LAYER; int r = it - l * PER_LAYER;
        if (r < I_IN) { transpose_item(a.in[2] + (size_t)l * D * INCOLS, D, INCOLS, (bf16*)lw(F, l, LW_WIN), D, 0, scr, r, F.lane, a.in[1] + (size_t)l * D); continue; } r -= I_IN;
        if (r < I_VA) { if (l > 0) transpose_item(a.in[25] + (size_t)(l - 1) * D * 64, D, 64, (bf16*)lw(F, l, LW_WIN), D, ZC_VRES, scr, r, F.lane, a.in[1] + (size_t)l * D); continue; } r -= I_VA;
        if (r < I_SQ) { transpose_item(a.in[32] + (size_t)l * D * D, D, D, (bf16*)lw(F, l, LW_WUP), D, 0, scr, r, F.lane); continue; } r -= I_SQ;
        if (r < I_SQ) { transpose_item(a.in[33] + (size_t)l * D * D, D, D, (bf16*)lw(F, l, LW_WOUT), D, 0, scr, r, F.lane); continue; } r -= I_SQ;
        if (r < I_1) { transpose_item(a.in[35] + (size_t)l * D * DFF, D, DFF, (bf16*)lw(F, l, LW_W1), D, 0, scr, r, F.lane, a.in[34] + (size_t)l * D); continue; } r -= I_1;
        if (r < I_2) { transpose_item(a.in[36] + (size_t)l * DFF * D, DFF, D, (bf16*)lw(F, l, LW_W2), DFF, 0, scr, r, F.lane); continue; } r -= I_2;
        if (r < I_GLU) { transpose_item(a.in[12] + (size_t)l * S5W * S5W, S5W, S5W, (bf16*)lw(F, l, LW_GLU), S5W, 0, scr, r, F.lane); continue; } r -= I_GLU;
        if (r < I_WL) { transpose_item(a.in[15] + (size_t)l * 96 * RW, 96, RW, (bf16*)lw(F, l, LW_WL), 96, 0, scr, r, F.lane, nullptr, 3); continue; } r -= I_WL;
        if (r < I_AL) { transpose_item(a.in[17] + (size_t)l * 128 * RW, 128, RW, (bf16*)lw(F, l, LW_AL), 128, 0, scr, r, F.lane, nullptr, 4); continue; } r -= I_AL;
        if (r < I_GL) { transpose_item(a.in[19] + (size_t)l * 256 * RW, 256, RW, (bf16*)lw(F, l, LW_GL), 256, 0, scr, r, F.lane, nullptr, 8); continue; } r -= I_GL;
        if (l > 0) transpose_item(a.in[27] + (size_t)(l - 1) * 64 * RW, 64, RW, (bf16*)lw(F, l, LW_VB), 64, 0, scr, r, F.lane, nullptr, 2);
    }
}

template <bool IN_BF16, bool OUT_F32>
DI void rmsnorm_phase(const Frame& F, const void* xp, const float* g, void* outp) {
    const int gw = F.bid * 8 + F.wave, NGW = F.G * 8;
    f32x4 gv[8];
    if (IN_BF16) {
#pragma unroll
        for (int j = 0; j < 4; ++j) { gv[2 * j] = ((const GAS f32x4*)g)[2 * (64 * j + F.lane)]; gv[2 * j + 1] = ((const GAS f32x4*)g)[2 * (64 * j + F.lane) + 1]; }
    } else {
#pragma unroll
        for (int j = 0; j < 8; ++j) gv[j] = ((const GAS f32x4*)g)[64 * j + F.lane];
    }
    for (int m = gw; m < M; m += NGW) {
        f32x4 v[8]; float s = 0.f;
        if (IN_BF16) { const GAS u32x4* xr = (const GAS u32x4*)((const bf16*)xp + (size_t)m * XP) + F.lane;
            u32x4 r[4];
#pragma unroll
            for (int j = 0; j < 4; ++j) r[j] = xr[64 * j];
#pragma unroll
            for (int j = 0; j < 4; ++j) { v[2 * j] = (f32x4){bflo(r[j].x), bfhi(r[j].x), bflo(r[j].y), bfhi(r[j].y)}; v[2 * j + 1] = (f32x4){bflo(r[j].z), bfhi(r[j].z), bflo(r[j].w), bfhi(r[j].w)}; }
#pragma unroll
            for (int j = 0; j < 8; ++j) s += (v[j].x * v[j].x + v[j].y * v[j].y) + (v[j].z * v[j].z + v[j].w * v[j].w);
        } else { const GAS f32x4* xr = (const GAS f32x4*)((const float*)xp + (size_t)m * D) + F.lane;
#pragma unroll
            for (int j = 0; j < 8; ++j) { v[j] = xr[64 * j]; s += (v[j].x * v[j].x + v[j].y * v[j].y) + (v[j].z * v[j].z + v[j].w * v[j].w); } }
        const float rstd = 1.f / sqrtf(wave_sum(s) * (1.f / D) + NORM_EPS);
        if (OUT_F32) {
            if (IN_BF16) { GAS f32x4* o = (GAS f32x4*)((float*)outp + (size_t)m * D);
#pragma unroll
                for (int j = 0; j < 4; ++j) { o[2 * (64 * j + F.lane)] = v[2 * j] * rstd * gv[2 * j]; o[2 * (64 * j + F.lane) + 1] = v[2 * j + 1] * rstd * gv[2 * j + 1]; }
            } else { GAS f32x4* o = (GAS f32x4*)((float*)outp + (size_t)m * D) + F.lane;
#pragma unroll
                for (int j = 0; j < 8; ++j) o[64 * j] = v[j] * rstd * gv[j]; }
        } else {
            if (IN_BF16) { GAS u32x4* o = (GAS u32x4*)((bf16*)outp + (size_t)m * D) + F.lane;
#pragma unroll
                for (int j = 0; j < 4; ++j) { const f32x4 y0 = v[2 * j] * rstd * gv[2 * j], y1 = v[2 * j + 1] * rstd * gv[2 * j + 1]; u32x4 w; w.x = pk2(y0.x, y0.y); w.y = pk2(y0.z, y0.w); w.z = pk2(y1.x, y1.y); w.w = pk2(y1.z, y1.w); o[64 * j] = w; }
            } else { GAS u32x2* o = (GAS u32x2*)((bf16*)outp + (size_t)m * D) + F.lane;
#pragma unroll
                for (int j = 0; j < 8; ++j) { const f32x4 y = v[j] * rstd * gv[j]; u32x2 w; w.x = pk2(y.x, y.y); w.y = pk2(y.z, y.w); o[64 * j] = w; } }
        }
    }
}

constexpr int AL_PITCH = 552;
constexpr int PO_PITCH = 68;
struct RwPrep { bf16 *R, *K2, *V, *KK, *BB, *G; float *LW, *BC, *VF; };
DI RwPrep rwprep_ptrs(const Frame& F) { RwPrep p; bf16* b = (bf16*)(F.ws + WS_R4); const size_t n = (size_t)RH * M * 64;
    p.R = b; p.K2 = b + n; p.V = b + 2 * n; p.KK = b + 3 * n; p.BB = b + 4 * n; p.G = b + 5 * n; p.LW = (float*)(F.ws + WS_LW); p.BC = (float*)(F.ws + WS_BC); p.VF = (float*)(F.ws + WS_R5); return p; }
#define SB() __builtin_amdgcn_sched_barrier(0)
#ifndef REP3_MASK
#define REP3_MASK 0
#endif
#define REP3(k) ((REP3_MASK >> (k)) & 1)
template <int K, int KOFF, int L>
DI void lora_tile(const LAS bf16* AL, const bf16* Bt, LAS float* PO, int h, int mt, int np, int fr, int fq) {
    constexpr int NK = K / 32;
    bf16x8 bv[2][NK], av[NK];
#pragma unroll
    for (int ks = 0; ks < NK; ++ks) { av[ks] = *(const LAS bf16x8*)(AL + (16 * mt + fr) * AL_PITCH + KOFF + 32 * ks + 8 * fq);
#pragma unroll
        for (int nn = 0; nn < 2; ++nn) bv[nn][ks] = *(const GAS bf16x8*)(Bt + (size_t)(h * 64 + 16 * (2 * np + nn) + fr) * K + 8 * fq + 32 * ks); }
    SB();
#pragma unroll
    for (int nn = 0; nn < 2; ++nn) { const int nt = 2 * np + nn; f32x4 acc = {0.f, 0.f, 0.f, 0.f};
#pragma unroll
        for (int ks = 0; ks < NK; ++ks) acc = __builtin_amdgcn_mfma_f32_16x16x32_bf16(av[ks], bv[nn][ks], acc, 0, 0, 0);
#pragma unroll
        for (int i = 0; i < 4; ++i) PO[(L * 64 + 16 * mt + 4 * fq + i) * PO_PITCH + 16 * nt + fr] = acc[i]; }
    SB();
}
DI void lora2_tile(const LAS bf16* AL, const bf16* WLt, const bf16* VBt, LAS float* PO, int h, int mt, int np, int fr, int fq, bool has_v) {
    bf16x8 b0[2][3], a0[3], b3[2][2], a3[2];
    const LAS bf16* arow = AL + (16 * mt + fr) * AL_PITCH + 8 * fq;
#pragma unroll
    for (int ks = 0; ks < 3; ++ks) { a0[ks] = *(const LAS bf16x8*)(arow + 32 * ks);
#pragma unroll
        for (int nn = 0; nn < 2; ++nn) b0[nn][ks] = *(const GAS bf16x8*)(WLt + (size_t)(h * 64 + 16 * (2 * np + nn) + fr) * 96 + 8 * fq + 32 * ks); }
#pragma unroll
    for (int ks = 0; ks < 2; ++ks) { a3[ks] = *(const LAS bf16x8*)(arow + 480 + 32 * ks);
#pragma unroll
        for (int nn = 0; nn < 2; ++nn) b3[nn][ks] = has_v ? *(const GAS bf16x8*)(VBt + (size_t)(h * 64 + 16 * (2 * np + nn) + fr) * 64 + 8 * fq + 32 * ks) : (bf16x8){0, 0, 0, 0, 0, 0, 0, 0}; }
    SB();
#pragma unroll
    for (int nn = 0; nn < 2; ++nn) { const int nt = 2 * np + nn; f32x4 c0 = {0.f, 0.f, 0.f, 0.f}, c3 = c0;
#pragma unroll
        for (int ks = 0; ks < 3; ++ks) c0 = __builtin_amdgcn_mfma_f32_16x16x32_bf16(a0[ks], b0[nn][ks], c0, 0, 0, 0);
#pragma unroll
        for (int ks = 0; ks < 2; ++ks) c3 = __builtin_amdgcn_mfma_f32_16x16x32_bf16(a3[ks], b3[nn][ks], c3, 0, 0, 0);
#pragma unroll
        for (int i = 0; i < 4; ++i) { PO[(0 * 64 + 16 * mt + 4 * fq + i) * PO_PITCH + 16 * nt + fr] = c0[i]; PO[(3 * 64 + 16 * mt + 4 * fq + i) * PO_PITCH + 16 * nt + fr] = c3[i]; } }
    SB();
}
DI void rwkv_prep_phase(const Frame& F, const CAS Args& a, int l) {
    const bf16* Z = (const bf16*)(F.ws + WS_R2);
    LAS bf16* AL = (LAS bf16*)F.lds;
    LAS float* PO = (LAS float*)(F.lds + 64 * AL_PITCH * 2);
    const float* mu = a.in[14] + (size_t)l * RWCOLS;
    const float* vmu = a.in[26] + (size_t)(l > 0 ? l - 1 : 0) * 64;
    const RwPrep P = rwprep_ptrs(F);
    const bf16* WLt = (const bf16*)lw(F, l, LW_WL); const bf16* ALt = (const bf16*)lw(F, l, LW_AL); const bf16* GLt = (const bf16*)lw(F, l, LW_GL); const bf16* VBt = (const bf16*)lw(F, l, LW_VB);
    for (int c = F.bid; c < M / 64; c += F.G) {
        for (int rep_ = 0; rep_ < 1 + REP3(0); ++rep_) {
        if (F.tid < 476) { const int cc = F.tid % 68, r0 = F.tid / 68, j = cc * 8;
            const int zc = (j < 480) ? ZC_WIN + j : ZC_VRES + (j - 480); const float* mp = (j < 480) ? mu + (ZC_WIN - ZC_R) + j : vmu + (j - 480);
            const int kind = (j < 96) ? 0 : ((j >= 224 && j < 480) ? 2 : ((j >= 480 && l == 0) ? 3 : 1));
            const f32x4 m0 = *(const GAS f32x4*)mp, m1 = *(const GAS f32x4*)(mp + 4);
            for (int ib = 0; ib < 2; ++ib) {
                u32x4 cu[5], pr[5];
#pragma unroll
                for (int u = 0; u < 5; ++u) { const int r = r0 + 7 * (5 * ib + u), rr = r < 64 ? r : 63, gr = 64 * c + rr;
                    cu[u] = *(const GAS u32x4*)(Z + (size_t)gr * ZP + zc); pr[u] = *(const GAS u32x4*)(Z + (size_t)(gr > 0 ? gr - 1 : 0) * ZP + zc); }
                SB();
#pragma unroll
                for (int u = 0; u < 5; ++u) { const int r = r0 + 7 * (5 * ib + u); if (r < 64) { const int gr = 64 * c + r;
                    float cur[8], prv[8], o[8]; unpack8(cu[u], cur); unpack8(pr[u], prv);
#pragma unroll
                    for (int e = 0; e < 8; ++e) { const float pv = gr > 0 ? prv[e] : 0.f; const float mm = e < 4 ? m0[e] : m1[e - 4]; o[e] = cur[e] + (pv - cur[e]) * mm; }
                    if (kind == 0) {
#pragma unroll
                        for (int e = 0; e < 8; ++e) o[e] = 1.f - 2.f * __builtin_amdgcn_rcpf(__expf(2.f * o[e]) + 1.f);
                    } else if (kind == 2) {
#pragma unroll
                        for (int e = 0; e < 8; ++e) o[e] = sigmoidf_(o[e]);
                    } else if (kind == 3) {
#pragma unroll
                        for (int e = 0; e < 8; ++e) o[e] = 0.f; }
                    *(LAS u32x4*)(AL + r * AL_PITCH + j) = pack8(o); } }
                SB();
            } }
        }
        __syncthreads();
        for (int h = 0; h < RH; ++h) {
            const int t = F.tid >> 3, cg = F.tid & 7, gr = 64 * c + t, ch = h * 64 + 8 * cg;
            const size_t po = ((size_t)h * M + gr) * 64 + 8 * cg;
            u32x4 zc_[3], zp_[3]; f32x4 zm0[3], zm1[3];
#pragma unroll
            for (int which = 0; which < 3; ++which) { const int zc = (which == 0 ? ZC_R : (which == 1 ? ZC_K : ZC_V)) + ch;
                zc_[which] = *(const GAS u32x4*)(Z + (size_t)gr * ZP + zc); zp_[which] = *(const GAS u32x4*)(Z + (size_t)(gr > 0 ? gr - 1 : 0) * ZP + zc);
                zm0[which] = *(const GAS f32x4*)(mu + (zc - ZC_R)); zm1[which] = *(const GAS f32x4*)(mu + (zc - ZC_R) + 4); }
            SB();
            for (int rep_ = 0; rep_ < 1 + REP3(1); ++rep_)
            { const int mt = F.wave & 3, np = F.wave >> 2, fr = F.lane & 15, fq = F.lane >> 4;
              lora2_tile(AL, WLt, VBt, PO, h, mt, np, fr, fq, l > 0);
              lora_tile<128, 96, 1>(AL, ALt, PO, h, mt, np, fr, fq);
              lora_tile<256, 224, 2>(AL, GLt, PO, h, mt, np, fr, fq);
            }
            f32x4 pw0[2], pa0[2], pkk[2], pka[2], prk[2], pvb[2], pvf[2];
#pragma unroll
            for (int q = 0; q < 2; ++q) { pw0[q] = *(const GAS f32x4*)(a.in[16] + (size_t)l * RW + ch + 4 * q); pa0[q] = *(const GAS f32x4*)(a.in[18] + (size_t)l * RW + ch + 4 * q); pkk[q] = *(const GAS f32x4*)(a.in[20] + (size_t)l * RW + ch + 4 * q);
                pka[q] = *(const GAS f32x4*)(a.in[21] + (size_t)l * RW + ch + 4 * q); prk[q] = *(const GAS f32x4*)(a.in[22] + (size_t)l * RW + ch + 4 * q);
                pvb[q] = (l > 0) ? *(const GAS f32x4*)(a.in[28] + (size_t)(l - 1) * RW + ch + 4 * q) : (f32x4){0.f, 0.f, 0.f, 0.f}; pvf[q] = (l > 0) ? *(const GAS f32x4*)(P.VF + po + 4 * q) : (f32x4){0.f, 0.f, 0.f, 0.f}; }
            SB();
            __syncthreads();
            for (int rep_ = 0; rep_ < 1 + REP3(2); ++rep_)
            {
              float r[8], k[8], v[8];
#pragma unroll
              for (int which = 0; which < 3; ++which) { float cu[8], pr[8]; unpack8(zc_[which], cu); unpack8(zp_[which], pr);
#pragma unroll
                  for (int e = 0; e < 8; ++e) { const float pv = gr > 0 ? pr[e] : 0.f; const float mm = e < 4 ? zm0[which][e] : zm1[which][e - 4]; const float zs = cu[e] + (pv - cu[e]) * mm;
                      if (which == 0) r[e] = zs; else if (which == 1) k[e] = zs; else v[e] = zs; } }
              float wpre[8], apre[8], gpre[8], vpre[8];
#pragma unroll
              for (int q = 0; q < 2; ++q) { const f32x4 x0 = *(const LAS f32x4*)(PO + (0 * 64 + t) * PO_PITCH + 8 * cg + 4 * q), x1 = *(const LAS f32x4*)(PO + (1 * 64 + t) * PO_PITCH + 8 * cg + 4 * q), x2 = *(const LAS f32x4*)(PO + (2 * 64 + t) * PO_PITCH + 8 * cg + 4 * q);
                  const f32x4 x3 = (l > 0) ? *(const LAS f32x4*)(PO + (3 * 64 + t) * PO_PITCH + 8 * cg + 4 * q) : (f32x4){0.f, 0.f, 0.f, 0.f};
#pragma unroll
                  for (int e = 0; e < 4; ++e) { wpre[4 * q + e] = x0[e]; apre[4 * q + e] = x1[e]; gpre[4 * q + e] = x2[e]; vpre[4 * q + e] = x3[e]; } }
              float lwv[8], av[8], kk[8], k2[8], bb[8]; float ss = 0.f, bc = 0.f;
              if (l > 0) {
#pragma unroll
                  for (int e = 0; e < 8; ++e) { const float vg = sigmoidf_(pvb[e >> 2][e & 3] + vpre[e]); const float vf = pvf[e >> 2][e & 3]; v[e] = v[e] + (vf - v[e]) * vg; } }
#pragma unroll
              for (int e = 0; e < 8; ++e) {
                  const float w = -softplusf_(-(pw0[e >> 2][e & 3] + wpre[e])) - 0.5f; lwv[e] = -__expf(w);
                  av[e] = sigmoidf_(pa0[e >> 2][e & 3] + apre[e]);
                  kk[e] = k[e] * pkk[e >> 2][e & 3]; ss += kk[e] * kk[e];
                  k2[e] = k[e] * (1.f + (av[e] - 1.f) * pka[e >> 2][e & 3]); bc += r[e] * k2[e] * prk[e >> 2][e & 3]; }
              ss = sum8(ss); bc = sum8(bc); const float rn = 1.f / sqrtf(fmaxf(ss, 1e-24f));
#pragma unroll
              for (int e = 0; e < 8; ++e) { kk[e] *= rn; bb[e] = kk[e] * av[e]; }
#define ST8(dst, arr) do { *(GAS f32x4*)((dst) + po) = (f32x4){arr[0], arr[1], arr[2], arr[3]}; *(GAS f32x4*)((dst) + po + 4) = (f32x4){arr[4], arr[5], arr[6], arr[7]}; } while (0)
#define ST8B(dst, arr) do { *(GAS u32x4*)((dst) + po) = pack8(arr); } while (0)
              ST8B(P.R, r); ST8(P.LW, lwv); ST8B(P.K2, k2); ST8B(P.V, v); ST8B(P.KK, kk); ST8B(P.BB, bb); ST8B(P.G, gpre);
              if (cg == 0) P.BC[(size_t)h * M + gr] = bc;
              if (l == 0) ST8(P.VF, v);
#undef ST8B
#undef ST8
            }
            __syncthreads();
        }
    }
}
DI float gelu_tanh(float y) { const float u = 0.7978845608028654f * (y + 0.044715f * y * y * y); const float e = __expf(2.f * u); const float th = 1.f - 2.f * __builtin_amdgcn_rcpf(e + 1.f); return 0.5f * y * (1.f + th); }

typedef short s16x4 __attribute__((ext_vector_type(4)));
DI bf16x8 ld_pi(const LAS bf16* row, int ks, int kg) {
    const u32x2 a = *(const LAS u32x2*)(row + 32 * ks + 4 * kg), b = *(const LAS u32x2*)(row + 32 * ks + 16 + 4 * kg);
    u32x4 v; v.x = a.x; v.y = a.y; v.z = b.x; v.w = b.y; return __builtin_bit_cast(bf16x8, v);
}
DI bf16x8 pack_pi(const f32x4 lo, const f32x4 hi) { u32x4 v; v.x = pk2(lo[0], lo[1]); v.y = pk2(lo[2], lo[3]); v.z = pk2(hi[0], hi[1]); v.w = pk2(hi[2], hi[3]); return __builtin_bit_cast(bf16x8, v); }
DI unsigned char* ck_ptr(const Frame& F, int c, int h) { return F.ws + WS_CK + ((size_t)c * RH + h) * CK_SIZE; }

constexpr int RPP = 72;
constexpr int RP_AT = 0, RP_BT = 9216, RP_KT = 18432, RP_RT = 27648, RP_BDT = 36864, RP_KDT = 46080, RP_VT = 55296, RP_LAK = 64512, RP_MRB = 73728, RP_MRK = 82944;
constexpr int RP_L = 92160, RP_CUM = RP_L + 17408, RP_TBB = RP_CUM + 17408, RP_SEG = RP_TBB + 5120, RP_END = RP_SEG + 2048;
static_assert(RP_END + 9 * 64 * 4 <= MISC_OFF, "rwkv_pre LDS");

DI void rwkv_chunk_tail(const Frame& F, unsigned char* const ck, LAS bf16* const At, LAS bf16* const Bt, LAS bf16* const Kt, LAS bf16* const Rt, LAS bf16* const BdT, LAS bf16* const KdT, LAS bf16* const VT,
                        LAS bf16* const Lak, LAS bf16* const Mrb, LAS bf16* const Mrk, LAS float* const Lm, LAS float* const Tbb) {
    const int lane = F.lane, w = F.wave, n = lane & 15, g4 = lane >> 4;
    {
        { const int p = w >> 1;
          const LAS bf16* Xs = (p & 1) ? Kt : Bt; const LAS bf16* Xt = (p & 2) ? Rt : At;
          bf16x8 bfrag[2][2], afrag[4][2];
#pragma unroll
          for (int nn = 0; nn < 2; ++nn)
#pragma unroll
              for (int ks = 0; ks < 2; ++ks) bfrag[nn][ks] = *(const LAS bf16x8*)(Xt + (16 * (2 * (w & 1) + nn) + n) * RPP + 32 * ks + 8 * g4);
#pragma unroll
          for (int ms = 0; ms < 4; ++ms)
#pragma unroll
              for (int ks = 0; ks < 2; ++ks) afrag[ms][ks] = *(const LAS bf16x8*)(Xs + (16 * ms + n) * RPP + 32 * ks + 8 * g4);
          SB();
#pragma unroll
          for (int nn = 0; nn < 2; ++nn) { const int nt = 2 * (w & 1) + nn; const int t = 16 * nt + n;
#pragma unroll
              for (int ms = 0; ms < 4; ++ms) {
                  if (ms <= nt) { f32x4 acc = {0.f, 0.f, 0.f, 0.f};
#pragma unroll
                      for (int ks = 0; ks < 2; ++ks) acc = __builtin_amdgcn_mfma_f32_16x16x32_bf16(afrag[ms][ks], bfrag[nn][ks], acc, 0, 0, 0);
#pragma unroll
                      for (int r = 0; r < 4; ++r) { const int s = 16 * ms + 4 * g4 + r; const bool keep = (p & 2) ? (s <= t) : (s < t); acc[r] = keep ? acc[r] : 0.f; }
                      if (p == 0) *(LAS f32x4*)(Lm + t * 68 + 16 * ms + 4 * g4) = acc;
                      else { LAS bf16* dst = (p == 1) ? Lak : (p == 2 ? Mrb : Mrk); u32x2 o; o.x = pk2(acc[0], acc[1]); o.y = pk2(acc[2], acc[3]); *(LAS u32x2*)(dst + t * RPP + 16 * ms + 4 * g4) = o; } } } } }
        __syncthreads();
        if (F.tid < 64) { const int b = F.tid >> 4, cc = F.tid & 15; float x[16];
#pragma unroll
            for (int t0 = 0; t0 < 16; t0 += 4) { f32x4 lr[4][4];
#pragma unroll
                for (int tt = 0; tt < 4; ++tt)
#pragma unroll
                    for (int q = 0; q < 4; ++q) if (4 * q < t0 + tt) lr[tt][q] = *(const LAS f32x4*)(Lm + (16 * b + t0 + tt) * 68 + 16 * b + 4 * q);
                SB();
#pragma unroll
                for (int tt = 0; tt < 4; ++tt) { const int t = t0 + tt; float s = (t == cc) ? 1.f : 0.f;
#pragma unroll
                    for (int s2 = 0; s2 < t; ++s2) s += lr[tt][s2 >> 2][s2 & 3] * x[s2];
                    x[t] = s; Tbb[(b * 16 + t) * 20 + cc] = s; }
                SB(); } }
        __syncthreads();
        { f32x4 rhs[4];
          if (w < 4) {
#pragma unroll
              for (int b = 0; b < 4; ++b)
#pragma unroll
                  for (int r = 0; r < 4; ++r) rhs[b][r] = bf2f(At[(16 * b + 4 * g4 + r) * RPP + 16 * w + n]);
          } else { const int vs = w - 4;
              bf16x8 vf[2];
#pragma unroll
              for (int ks = 0; ks < 2; ++ks) vf[ks] = *(const LAS bf16x8*)(VT + (16 * vs + n) * RPP + 32 * ks + 8 * g4);
#pragma unroll
              for (int b = 0; b < 4; ++b) { f32x4 acc = {0.f, 0.f, 0.f, 0.f};
#pragma unroll
                  for (int ks = 0; ks < 2; ++ks) { const bf16x8 af = *(const LAS bf16x8*)(Lak + (16 * b + n) * RPP + 32 * ks + 8 * g4); acc = __builtin_amdgcn_mfma_f32_16x16x32_bf16(af, vf[ks], acc, 0, 0, 0); }
                  rhs[b] = acc; } }
          SB();
          f32x4 X[4];
#pragma unroll
          for (int b = 0; b < 4; ++b) { f32x4 lf[3], tf;
              tf = *(const LAS f32x4*)(Tbb + (b * 16 + n) * 20 + 4 * g4);
#pragma unroll
              for (int b2 = 0; b2 < 3; ++b2) if (b2 < b) lf[b2] = *(const LAS f32x4*)(Lm + (16 * b + n) * 68 + 16 * b2 + 4 * g4);
              SB();
              f32x4 acc = rhs[b];
#pragma unroll
              for (int b2 = 0; b2 < b; ++b2) {
#pragma unroll
                  for (int q = 0; q < 4; ++q) acc = __builtin_amdgcn_mfma_f32_16x16x4f32(lf[b2][q], X[b2][q], acc, 0, 0, 0); }
              f32x4 o = {0.f, 0.f, 0.f, 0.f};
#pragma unroll
              for (int q = 0; q < 4; ++q) o = __builtin_amdgcn_mfma_f32_16x16x4f32(tf[q], acc[q], o, 0, 0, 0);
              X[b] = o;
              SB(); }
          bf16x8 xf[2]; xf[0] = pack_pi(X[0], X[1]); xf[1] = pack_pi(X[2], X[3]);
          SB();
          if (w < 4) { const int ws_ = w;
#pragma unroll
              for (int n0 = 0; n0 < 4; n0 += 2) { bf16x8 fb[2][2], fm[2][2]; u32x2 rr[2];
#pragma unroll
                  for (int nn = 0; nn < 2; ++nn) { const int nt = n0 + nn; rr[nn] = *(const LAS u32x2*)(Rt + (16 * nt + n) * RPP + 16 * ws_ + 4 * g4);
#pragma unroll
                      for (int ks = 0; ks < 2; ++ks) { fb[nn][ks] = ld_pi(BdT + (16 * nt + n) * RPP, ks, g4); fm[nn][ks] = ld_pi(Mrb + (16 * nt + n) * RPP, ks, g4); } }
                  SB();
#pragma unroll
                  for (int nn = 0; nn < 2; ++nn) { const int nt = n0 + nn;
                      f32x4 acc = {0.f, 0.f, 0.f, 0.f}, ac2 = {0.f, 0.f, 0.f, 0.f};
#pragma unroll
                      for (int ks = 0; ks < 2; ++ks) { acc = __builtin_amdgcn_mfma_f32_16x16x32_bf16(xf[ks], fb[nn][ks], acc, 0, 0, 0); ac2 = __builtin_amdgcn_mfma_f32_16x16x32_bf16(xf[ks], fm[nn][ks], ac2, 0, 0, 0); }
                      u32x2 o; o.x = pk2(acc[0], acc[1]); o.y = pk2(acc[2], acc[3]);
                      *(GAS u32x2*)(ck + CK_PL + ((size_t)((nt * 2 + (ws_ >> 1)) * 64 + lane)) * 16 + (ws_ & 1) * 8) = o;
                      ac2[0] += bflo(rr[nn].x); ac2[1] += bfhi(rr[nn].x); ac2[2] += bflo(rr[nn].y); ac2[3] += bfhi(rr[nn].y);
                      u32x2 o2; o2.x = pk2(ac2[0], ac2[1]); o2.y = pk2(ac2[2], ac2[3]);
                      *(GAS u32x2*)(ck + CK_RP + ((size_t)((nt * 2 + (ws_ >> 1)) * 64 + lane)) * 16 + (ws_ & 1) * 8) = o2; }
                  SB(); }
          } else { const int vs = w - 4;
              bf16x8 vf[2];
#pragma unroll
              for (int ks = 0; ks < 2; ++ks) vf[ks] = *(const LAS bf16x8*)(VT + (16 * vs + n) * RPP + 32 * ks + 8 * g4);
#pragma unroll
              for (int mt = 0; mt < 4; ++mt) { bf16x8 fb[2], fm[2], fk[2], fr[2];
#pragma unroll
                  for (int ks = 0; ks < 2; ++ks) { fb[ks] = ld_pi(BdT + (16 * mt + n) * RPP, ks, g4); fm[ks] = ld_pi(Mrb + (16 * mt + n) * RPP, ks, g4);
                      fk[ks] = *(const LAS bf16x8*)(KdT + (16 * mt + n) * RPP + 32 * ks + 8 * g4); fr[ks] = *(const LAS bf16x8*)(Mrk + (16 * mt + n) * RPP + 32 * ks + 8 * g4); }
                  SB();
                  f32x4 q = {0.f, 0.f, 0.f, 0.f}, o0 = {0.f, 0.f, 0.f, 0.f};
#pragma unroll
                  for (int ks = 0; ks < 2; ++ks) { q = __builtin_amdgcn_mfma_f32_16x16x32_bf16(fb[ks], xf[ks], q, 0, 0, 0); o0 = __builtin_amdgcn_mfma_f32_16x16x32_bf16(xf[ks], fm[ks], o0, 0, 0, 0);
                      q = __builtin_amdgcn_mfma_f32_16x16x32_bf16(fk[ks], vf[ks], q, 0, 0, 0); o0 = __builtin_amdgcn_mfma_f32_16x16x32_bf16(vf[ks], fr[ks], o0, 0, 0, 0); }
                  u32x2 qo; qo.x = pk2(q[0], q[1]); qo.y = pk2(q[2], q[3]);
                  *(GAS u32x2*)(ck + CK_Q + ((size_t)((vs * 4 + mt) * 64 + lane)) * 8) = qo;
                  { u32x2 oo; oo.x = pk2(o0[0], o0[1]); oo.y = pk2(o0[2], o0[3]); *(GAS u32x2*)(ck + CK_O0 + ((size_t)((vs * 4 + mt) * 64 + lane)) * 8) = oo; }
                  SB(); } } }
        __syncthreads();
    }
}

DI void x0_phase(const Frame& F, const float* x, bf16* xb, float* ssq) {
    const int gw = F.bid * 8 + F.wave, NGW = F.G * 8;
    for (int m = gw; m < M; m += NGW) {
        const GAS f32x4* xr = (const GAS f32x4*)(x + (size_t)m * D) + F.lane;
        f32x4 v[8]; float s = 0.f;
#pragma unroll
        for (int j = 0; j < 8; ++j) { v[j] = xr[64 * j]; s += (v[j].x * v[j].x + v[j].y * v[j].y) + (v[j].z * v[j].z + v[j].w * v[j].w); }
        s = wave_sum(s);
        GAS u32x2* o = (GAS u32x2*)(xb + (size_t)m * XP) + F.lane;
#pragma unroll
        for (int j = 0; j < 8; ++j) { u32x2 w; w.x = pk2(v[j].x, v[j].y); w.y = pk2(v[j].z, v[j].w); o[64 * j] = w; }
        if (F.lane < 32) ssq[(size_t)m * 32 + F.lane] = (F.lane == 0) ? s : 0.f;
    }
}
constexpr int RS_OFF = STAGE_BYTES;
static_assert(RS_OFF + 2048 * 4 <= MISC_OFF, "rstd table");
DI const LAS float* rstd_table(const Frame& F) {
    LAS float* const tab = (LAS float*)(F.lds + RS_OFF);
    const int base = (F.bid & 7) * 2048;
    const float* P = (const float*)(F.ws + WS_SSQ) + (size_t)base * 32;
    for (int r = F.tid; r < 2048; r += 512) { f32x4 p[8];
#pragma unroll
        for (int q = 0; q < 8; ++q) p[q] = ((const GAS f32x4*)(P + (size_t)r * 32))[q];
        SB();
        f32x4 t = (p[0] + p[1]) + (p[2] + p[3]) + ((p[4] + p[5]) + (p[6] + p[7]));
        tab[r] = 1.f / sqrtf(((t[0] + t[1]) + (t[2] + t[3])) * (1.f / D) + NORM_EPS);
        SB(); }
    __syncthreads();
    return tab - base;
}
constexpr size_t ALG_BYTES = (size_t)64 * AL_PITCH * 2;
template <int K, int KOFF, int L>
DI void lora_tile_g(const bf16* ALG, const bf16* Bt, LAS float* PO, int h, int mt, int np, int fr, int fq) {
    constexpr int NK = K / 32;
    bf16x8 bv[2][NK], av[NK];
    unsigned lo = (unsigned)(fr + 16 * fq) * 16u; asm volatile("" : "+v"(lo));
    const unsigned char* const ab = (const unsigned char*)ALG + (size_t)(mt * 17 + KOFF / 32) * 1024;
    const unsigned char* const bb = (const unsigned char*)Bt + (size_t)((4 * h + 2 * np) * NK) * 1024;
#pragma unroll
    for (int ks = 0; ks < NK; ++ks) { av[ks] = *(const GAS bf16x8*)(ab + ks * 1024 + lo);
#pragma unroll
        for (int nn = 0; nn < 2; ++nn) bv[nn][ks] = *(const GAS bf16x8*)(bb + (nn * NK + ks) * 1024 + lo); }
    SB();
#pragma unroll
    for (int nn = 0; nn < 2; ++nn) { const int nt = 2 * np + nn; f32x4 acc = {0.f, 0.f, 0.f, 0.f};
#pragma unroll
        for (int ks = 0; ks < NK; ++ks) acc = __builtin_amdgcn_mfma_f32_16x16x32_bf16(av[ks], bv[nn][ks], acc, 0, 0, 0);
#pragma unroll
        for (int i = 0; i < 4; ++i) PO[(L * 64 + 16 * mt + 4 * fq + i) * PO_PITCH + 16 * nt + fr] = acc[i]; }
    SB();
}
static_assert(3 * 64 * PO_PITCH * 4 <= RP_LAK && RP_END + 64 * PO_PITCH * 4 + 9 * 64 * 4 <= MISC_OFF, "the LoRA output tiles overlay only images that are rewritten for every item");

DI void rwkv_fused_phase(const Frame& F, const CAS Args& a, int l) {
    const bf16* Z = (const bf16*)(F.ws + WS_R2);
    const RwPrep P = rwprep_ptrs(F);
    LAS unsigned char* const lds = F.lds;
    LAS float* const PO = (LAS float*)lds;
    LAS float* const PO3 = (LAS float*)(lds + RP_END) - 3 * 64 * PO_PITCH;
    LAS bf16* const At = (LAS bf16*)(lds + RP_AT); LAS bf16* const Bt = (LAS bf16*)(lds + RP_BT); LAS bf16* const Kt = (LAS bf16*)(lds + RP_KT); LAS bf16* const Rt = (LAS bf16*)(lds + RP_RT);
    LAS bf16* const BdT = (LAS bf16*)(lds + RP_BDT); LAS bf16* const KdT = (LAS bf16*)(lds + RP_KDT); LAS bf16* const VT = (LAS bf16*)(lds + RP_VT);
    LAS bf16* const Lak = (LAS bf16*)(lds + RP_LAK); LAS bf16* const Mrb = (LAS bf16*)(lds + RP_MRB); LAS bf16* const Mrk = (LAS bf16*)(lds + RP_MRK);
    LAS float* const Lm = (LAS float*)(lds + RP_L); LAS float* const cum = (LAS float*)(lds + RP_CUM); LAS float* const Tbb = (LAS float*)(lds + RP_TBB); LAS float* const seg = (LAS float*)(lds + RP_SEG);
    const float* mu = a.in[14] + (size_t)l * RWCOLS;
    const float* vmu = a.in[26] + (size_t)__builtin_amdgcn_readfirstlane(l > 0 ? l - 1 : 0) * 64;
    const bf16* WLt = (const bf16*)lw(F, l, LW_WL); const bf16* ALt = (const bf16*)lw(F, l, LW_AL); const bf16* GLt = (const bf16*)lw(F, l, LW_GL); const bf16* VBt = (const bf16*)lw(F, l, LW_VB);
    bf16* const ALG = (bf16*)(F.ws + WS_ALG + (size_t)F.bid * ALG_BYTES);
    const int lane = F.lane, w = F.wave, n = lane & 15, g4 = lane >> 4;
    { unsigned zz = 0u; asm volatile("" : "+v"(zz));
      for (int q = F.tid; q < (RP_CUM - RP_LAK) / 16; q += 512) *(LAS u32x4*)(lds + RP_LAK + q * 16) = (u32x4){zz, zz, zz, zz}; }
    __syncthreads();
    for (int c = F.bid; c < NCH; c += F.G) {
        if (F.tid < 476) { int cc = F.tid % 68; asm volatile("" : "+v"(cc)); const int j = cc * 8; int r0 = F.tid / 68;
            const int zc = (j < 480) ? ZC_WIN + j : ZC_VRES + (j - 480); const float* mp = (j < 480) ? mu + (ZC_WIN - ZC_R) + j : vmu + (j - 480);
            const int kind = (j < 96) ? 0 : ((j >= 224 && j < 480) ? 2 : ((j >= 480 && l == 0) ? 3 : 1));
            const f32x4 m0 = *(const GAS f32x4*)mp, m1 = *(const GAS f32x4*)(mp + 4);
            unsigned jfo = (unsigned)((j >> 5) * 1024 + ((j & 31) >> 3) * 256); asm volatile("" : "+v"(jfo));
#define SA_LOAD(cu, pr, ib) do { _Pragma("unroll") for (int u = 0; u < 3; ++u) { const int r = r0 + 7 * (3 * (ib) + u), rr = r < 64 ? r : 63, gr = 64 * c + rr; \
                    cu[u] = *(const GAS u32x4*)(Z + (size_t)gr * ZP + zc); pr[u] = *(const GAS u32x4*)(Z + (size_t)(gr > 0 ? gr - 1 : 0) * ZP + zc); } } while (0)
#define SA_COMP(cu, pr, ib) do { _Pragma("unroll") for (int u = 0; u < 3; ++u) { const int r = r0 + 7 * (3 * (ib) + u); if (r < 64) { const int gr = 64 * c + r; \
                    float cur[8], prv[8], o[8]; unpack8(cu[u], cur); unpack8(pr[u], prv); \
                    _Pragma("unroll") for (int e = 0; e < 8; ++e) { const float pv = gr > 0 ? prv[e] : 0.f; const float mm = e < 4 ? m0[e] : m1[e - 4]; o[e] = cur[e] + (pv - cur[e]) * mm; } \
                    if (kind == 0) { _Pragma("unroll") for (int e = 0; e < 8; ++e) o[e] = 1.f - 2.f * __builtin_amdgcn_rcpf(__expf(2.f * o[e]) + 1.f); } \
                    else if (kind == 2) { _Pragma("unroll") for (int e = 0; e < 8; ++e) o[e] = sigmoidf_(o[e]); } \
                    else if (kind == 3) { _Pragma("unroll") for (int e = 0; e < 8; ++e) o[e] = 0.f; } \
                    *(GAS u32x4*)((GAS unsigned char*)ALG + (unsigned)((r >> 4) * (17 * 1024) + (r & 15) * 16) + jfo) = pack8(o); } } } while (0)
            u32x4 cuA[3], prA[3];
            for (int ib = 0; ib < 4; ++ib) {
                asm volatile("" : "+v"(r0));
                SA_LOAD(cuA, prA, ib);
                SB();
                SA_COMP(cuA, prA, ib);
                SB();
            }
#undef SA_LOAD
#undef SA_COMP
            }
        __builtin_amdgcn_fence(__ATOMIC_RELEASE, "workgroup");
        __syncthreads();
        __builtin_amdgcn_fence(__ATOMIC_ACQUIRE, "workgroup");
        float* const LWp = (float*)(F.ws + WS_R3) + (size_t)F.bid * (RH * 4096);
        bf16* const LAp = (bf16*)(F.ws + WS_R1) + (size_t)F.bid * (RH * 2 * 4096);
        { const int mt = w & 3, np = w >> 2;
          unsigned lo = (unsigned)lane * 16u; asm volatile("" : "+v"(lo));
          bf16x8 af[17];
#pragma unroll
          for (int i = 0; i < 17; ++i) af[i] = *(const GAS bf16x8*)((const unsigned char*)ALG + (size_t)(mt * 17 + i) * 1024 + lo);
          const int nch = (l > 0) ? 68 : 60;
#define LP_DMA(hh) do { LAS unsigned char* const bufd = lds + ((hh) & 1) * 69632; \
            for (int cix = w; cix < nch; cix += 8) { const unsigned char* srcp = (cix < 12) ? (const unsigned char*)WLt + (size_t)(4 * (hh) * 3 + cix) * 1024 : (cix < 28) ? (const unsigned char*)ALt + (size_t)(4 * (hh) * 4 + cix - 12) * 1024 \
                    : (cix < 60) ? (const unsigned char*)GLt + (size_t)(4 * (hh) * 8 + cix - 28) * 1024 : (const unsigned char*)VBt + (size_t)(4 * (hh) * 2 + cix - 60) * 1024; \
                __builtin_amdgcn_global_load_lds((const unsigned*)(srcp + lo), (LAS unsigned*)(bufd + cix * 1024), 16, 0, 0); } } while (0)
#define LP_TILE(NK, KO, OFF, STORE) do { \
            _Pragma("unroll") for (int nn = 0; nn < 2; ++nn) { bf16x8 bfr[NK]; \
                _Pragma("unroll") for (int ks = 0; ks < NK; ++ks) bfr[ks] = *(const LAS bf16x8*)(bufc + ((OFF) + (2 * np + nn) * (NK) + ks) * 1024 + lane * 16); \
                SB(); \
                f32x4 acc = {0.f, 0.f, 0.f, 0.f}; \
                _Pragma("unroll") for (int ks = 0; ks < NK; ++ks) acc = __builtin_amdgcn_mfma_f32_16x16x32_bf16(bfr[ks], af[(KO) + ks], acc, 0, 0, 0); \
                const int chu = 16 * (2 * np + nn); STORE; \
                SB(); } } while (0)
          LP_DMA(0);
          for (int h = 0; h < RH; ++h) {
              asm volatile("s_waitcnt vmcnt(0)" ::: "memory");
              __syncthreads();
              if (h + 1 < RH) LP_DMA(h + 1);
              const LAS unsigned char* const bufc = lds + (h & 1) * 69632;
              unsigned lof = (unsigned)(((16 * mt + n) * 64 + 4 * g4) * 2); asm volatile("" : "+v"(lof));
              LP_TILE(3, 0, 0, *(GAS f32x4*)((unsigned char*)(LWp + (size_t)h * 4096 + chu) + 2 * lof) = acc);
              LP_TILE(4, 3, 12, { u32x2 o; o.x = pk2(acc[0], acc[1]); o.y = pk2(acc[2], acc[3]); *(GAS u32x2*)((unsigned char*)(LAp + (size_t)(h * 2 + 0) * 4096 + chu) + lof) = o; });
              LP_TILE(8, 7, 28, { u32x2 o; o.x = pk2(acc[0], acc[1]); o.y = pk2(acc[2], acc[3]); *(GAS u32x2*)((unsigned char*)(P.G + ((size_t)h * M + 64 * c) * 64 + chu) + lof) = o; });
              if (l > 0) LP_TILE(2, 15, 60, { u32x2 o; o.x = pk2(acc[0], acc[1]); o.y = pk2(acc[2], acc[3]); *(GAS u32x2*)((unsigned char*)(LAp + (size_t)(h * 2 + 1) * 4096 + chu) + lof) = o; });
          }
#undef LP_DMA
#undef LP_TILE
        }
        asm volatile("s_waitcnt vmcnt(0)" ::: "memory");
        __builtin_amdgcn_fence(__ATOMIC_RELEASE, "workgroup");
        __syncthreads();
        __builtin_amdgcn_fence(__ATOMIC_ACQUIRE, "workgroup");
        { unsigned zz = 0u; asm volatile("" : "+v"(zz));
          for (int q = F.tid; q < (RP_CUM - RP_LAK) / 16; q += 512) *(LAS u32x4*)(lds + RP_LAK + q * 16) = (u32x4){zz, zz, zz, zz}; }
        __syncthreads();
        for (int h = 0; h < RH; ++h) {
            const int t = F.tid >> 3, cg = F.tid & 7, gr = 64 * c + t; int ch = h * 64 + 8 * cg;
            asm volatile("" : "+v"(ch));
            unsigned pol = (unsigned)(((size_t)h * M + gr) * 64 + 8 * cg); asm volatile("" : "+v"(pol)); const size_t po = pol;
            int hrow = h * 64 + n; asm volatile("" : "+v"(hrow));
            unsigned char* const ck = ck_ptr(F, c, h);
            u32x4 zc_[3], zp_[3];
            LAS float* const PRM = (LAS float*)(lds + RP_END + 64 * PO_PITCH * 4);
            f32x4 prmv = {0.f, 0.f, 0.f, 0.f};
            { unsigned pq = (unsigned)(F.tid < 144 ? F.tid : 0) * 16u; asm volatile("" : "+v"(pq));
              prmv = *(const GAS f32x4*)((const unsigned char*)(F.ws + WS_PRM) + (size_t)((l * RH + h) * 576) * 4 + pq); }
            f32x4 pvf[2], wl_[2]; u32x4 al_, vl_ = {0u, 0u, 0u, 0u};
            { unsigned lro = (unsigned)((h * 64 + t) * 64 + 8 * cg); asm volatile("" : "+v"(lro));
              wl_[0] = *(const GAS f32x4*)(LWp + lro); wl_[1] = *(const GAS f32x4*)(LWp + lro + 4);
              unsigned lao = (unsigned)(((h * 2) * 64 + t) * 64 + 8 * cg); asm volatile("" : "+v"(lao));
              al_ = *(const GAS u32x4*)(LAp + lao); if (l > 0) vl_ = *(const GAS u32x4*)(LAp + lao + 4096); }
#pragma unroll
            for (int q = 0; q < 2; ++q) pvf[q] = *(const GAS f32x4*)(P.VF + po + 4 * q);
#pragma unroll
            for (int which = 0; which < 3; ++which) { const int zc = (which == 0 ? ZC_R : (which == 1 ? ZC_K : ZC_V)) + ch;
                zc_[which] = *(const GAS u32x4*)(Z + (size_t)gr * ZP + zc); zp_[which] = *(const GAS u32x4*)(Z + (size_t)(gr > 0 ? gr - 1 : 0) * ZP + zc); }
            SB();
            if (F.tid < 144) *(LAS f32x4*)(PRM + 4 * F.tid) = prmv;
            asm volatile("s_waitcnt lgkmcnt(0)" ::: "memory");
            __builtin_amdgcn_s_barrier();
            SB();
            float r[8], k2[8], kk[8], bb[8], v[8], lwv[8];
            { float k[8];
#pragma unroll
              for (int which = 0; which < 3; ++which) { float cu[8], pr[8]; unpack8(zc_[which], cu); unpack8(zp_[which], pr);
#pragma unroll
                  for (int e = 0; e < 8; ++e) { const float pv = gr > 0 ? pr[e] : 0.f; const float mm = PRM[which * 64 + 8 * cg + e]; const float zs = cu[e] + (pv - cu[e]) * mm;
                      if (which == 0) r[e] = zs; else if (which == 1) k[e] = zs; else v[e] = zs; } }
              SB();
              if (l > 0) { float vpre[8]; unpack8(vl_, vpre);
#pragma unroll
                  for (int e = 0; e < 8; ++e) { const float vg = sigmoidf_(PRM[8 * 64 + 8 * cg + e] + vpre[e]); const float vf = pvf[e >> 2][e & 3]; v[e] = v[e] + (vf - v[e]) * vg; } }
              *(GAS u32x4*)(P.V + po) = pack8(v);
              if (l == 0) { *(GAS f32x4*)(P.VF + po) = (f32x4){v[0], v[1], v[2], v[3]}; *(GAS f32x4*)(P.VF + po + 4) = (f32x4){v[4], v[5], v[6], v[7]}; }
              SB();
              { float wpre[8];
#pragma unroll
                for (int q = 0; q < 2; ++q) { wpre[4 * q] = wl_[q][0]; wpre[4 * q + 1] = wl_[q][1]; wpre[4 * q + 2] = wl_[q][2]; wpre[4 * q + 3] = wl_[q][3]; }
#pragma unroll
                for (int e = 0; e < 8; ++e) { const float wv = -softplusf_(-(PRM[3 * 64 + 8 * cg + e] + wpre[e])) - 0.5f; lwv[e] = -__expf(wv); } }
              *(LAS f32x4*)(cum + t * 68 + 8 * cg) = (f32x4){lwv[0], lwv[1], lwv[2], lwv[3]}; *(LAS f32x4*)(cum + t * 68 + 8 * cg + 4) = (f32x4){lwv[4], lwv[5], lwv[6], lwv[7]};
              SB();
              float av[8], apre[8]; float ss = 0.f, bc = 0.f;
              unpack8(al_, apre);
#pragma unroll
              for (int e = 0; e < 8; ++e) {
                  av[e] = sigmoidf_(PRM[4 * 64 + 8 * cg + e] + apre[e]);
                  kk[e] = k[e] * PRM[5 * 64 + 8 * cg + e]; ss += kk[e] * kk[e];
                  k2[e] = k[e] * (1.f + (av[e] - 1.f) * PRM[6 * 64 + 8 * cg + e]); bc += r[e] * k2[e] * PRM[7 * 64 + 8 * cg + e]; }
              ss = sum8(ss); bc = sum8(bc); const float rn = 1.f / sqrtf(fmaxf(ss, 1e-24f));
#pragma unroll
              for (int e = 0; e < 8; ++e) { kk[e] *= rn; bb[e] = kk[e] * av[e]; }
              if (cg == 0) P.BC[(size_t)h * M + gr] = bc; }
            __syncthreads();
            { const int pk_ = F.tid & 63, ptq = F.tid >> 6; float run = 0.f;
#pragma unroll
              for (int i = 0; i < 8; ++i) { run += cum[(8 * ptq + i) * 68 + pk_]; cum[(8 * ptq + i) * 68 + pk_] = run; }
              seg[ptq * 64 + pk_] = run;
              __syncthreads();
              float off = 0.f;
              for (int q = 0; q < ptq; ++q) off += seg[q * 64 + pk_];
#pragma unroll
              for (int i = 0; i < 8; ++i) cum[(8 * ptq + i) * 68 + pk_] += off; }
            __syncthreads();
            { float cmv[8], ccv[8];
              { const f32x4 c0 = *(const LAS f32x4*)(cum + t * 68 + 8 * cg), c1 = *(const LAS f32x4*)(cum + t * 68 + 8 * cg + 4), d0 = *(const LAS f32x4*)(cum + 63 * 68 + 8 * cg), d1 = *(const LAS f32x4*)(cum + 63 * 68 + 8 * cg + 4);
#pragma unroll
                for (int e = 0; e < 4; ++e) { cmv[e] = c0[e]; cmv[4 + e] = c1[e]; ccv[e] = d0[e]; ccv[4 + e] = d1[e]; } }
              float at[8], bt[8], kt[8], rt[8];
#pragma unroll
              for (int e = 0; e < 8; ++e) { const float cm = cmv[e], cC = ccv[e];
                  const float ein = __expf(cm), einv = __expf(-cm), eex = __expf(cm - lwv[e]), ed = __expf(cC - cm);
                  at[e] = -kk[e] * eex; bt[e] = bb[e] * einv; kt[e] = k2[e] * einv; rt[e] = r[e] * ein;
                  const unsigned pbd = pk2(bb[e] * ed, k2[e] * ed);
                  BdT[(8 * cg + e) * RPP + t] = (bf16)(pbd & 0xffffu); KdT[(8 * cg + e) * RPP + t] = (bf16)(pbd >> 16);
                  VT[(8 * cg + e) * RPP + t] = (bf16)(pk2(v[e], 0.f) & 0xffffu); }
              *(LAS u32x4*)(At + t * RPP + 8 * cg) = pack8(at); *(LAS u32x4*)(Bt + t * RPP + 8 * cg) = pack8(bt); *(LAS u32x4*)(Kt + t * RPP + 8 * cg) = pack8(kt); *(LAS u32x4*)(Rt + t * RPP + 8 * cg) = pack8(rt);
              if (F.tid < 64) ((GAS float*)(ck + CK_GC))[F.tid] = __expf(cum[63 * 68 + F.tid]); }
            __syncthreads();
            rwkv_chunk_tail(F, ck, At, Bt, Kt, Rt, BdT, KdT, VT, Lak, Mrb, Mrk, Lm, Tbb);
        }
    }
}

constexpr int SC_SLOT = 8192 + 2048 + 512, SC_NS = 14;
static_assert(SC_NS * SC_SLOT <= MISC_OFF, "scan ring");
DI void rwkv_scan_phase(const Frame& F, int h, int vs) {
    LAS unsigned char* const lds = F.lds;
    const int lane = F.lane, w = F.wave, g4 = lane >> 4;
    if (w >= 4) {
        const int lw_ = w - 4;
#define SC_DMA(cc) do { const int cq_ = (cc) < NCH ? (cc) : NCH - 1; const unsigned char* ck_ = ck_ptr(F, cq_, h); LAS unsigned char* sl_ = lds + ((cc) % SC_NS) * SC_SLOT; \
            _Pragma("unroll") for (int i_ = 0; i_ < 2; ++i_) __builtin_amdgcn_global_load_lds((const unsigned*)(ck_ + CK_PL + (size_t)((lw_ * 2 + i_) * 64 + lane) * 16), (LAS unsigned*)(sl_ + (lw_ * 2 + i_) * 1024), 16, 0, 0); \
            if (lw_ < 2) __builtin_amdgcn_global_load_lds((const unsigned*)(ck_ + CK_Q + (size_t)vs * 2048 + (size_t)(lw_ * 64 + lane) * 16), (LAS unsigned*)(sl_ + 8192 + lw_ * 1024), 16, 0, 0); \
            else __builtin_amdgcn_global_load_lds((const unsigned*)(ck_ + CK_GC + (size_t)lane * 4), (LAS unsigned*)(sl_ + 10240 + (lw_ - 2) * 256), 4, 0, 0); } while (0)
        for (int cc = 0; cc < SC_NS - 1; ++cc) SC_DMA(cc);
        asm volatile("s_waitcnt vmcnt(33)" ::: "memory");
        __builtin_amdgcn_s_barrier();
        for (int c = 0; c < NCH; ++c) {
            SC_DMA(c + SC_NS - 1);
            asm volatile("s_waitcnt vmcnt(33)" ::: "memory");
            __builtin_amdgcn_s_barrier();
        }
#undef SC_DMA
    } else if (w == 0) {
        f32x4 Hf[4];
#pragma unroll
        for (int mt = 0; mt < 4; ++mt) Hf[mt] = (f32x4){0.f, 0.f, 0.f, 0.f};
        __builtin_amdgcn_s_barrier();
        f32x4 gqA[4], gqB[4]; u32x2 qqA[4], qqB[4]; bf16x8 pfA[4][2], pfB[4][2];
#define SC_LDS(cc, gq, qq, pf) do { const LAS unsigned char* sl = lds + ((cc) % SC_NS) * SC_SLOT; \
            _Pragma("unroll") for (int mt = 0; mt < 4; ++mt) { gq[mt] = *(const LAS f32x4*)(sl + 10240 + (16 * mt + 4 * g4) * 4); qq[mt] = *(const LAS u32x2*)(sl + 8192 + (size_t)(mt * 64 + lane) * 8); \
                _Pragma("unroll") for (int ks = 0; ks < 2; ++ks) pf[mt][ks] = *(const LAS bf16x8*)(sl + (size_t)((mt * 2 + ks) * 64 + lane) * 16); } } while (0)
#define SC_STEP(c, gq, qq, pf, gqn, qqn, pfn) do { \
            SC_LDS((c) + 1, gqn, qqn, pfn); SB(); \
            f32x4 acc[4]; \
            bf16x8 hb[2]; hb[0] = pack_pi(Hf[0], Hf[1]); hb[1] = pack_pi(Hf[2], Hf[3]); \
            unsigned char* ck = ck_ptr(F, (c), h); \
            _Pragma("unroll") for (int ks = 0; ks < 2; ++ks) *(GAS bf16x8*)(ck + CK_H + (size_t)((vs * 2 + ks) * 64 + lane) * 16) = hb[ks]; \
            _Pragma("unroll") for (int mt = 0; mt < 4; ++mt) { const f32x4 qf = {bflo(qq[mt].x), bfhi(qq[mt].x), bflo(qq[mt].y), bfhi(qq[mt].y)}; acc[mt] = gq[mt] * Hf[mt] + qf; } \
            _Pragma("unroll") for (int ks = 0; ks < 2; ++ks) \
                _Pragma("unroll") for (int mt = 0; mt < 4; ++mt) acc[mt] = __builtin_amdgcn_mfma_f32_16x16x32_bf16(pf[mt][ks], hb[ks], acc[mt], 0, 0, 0); \
            _Pragma("unroll") for (int mt = 0; mt < 4; ++mt) Hf[mt] = acc[mt]; \
            SB(); \
            asm volatile("s_waitcnt lgkmcnt(0)" ::: "memory"); \
            __builtin_amdgcn_s_barrier(); } while (0)
        SC_LDS(0, gqA, qqA, pfA);
        for (int c = 0; c < NCH; c += 2) {
            SC_STEP(c, gqA, qqA, pfA, gqB, qqB, pfB);
            SC_STEP(c + 1, gqB, qqB, pfB, gqA, qqA, pfA);
        }
#undef SC_STEP
#undef SC_LDS
    } else {
        for (int c = 0; c <= NCH; ++c) __builtin_amdgcn_s_barrier();
    }
}

DI float sum16(float v) { v += __builtin_bit_cast(float, __builtin_amdgcn_update_dpp(0, __builtin_bit_cast(int, v), 0xB1, 0xF, 0xF, true));
                          v += __builtin_bit_cast(float, __builtin_amdgcn_update_dpp(0, __builtin_bit_cast(int, v), 0x4E, 0xF, 0xF, true));
                          v += __builtin_bit_cast(float, __builtin_amdgcn_update_dpp(0, __builtin_bit_cast(int, v), 0x141, 0xF, 0xF, true));
                          v += __builtin_bit_cast(float, __builtin_amdgcn_update_dpp(0, __builtin_bit_cast(int, v), 0x140, 0xF, 0xF, true)); return v; }
DI void rwkv_post_phase(const Frame& F, const CAS Args& a, int l) {
    const RwPrep P = rwprep_ptrs(F);
    bf16* ycat = (bf16*)(F.ws + WS_R3);
    const int lane = F.lane, n = lane & 15, g4 = lane >> 4;
    const int gw = F.bid * 8 + F.wave, NGW = F.G * 8;
#define XSUM(v) do { v += __builtin_bit_cast(float, __builtin_amdgcn_ds_bpermute(a16, __builtin_bit_cast(int, v))); v += __builtin_bit_cast(float, __builtin_amdgcn_ds_bpermute(a32, __builtin_bit_cast(int, v))); } while (0)
    for (int it = gw; it < NCH * RH * 4; it += NGW) {
        const int mt = it & 3, ch_ = it >> 2, c = ch_ / RH, h = ch_ - c * RH;
        const unsigned char* ck = ck_ptr(F, c, h);
        bf16x8 af[2], hf[4][2]; f32x4 acc[4], lw4[4], lb4[4]; u32x2 vv[4], gg[4];
        const int t = 64 * c + 16 * mt + n; const size_t po = ((size_t)h * M + t) * 64 + 4 * g4;
        int a16 = (lane ^ 16) << 2, a32 = (lane ^ 32) << 2; asm volatile("" : "+v"(a16), "+v"(a32));
#pragma unroll
        for (int ks = 0; ks < 2; ++ks) af[ks] = *(const GAS bf16x8*)(ck + CK_RP + (size_t)((mt * 2 + ks) * 64 + lane) * 16);
#pragma unroll
        for (int nt = 0; nt < 4; ++nt) { { const u32x2 oo = *(const GAS u32x2*)(ck + CK_O0 + (size_t)((nt * 4 + mt) * 64 + lane) * 8); acc[nt] = (f32x4){bflo(oo.x), bfhi(oo.x), bflo(oo.y), bfhi(oo.y)}; }
#pragma unroll
            for (int ks = 0; ks < 2; ++ks) hf[nt][ks] = *(const GAS bf16x8*)(ck + CK_H + (size_t)((nt * 2 + ks) * 64 + lane) * 16);
            vv[nt] = *(const GAS u32x2*)(P.V + po + 16 * nt); gg[nt] = *(const GAS u32x2*)(P.G + po + 16 * nt); }
        const float bcv = P.BC[(size_t)h * M + t];
#pragma unroll
        for (int nt = 0; nt < 4; ++nt) { lw4[nt] = *(const GAS f32x4*)(a.in[23] + (size_t)l * RW + h * 64 + 16 * nt + 4 * g4); lb4[nt] = *(const GAS f32x4*)(a.in[24] + (size_t)l * RW + h * 64 + 16 * nt + 4 * g4); }
        SB();
#pragma unroll
        for (int nt = 0; nt < 4; ++nt)
#pragma unroll
            for (int ks = 0; ks < 2; ++ks) acc[nt] = __builtin_amdgcn_mfma_f32_16x16x32_bf16(hf[nt][ks], af[ks], acc[nt], 0, 0, 0);
        float s = 0.f;
#pragma unroll
        for (int nt = 0; nt < 4; ++nt) s += (acc[nt][0] + acc[nt][1]) + (acc[nt][2] + acc[nt][3]);
        XSUM(s); const float mean = s * (1.f / 64.f);
        float vs = 0.f;
#pragma unroll
        for (int nt = 0; nt < 4; ++nt)
#pragma unroll
            for (int r = 0; r < 4; ++r) { const float d = acc[nt][r] - mean; vs += d * d; }
        XSUM(vs); const float rstd = 1.f / sqrtf(vs * (1.f / 64.f) + 64e-5f);
#pragma unroll
        for (int nt = 0; nt < 4; ++nt) { const float v0 = bflo(vv[nt].x), v1 = bfhi(vv[nt].x), v2 = bflo(vv[nt].y), v3 = bfhi(vv[nt].y), g0 = bflo(gg[nt].x), g1 = bfhi(gg[nt].x), g2 = bflo(gg[nt].y), g3 = bfhi(gg[nt].y);
            const float y0 = ((acc[nt][0] - mean) * rstd * lw4[nt][0] + lb4[nt][0] + bcv * v0) * g0, y1 = ((acc[nt][1] - mean) * rstd * lw4[nt][1] + lb4[nt][1] + bcv * v1) * g1;
            const float y2 = ((acc[nt][2] - mean) * rstd * lw4[nt][2] + lb4[nt][2] + bcv * v2) * g2, y3 = ((acc[nt][3] - mean) * rstd * lw4[nt][3] + lb4[nt][3] + bcv * v3) * g3;
            u32x2 o; o.x = pk2(y0, y1); o.y = pk2(y2, y3);
            *(GAS u32x2*)(ycat + (size_t)t * D + S5W + h * 64 + 16 * nt + 4 * g4) = o; }
    }
#undef XSUM
}
constexpr size_t GK_E = 0, GK_H = 32768, GK_GC = 49152, GK_SIZE = 49408;
DI unsigned char* gk_ptr(const Frame& F, int c, int h) { return F.ws + WS_GK + ((size_t)c * GH + h) * GK_SIZE; }
constexpr int GP_CUM = 0, GP_SEG = 17408, GP_KDT = GP_SEG + 2048, GP_VT = GP_KDT + 9216, GP_QT = GP_VT + 18432, GP_KT = GP_QT + 9216, GP_ATT = GP_KT + 9216, GP_PART = GP_ATT + 9216, GP_END = GP_PART + 2048;
static_assert(GP_END <= MISC_OFF, "gla LDS");

DI void gla_store_vt(const Frame& F, const u32x4 (&rv)[2], LAS bf16* VT) {
#pragma unroll
    for (int half = 0; half < 2; ++half) { const int t = F.tid >> 3, v0 = 64 * half + 8 * (F.tid & 7); float f[8]; unpack8(rv[half], f);
#pragma unroll
        for (int e = 0; e < 8; ++e) VT[(v0 + e) * RPP + t] = (bf16)(pk2(f[e], 0.f) & 0xffffu); }
}
DI void gla_pre_phase(const Frame& F, const CAS Args& a, int l) {
    const bf16* Z = (const bf16*)(F.ws + WS_R2);
    LAS float* const cum = (LAS float*)(F.lds + GP_CUM); LAS float* const seg = (LAS float*)(F.lds + GP_SEG);
    LAS bf16* const KdT = (LAS bf16*)(F.lds + GP_KDT); LAS bf16* const VT = (LAS bf16*)(F.lds + GP_VT);
    const int lane = F.lane, w = F.wave, n = lane & 15, g4 = lane >> 4;
    const int t = F.tid >> 3, cg = F.tid & 7;
    u32x4 rv[2], rk, rq, ra0, ra1;
#define GP_LOADZ(itx) do { const int c_ = (itx) / GH, h_ = (itx) - c_ * GH; const bf16* zr_ = Z + (size_t)(64 * c_ + t) * ZP; \
        rv[0] = *(const GAS u32x4*)(zr_ + ZC_GV + h_ * 128 + 8 * cg); rv[1] = *(const GAS u32x4*)(zr_ + ZC_GV + h_ * 128 + 64 + 8 * cg); \
        rk = *(const GAS u32x4*)(zr_ + ZC_GKK + h_ * 64 + 8 * cg); rq = *(const GAS u32x4*)(zr_ + ZC_GQ + h_ * 64 + 8 * cg); \
        ra0 = *(const GAS u32x4*)(zr_ + ZC_GA); ra1 = *(const GAS u32x4*)(zr_ + ZC_GA + 8); } while (0)
    if (F.bid < NCH * GH) GP_LOADZ(F.bid);
    for (int it = F.bid; it < NCH * GH; it += F.G) {
        const int c = it / GH, h = it - c * GH;
        unsigned char* const gk = gk_ptr(F, c, h);
        unsigned char* const qkimg = F.ws + WS_GQK + (size_t)it * 16384; unsigned char* const vimg = F.ws + WS_GVP + (size_t)it * 16384;
        { const float* alora = a.in[29] + (size_t)l * 16 * GK + h * 64 + 8 * cg; const float* abias = a.in[30] + (size_t)l * GK + h * 64 + 8 * cg;
          const f32x4 b0 = *(const GAS f32x4*)abias, b1 = *(const GAS f32x4*)(abias + 4);
          f32x4 w0[16], w1[16];
#pragma unroll
          for (int j = 0; j < 16; ++j) { w0[j] = *(const GAS f32x4*)(alora + (size_t)j * GK); w1[j] = *(const GAS f32x4*)(alora + (size_t)j * GK + 4); }
          SB();
          float ain[16]; { float f0[8], f1[8]; unpack8(ra0, f0); unpack8(ra1, f1);
#pragma unroll
              for (int e = 0; e < 8; ++e) { ain[e] = f0[e]; ain[8 + e] = f1[e]; } }
          float x[8]; x[0] = b0[0]; x[1] = b0[1]; x[2] = b0[2]; x[3] = b0[3]; x[4] = b1[0]; x[5] = b1[1]; x[6] = b1[2]; x[7] = b1[3];
#pragma unroll
          for (int j = 0; j < 16; ++j) {
#pragma unroll
              for (int e = 0; e < 4; ++e) { x[e] += ain[j] * w0[j][e]; x[4 + e] += ain[j] * w1[j][e]; } }
          f32x4 o0, o1;
#pragma unroll
          for (int e = 0; e < 4; ++e) { o0[e] = -softplusf_(-x[e]) * (1.f / 16.f); o1[e] = -softplusf_(-x[4 + e]) * (1.f / 16.f); }
          *(LAS f32x4*)(cum + t * 68 + 8 * cg) = o0; *(LAS f32x4*)(cum + t * 68 + 8 * cg + 4) = o1; }
        __syncthreads();
        { const int k = F.tid & 63, tq = F.tid >> 6; float run = 0.f;
#pragma unroll
          for (int i = 0; i < 8; ++i) { run += cum[(8 * tq + i) * 68 + k]; cum[(8 * tq + i) * 68 + k] = run; }
          seg[tq * 64 + k] = run;
          __syncthreads();
          float off = 0.f;
          for (int q = 0; q < tq; ++q) off += seg[q * 64 + k];
#pragma unroll
          for (int i = 0; i < 8; ++i) cum[(8 * tq + i) * 68 + k] += off; }
        __syncthreads();
        { float kf[8], qf[8]; unpack8(rk, kf); unpack8(rq, qf);
          const f32x4 c0 = *(const LAS f32x4*)(cum + t * 68 + 8 * cg), c1 = *(const LAS f32x4*)(cum + t * 68 + 8 * cg + 4), d0 = *(const LAS f32x4*)(cum + 63 * 68 + 8 * cg), d1 = *(const LAS f32x4*)(cum + 63 * 68 + 8 * cg + 4);
          float qt[8], kt[8];
#pragma unroll
          for (int e = 0; e < 8; ++e) { const float cm = (e < 4 ? c0[e] : c1[e - 4]); const float ed = __expf((e < 4 ? d0[e] : d1[e - 4]) - cm); KdT[(8 * cg + e) * RPP + t] = (bf16)(pk2(kf[e] * ed, 0.f) & 0xffffu);
              qt[e] = qf[e] * 0.125f * __expf(cm); kt[e] = kf[e] * __expf(-cm); }
          { const int q3 = cg & 3; unsigned char* const qd = qkimg + (size_t)((((t >> 4) * 2 + (cg >> 2)) * 64 + (2 * (q3 & 1)) * 16 + (t & 15)) * 16 + (q3 >> 1) * 8);
            u32x2 o; o.x = pk2(qt[0], qt[1]); o.y = pk2(qt[2], qt[3]); *(GAS u32x2*)qd = o; o.x = pk2(qt[4], qt[5]); o.y = pk2(qt[6], qt[7]); *(GAS u32x2*)(qd + 256) = o;
            o.x = pk2(kt[0], kt[1]); o.y = pk2(kt[2], kt[3]); *(GAS u32x2*)(qd + 8192) = o; o.x = pk2(kt[4], kt[5]); o.y = pk2(kt[6], kt[7]); *(GAS u32x2*)(qd + 8192 + 256) = o; }
          if (F.tid < 64) ((GAS float*)(gk + GK_GC))[F.tid] = __expf(cum[63 * 68 + F.tid]); }
        gla_store_vt(F, rv, VT);
        SB();
        { const int itn = it + F.G; if (itn < NCH * GH) GP_LOADZ(itn); }
        SB();
        asm volatile("s_waitcnt lgkmcnt(0)" ::: "memory"); __builtin_amdgcn_s_barrier(); SB();
        { bf16x8 vf[2], kf_[4][2];
#pragma unroll
          for (int ks = 0; ks < 2; ++ks) { *(GAS bf16x8*)(vimg + (size_t)((w * 2 + ks) * 64 + lane) * 16) = ld_pi(VT + (16 * w + n) * RPP, ks, g4);
              vf[ks] = *(const LAS bf16x8*)(VT + (16 * w + n) * RPP + 32 * ks + 8 * g4);
#pragma unroll
              for (int mt = 0; mt < 4; ++mt) kf_[mt][ks] = *(const LAS bf16x8*)(KdT + (16 * mt + n) * RPP + 32 * ks + 8 * g4); }
          SB();
#pragma unroll
          for (int mt = 0; mt < 4; ++mt) { f32x4 acc = {0.f, 0.f, 0.f, 0.f};
#pragma unroll
              for (int ks = 0; ks < 2; ++ks) acc = __builtin_amdgcn_mfma_f32_16x16x32_bf16(kf_[mt][ks], vf[ks], acc, 0, 0, 0);
              *(GAS f32x4*)(gk + GK_E + (size_t)((w * 4 + mt) * 64 + lane) * 16) = acc; } }
        asm volatile("s_waitcnt lgkmcnt(0)" ::: "memory"); __builtin_amdgcn_s_barrier(); SB();
    }
#undef GP_LOADZ
}
DI void gla_scan_wave(const Frame& F, int item) {
    const int mt = item & 3, vs = (item >> 2) & 7, h = item >> 5;
    const int lane = F.lane, g4 = lane >> 4;
    f32x4 H = {0.f, 0.f, 0.f, 0.f};
    constexpr int U = 16;
    for (int c0 = 0; c0 < NCH; c0 += U) {
        f32x4 e[U], g[U];
#pragma unroll
        for (int u = 0; u < U; ++u) { const unsigned char* gk = gk_ptr(F, c0 + u, h); e[u] = *(const GAS f32x4*)(gk + GK_E + (size_t)((vs * 4 + mt) * 64 + lane) * 16); g[u] = *(const GAS f32x4*)(gk + GK_GC + (16 * mt + 4 * g4) * 4); }
        SB();
#pragma unroll
        for (int u = 0; u < U; ++u) { unsigned char* gk = gk_ptr(F, c0 + u, h);
            u32x2 o; o.x = pk2(H[0], H[1]); o.y = pk2(H[2], H[3]);
            *(GAS u32x2*)(gk + GK_H + (size_t)((vs * 2 + (mt >> 1)) * 64 + lane) * 16 + (mt & 1) * 8) = o;
            H = g[u] * H + e[u]; }
    }
}
#define GLDU(T, ubase, loff) (*(const GAS T*)((const unsigned char*)(ubase) + (loff)))
DI void gla_post_item(const Frame& F, const CAS Args& a, int l, int item) {
    const bf16* Z = (const bf16*)(F.ws + WS_R2);
    bf16* ycat = (bf16*)(F.ws + WS_R3);
    const int lane = F.lane, n = lane & 15, g4 = lane >> 4;
    const int mt = item & 3, ch_ = item >> 2, c = ch_ / GH, h = ch_ - c * GH;
    const unsigned char* const gk = gk_ptr(F, c, h) + GK_H;
    const unsigned char* const qk = F.ws + WS_GQK + (size_t)ch_ * 16384;
    const unsigned char* const vp = F.ws + WS_GVP + (size_t)ch_ * 16384;
    unsigned lo16 = (unsigned)lane * 16u; asm volatile("" : "+v"(lo16));
    bf16x8 qf[2], kf[4][2], hA[4][2], vA[4][2];
#pragma unroll
    for (int ks = 0; ks < 2; ++ks) qf[ks] = GLDU(bf16x8, qk + (mt * 2 + ks) * 1024, lo16);
#pragma unroll
    for (int ms = 0; ms < 4; ++ms)
#pragma unroll
        for (int ks = 0; ks < 2; ++ks) kf[ms][ks] = GLDU(bf16x8, qk + 8192 + (ms * 2 + ks) * 1024, lo16);
#pragma unroll
    for (int vt = 0; vt < 4; ++vt)
#pragma unroll
        for (int ks = 0; ks < 2; ++ks) { hA[vt][ks] = GLDU(bf16x8, gk + (vt * 2 + ks) * 1024, lo16); vA[vt][ks] = GLDU(bf16x8, vp + (vt * 2 + ks) * 1024, lo16); }
    SB();
    bf16x8 Pb[2];
    { f32x4 att[4];
#pragma unroll
      for (int ms = 0; ms < 4; ++ms) { att[ms] = (f32x4){0.f, 0.f, 0.f, 0.f};
          if (ms <= mt) {
#pragma unroll
              for (int ks = 0; ks < 2; ++ks) att[ms] = __builtin_amdgcn_mfma_f32_16x16x32_bf16(kf[ms][ks], qf[ks], att[ms], 0, 0, 0);
              if (ms == mt) {
#pragma unroll
                  for (int r = 0; r < 4; ++r) att[ms][r] = ((4 * g4 + r) <= n) ? att[ms][r] : 0.f; } } }
      Pb[0] = pack_pi(att[0], att[1]); Pb[1] = pack_pi(att[2], att[3]); }
    SB();
    bf16x8 hB[4][2], vB[4][2]; u32x2 gzr[8];
    const int tl = 64 * c + 16 * mt + n;
#pragma unroll
    for (int vt = 0; vt < 4; ++vt)
#pragma unroll
        for (int ks = 0; ks < 2; ++ks) { hB[vt][ks] = GLDU(bf16x8, gk + ((vt + 4) * 2 + ks) * 1024, lo16); vB[vt][ks] = GLDU(bf16x8, vp + ((vt + 4) * 2 + ks) * 1024, lo16); }
#pragma unroll
    for (int vt = 0; vt < 8; ++vt) gzr[vt] = *(const GAS u32x2*)(Z + (size_t)tl * ZP + ZC_GG + h * 128 + 16 * vt + 4 * g4);
    SB();
    f32x4 acc[8];
#pragma unroll
    for (int vt = 0; vt < 4; ++vt) { acc[vt] = (f32x4){0.f, 0.f, 0.f, 0.f};
#pragma unroll
        for (int ks = 0; ks < 2; ++ks) acc[vt] = __builtin_amdgcn_mfma_f32_16x16x32_bf16(hA[vt][ks], qf[ks], acc[vt], 0, 0, 0);
        acc[vt] = __builtin_amdgcn_mfma_f32_16x16x32_bf16(vA[vt][0], Pb[0], acc[vt], 0, 0, 0);
        if (mt >= 2) acc[vt] = __builtin_amdgcn_mfma_f32_16x16x32_bf16(vA[vt][1], Pb[1], acc[vt], 0, 0, 0); }
    SB();
#pragma unroll
    for (int vt = 0; vt < 4; ++vt) { acc[4 + vt] = (f32x4){0.f, 0.f, 0.f, 0.f};
#pragma unroll
        for (int ks = 0; ks < 2; ++ks) acc[4 + vt] = __builtin_amdgcn_mfma_f32_16x16x32_bf16(hB[vt][ks], qf[ks], acc[4 + vt], 0, 0, 0);
        acc[4 + vt] = __builtin_amdgcn_mfma_f32_16x16x32_bf16(vB[vt][0], Pb[0], acc[4 + vt], 0, 0, 0);
        if (mt >= 2) acc[4 + vt] = __builtin_amdgcn_mfma_f32_16x16x32_bf16(vB[vt][1], Pb[1], acc[4 + vt], 0, 0, 0); }
    SB();
    f32x4 ngv[8];
    { const float* ngp = a.in[31] + (size_t)l * GV + h * 128 + 4 * g4;
#pragma unroll
      for (int vt = 0; vt < 8; ++vt) ngv[vt] = *(const GAS f32x4*)(ngp + 16 * vt); }
    float ss = 0.f;
#pragma unroll
    for (int vt = 0; vt < 8; ++vt)
#pragma unroll
        for (int r = 0; r < 4; ++r) ss += acc[vt][r] * acc[vt][r];
    { int a16 = (lane ^ 16) << 2, a32 = (lane ^ 32) << 2; asm volatile("" : "+v"(a16), "+v"(a32));
      ss += __builtin_bit_cast(float, __builtin_amdgcn_ds_bpermute(a16, __builtin_bit_cast(int, ss)));
      ss += __builtin_bit_cast(float, __builtin_amdgcn_ds_bpermute(a32, __builtin_bit_cast(int, ss))); }
    const float rn = 1.f / sqrtf(ss * (1.f / 128.f) + NORM_EPS);
    SB();
#pragma unroll
    for (int vt = 0; vt < 8; ++vt) { const float g0 = bflo(gzr[vt].x), g1 = bfhi(gzr[vt].x), g2 = bflo(gzr[vt].y), g3 = bfhi(gzr[vt].y);
        const float y0 = acc[vt][0] * rn * ngv[vt][0] * g0 * sigmoidf_(g0), y1 = acc[vt][1] * rn * ngv[vt][1] * g1 * sigmoidf_(g1);
        const float y2 = acc[vt][2] * rn * ngv[vt][2] * g2 * sigmoidf_(g2), y3 = acc[vt][3] * rn * ngv[vt][3] * g3 * sigmoidf_(g3);
        u32x2 o; o.x = pk2(y0, y1); o.y = pk2(y2, y3);
        *(GAS u32x2*)(ycat + (size_t)tl * D + S5W + RW + h * 128 + 16 * vt + 4 * g4) = o; }
}
DI void gla_post_phase(const Frame& F, const CAS Args& a, int l) {
    constexpr int NIT = NCH * GH * 4;
    const int NGW = F.G * 8, rounds = NIT / NGW, rem = NIT - rounds * NGW, per = rem / F.G, left = rem - per * F.G;
    const int wv = __builtin_amdgcn_readfirstlane(F.wave);
    for (int r = 0; r < rounds; ++r) gla_post_item(F, a, l, r * NGW + F.bid * 8 + wv);
    if (wv < per) gla_post_item(F, a, l, rounds * NGW + F.bid * per + wv);
    else if (wv == per && F.bid < left) gla_post_item(F, a, l, rounds * NGW + F.G * per + F.bid);
}
constexpr size_t ALG_BYTES_C = (size_t)64 * 552 * 2;
constexpr size_t S5T_G = 0, S5T_K = 32768, S5T_F = 65536, S5T_L8 = 98304, S5T_LN = 98816, S5T_PN = 99328, S5T_SIZE = 99328 + 8192;
constexpr size_t WS_S5X = WS_S5XA;
static_assert(256 * ALG_BYTES_C <= SZ_HB && (size_t)DEPTH * 48 * S5T_SIZE <= 2 * SZ_HB && WS_S5TA >= WS_R4 + 3 * SZ_HB, "scratch overlays");
constexpr int S5_TW = 0, S5_X0 = 2 * 8 * 128 * 4, S5_END = S5_X0 + 2 * 128 * 4;
static_assert(S5_END <= MISC_OFF, "s5 LDS");

DI void s5_tables(const Frame& F, const CAS Args& a, int l, int g) {
    LAS float* PWr = (LAS float*)F.lds;
    LAS float* PWi = PWr + 9 * 64;
    LAS float* Bbr = PWi + 9 * 64;
    LAS float* Bbi = Bbr + 1024;
    LAS float* Cr = Bbi + 1024;
    LAS float* Ci = Cr + 1024;
    LAS float* Kt = Ci + 1024;
    unsigned char* tb = F.ws + WS_S5TA + ((size_t)l * S5G + g) * S5T_SIZE;
    if (F.tid < 64) { const int p = F.tid; const size_t gp = ((size_t)l * S5G + g) * S5P + p;
        const float lre = fminf(a.in[4][gp], -1e-4f), lim = a.in[5][gp], dt = expf(a.in[6][(size_t)l * S5G + g]);
        const float er = expf(lre * dt); float sn, cs; sincosf(lim * dt, &sn, &cs);
        const float lbr = er * cs, lbi = er * sn;
        const float nr = lbr - 1.f, ni = lbi, den = 1.f / (lre * lre + lim * lim);
        const float fr_ = (nr * lre + ni * lim) * den, fi_ = (ni * lre - nr * lim) * den;
#pragma unroll
        for (int jj = 0; jj < 16; ++jj) { const float br = a.in[7][gp * 16 + jj], bi = a.in[8][gp * 16 + jj]; Bbr[p * 16 + jj] = fr_ * br - fi_ * bi; Bbi[p * 16 + jj] = fr_ * bi + fi_ * br; }
        float pr = 1.f, pi = 0.f;
#pragma unroll
        for (int nn = 0; nn < 9; ++nn) { PWr[nn * 64 + p] = pr; PWi[nn * 64 + p] = pi; const float t0 = pr * lbr - pi * lbi, t1 = pr * lbi + pi * lbr; pr = t0; pi = t1; }
        float qr = PWr[8 * 64 + p], qi = PWi[8 * 64 + p];
        ((GAS float*)(tb + S5T_L8))[p] = qr; ((GAS float*)(tb + S5T_L8))[64 + p] = qi;
        { float ur = 1.f, ui = 0.f;
#pragma unroll
          for (int nn = 0; nn < 16; ++nn) { ((GAS float*)(tb + S5T_PN))[nn * 128 + p] = ur; ((GAS float*)(tb + S5T_PN))[nn * 128 + 64 + p] = ui; const float t0 = ur * qr - ui * qi, t1 = ur * qi + ui * qr; ur = t0; ui = t1; } }
#pragma unroll
        for (int s = 0; s < 7; ++s) { const float t0 = qr * qr - qi * qi, t1 = 2.f * qr * qi; qr = t0; qi = t1; }
        ((GAS float*)(tb + S5T_LN))[p] = qr; ((GAS float*)(tb + S5T_LN))[64 + p] = qi; }
    for (int q = F.tid; q < 1024; q += 512) { const int i = q >> 6, pp = q & 63; const size_t ci = (((size_t)l * S5G + g) * 16 + i) * S5P + pp; Cr[q] = a.in[9][ci]; Ci[q] = a.in[10][ci]; }
    __syncthreads();
    { const int tau = F.tid >> 6, i = (F.tid >> 2) & 15, j0 = (F.tid & 3) * 4; float s[4] = {0.f, 0.f, 0.f, 0.f};
      for (int p = 0; p < 64; ++p) { const float cr = Cr[i * 64 + p], ci = Ci[i * 64 + p], wr = PWr[tau * 64 + p], wi = PWi[tau * 64 + p];
          const float mr = cr * wr - ci * wi, mi = cr * wi + ci * wr;
#pragma unroll
          for (int e = 0; e < 4; ++e) s[e] += mr * Bbr[p * 16 + j0 + e] - mi * Bbi[p * 16 + j0 + e]; }
#pragma unroll
      for (int e = 0; e < 4; ++e) Kt[(tau * 16 + i) * 16 + j0 + e] = s[e]; }
    __syncthreads();
    { const int row = F.tid >> 2, c0 = (F.tid & 3) * 32;
#pragma unroll
      for (int q8 = 0; q8 < 4; ++q8) { float gv[8], kv[8], fv[8];
#pragma unroll
          for (int e = 0; e < 8; ++e) { const int col = c0 + 8 * q8 + e;
              { const int p = row & 63, part = row >> 6, b = col >> 4, j = col & 15; const float wr = PWr[(7 - b) * 64 + p], wi = PWi[(7 - b) * 64 + p], br = Bbr[p * 16 + j], bi = Bbi[p * 16 + j];
                gv[e] = part == 0 ? (wr * br - wi * bi) : (wr * bi + wi * br); }
              { const int bt = row >> 4, i = row & 15, bs = col >> 4, j = col & 15; kv[e] = (bs <= bt) ? Kt[((bt - bs) * 16 + i) * 16 + j] : 0.f; }
              { const int b = row >> 4, i = row & 15; const int pks = col >> 5, pkg = (col >> 3) & 3, pj = col & 7, pp = 16 * (2 * pks + (pj >> 2)) + 4 * pkg + (pj & 3);
                const int p = pp & 63, part = pp >> 6; const float cr = Cr[i * 64 + p], ci = Ci[i * 64 + p], wr = PWr[(b + 1) * 64 + p], wi = PWi[(b + 1) * 64 + p];
                fv[e] = part == 0 ? (cr * wr - ci * wi) : -(cr * wi + ci * wr); } }
          const int colb = c0 + 8 * q8; const size_t fo = ((size_t)(((row >> 4) * 4 + (colb >> 5)) * 64 + ((colb >> 3) & 3) * 16 + (row & 15))) * 16;
          *(GAS u32x4*)(tb + S5T_G + fo) = pack8(gv); *(GAS u32x4*)(tb + S5T_K + fo) = pack8(kv); *(GAS u32x4*)(tb + S5T_F + fo) = pack8(fv); } }
    __syncthreads();
}

#define LDU(T, ubase, loff) (*(const GAS T*)((const unsigned char*)(ubase) + (loff)))
#define DPPF(v, ctrl) __builtin_bit_cast(float, __builtin_amdgcn_update_dpp(0, __builtin_bit_cast(int, (v)), (ctrl), 0xF, 0xF, true))
template <int CTRL> DI f32x4 dpp4(const f32x4 v) { const float a0 = v[0], a1 = v[1], a2 = v[2], a3 = v[3]; const float b0 = DPPF(a0, CTRL), b1 = DPPF(a1, CTRL), b2 = DPPF(a2, CTRL), b3 = DPPF(a3, CTRL); return (f32x4){b0, b1, b2, b3}; }
template <int D>
DI void s5_scan_step(f32x4 (&Yr)[4], f32x4 (&Yi)[4], f32x4 (&Ar)[4], f32x4 (&Ai)[4]) {
#pragma unroll
    for (int m = 0; m < 4; ++m) {
        const f32x4 sr = dpp4<0x110 + D>(Yr[m]), si = dpp4<0x110 + D>(Yi[m]);
        Yr[m] += Ar[m] * sr - Ai[m] * si; Yi[m] += Ar[m] * si + Ai[m] * sr;
        const f32x4 a2r = Ar[m] * Ar[m] - Ai[m] * Ai[m], a2i = 2.f * Ar[m] * Ai[m]; Ar[m] = a2r; Ai[m] = a2i; }
}
template <bool POST>
DI void s5_phase(const Frame& F, const CAS Args& a, int l, int first, int stride) {
    const bf16* Z = (const bf16*)(F.ws + WS_R2);
    bf16* ypre = (bf16*)(F.ws + WS_R1 + (size_t)M * RW * 4);
    const int lane = F.lane, w = F.wave, n = lane & 15, kg = lane >> 4;
    int par = 0;
    for (int it = first; it < S5G * 16; it += stride, par ^= 1) {
        const int g = it >> 4, ib = it & 15;
        const unsigned char* tb = F.ws + WS_S5TA + ((size_t)l * S5G + g) * S5T_SIZE;
        float* TOT = (float*)(F.ws + WS_S5X) + (size_t)(g * 16) * 128;
        LAS float* const TW = (LAS float*)(F.lds + S5_TW) + par * 8 * 128;
        LAS float* const X0 = (LAS float*)(F.lds + S5_X0) + par * 128;
        const int sb = 128 * ib + 16 * w + n;
        const unsigned char* zb = F.ws + WS_ZS5 + ((size_t)g * M + 8 * (128 * ib + 16 * w)) * 32;
        unsigned lzu = (unsigned)((8 * n + (kg >> 1)) * 32 + (kg & 1) * 16);
        unsigned lzo = (unsigned)(8 * n * 32 + 8 * kg);
        unsigned ltab = (unsigned)lane * 16u;
        unsigned lyo = (unsigned)(8 * n * S5W + 4 * kg) * 2u;
        asm volatile("" : "+v"(lzu), "+v"(lzo), "+v"(ltab), "+v"(lyo));
        bf16x8 uf[4];
#pragma unroll
        for (int ks = 0; ks < 4; ++ks) uf[ks] = LDU(bf16x8, zb + 64 * ks, lzu);
        f32x4 Ar[4], Ai[4];
#pragma unroll
        for (int m = 0; m < 4; ++m) { Ar[m] = *(const GAS f32x4*)((const float*)(tb + S5T_L8) + 16 * m + 4 * kg); Ai[m] = *(const GAS f32x4*)((const float*)(tb + S5T_L8) + 64 + 16 * m + 4 * kg); }
        if (POST && w == 0) { const int p = lane; const float lnr = ((const GAS float*)(tb + S5T_LN))[p], lni = ((const GAS float*)(tb + S5T_LN))[64 + p];
            float xr = 0.f, xi = 0.f;
            for (int q0 = 0; q0 < ib; q0 += 4) { float tr[4], ti[4];
#pragma unroll
                for (int u = 0; u < 4; ++u) { const int q = (q0 + u < ib) ? q0 + u : q0; tr[u] = TOT[q * 128 + p]; ti[u] = TOT[q * 128 + 64 + p]; }
                SB();
#pragma unroll
                for (int u = 0; u < 4; ++u) if (q0 + u < ib) { const float t0 = lnr * xr - lni * xi + tr[u], t1 = lnr * xi + lni * xr + ti[u]; xr = t0; xi = t1; }
                SB(); }
            X0[p] = xr; X0[64 + p] = xi; }
        SB();
        f32x4 Yr[4], Yi[4];
        { bf16x8 gf[2][4];
#pragma unroll
          for (int ks = 0; ks < 4; ++ks) gf[0][ks] = LDU(bf16x8, tb + S5T_G + (0 * 4 + ks) * 1024, ltab);
#pragma unroll
          for (int mt = 0; mt < 8; ++mt) {
              if (mt + 1 < 8) {
#pragma unroll
                  for (int ks = 0; ks < 4; ++ks) gf[(mt + 1) & 1][ks] = LDU(bf16x8, tb + S5T_G + ((mt + 1) * 4 + ks) * 1024, ltab); }
              SB();
              f32x4 acc = {0.f, 0.f, 0.f, 0.f};
#pragma unroll
              for (int ks = 0; ks < 4; ++ks) acc = __builtin_amdgcn_mfma_f32_16x16x32_bf16(gf[mt & 1][ks], uf[ks], acc, 0, 0, 0);
              if (mt < 4) Yr[mt] = acc; else Yi[mt - 4] = acc;
              SB(); } }
        SB();
        s5_scan_step<1>(Yr, Yi, Ar, Ai); SB(); s5_scan_step<2>(Yr, Yi, Ar, Ai); SB(); s5_scan_step<4>(Yr, Yi, Ar, Ai); SB(); s5_scan_step<8>(Yr, Yi, Ar, Ai); SB();
        if (n == 15) {
#pragma unroll
            for (int m = 0; m < 4; ++m) { *(LAS f32x4*)(TW + w * 128 + 16 * m + 4 * kg) = Yr[m]; *(LAS f32x4*)(TW + w * 128 + 64 + 16 * m + 4 * kg) = Yi[m]; } }
        __syncthreads();
        f32x4 Sr[4], Si[4];
#pragma unroll
        for (int m = 0; m < 4; ++m) { Sr[m] = POST ? *(const LAS f32x4*)(X0 + 16 * m + 4 * kg) : (f32x4){0.f, 0.f, 0.f, 0.f}; Si[m] = POST ? *(const LAS f32x4*)(X0 + 64 + 16 * m + 4 * kg) : (f32x4){0.f, 0.f, 0.f, 0.f}; }
        const int nprev = POST ? w : 8;
        for (int q = 0; q < nprev; ++q) {
#pragma unroll
            for (int m = 0; m < 4; ++m) { const f32x4 tr = *(const LAS f32x4*)(TW + q * 128 + 16 * m + 4 * kg), ti = *(const LAS f32x4*)(TW + q * 128 + 64 + 16 * m + 4 * kg);
                const f32x4 nr = Ar[m] * Sr[m] - Ai[m] * Si[m] + tr, ni = Ar[m] * Si[m] + Ai[m] * Sr[m] + ti; Sr[m] = nr; Si[m] = ni; } }
        if (!POST) { if (w == 0 && n == 0) {
#pragma unroll
                for (int m = 0; m < 4; ++m) { *(GAS f32x4*)(TOT + ib * 128 + 16 * m + 4 * kg) = Sr[m]; *(GAS f32x4*)(TOT + ib * 128 + 64 + 16 * m + 4 * kg) = Si[m]; } } }
        if (POST) {
            f32x4 Xr[4], Xi[4], Pr[4], Pi[4];
#pragma unroll
            for (int m = 0; m < 4; ++m) { Pr[m] = *(const GAS f32x4*)((const float*)(tb + S5T_PN) + n * 128 + 16 * m + 4 * kg); Pi[m] = *(const GAS f32x4*)((const float*)(tb + S5T_PN) + n * 128 + 64 + 16 * m + 4 * kg); }
            SB();
#pragma unroll
            for (int m = 0; m < 4; ++m) { const f32x4 yr = dpp4<0x111>(Yr[m]), yi = dpp4<0x111>(Yi[m]); Xr[m] = Pr[m] * Sr[m] - Pi[m] * Si[m] + yr; Xi[m] = Pr[m] * Si[m] + Pi[m] * Sr[m] + yi; }
            bf16x8 xf[4]; xf[0] = pack_pi(Xr[0], Xr[1]); xf[1] = pack_pi(Xr[2], Xr[3]); xf[2] = pack_pi(Xi[0], Xi[1]); xf[3] = pack_pi(Xi[2], Xi[3]);
            SB();
            u32x2 uu[8]; bf16x8 uf2[4];
#pragma unroll
            for (int ks = 0; ks < 4; ++ks) uf2[ks] = LDU(bf16x8, zb + 64 * ks, lzu);
            const f32x4 dv = *(const GAS f32x4*)(a.in[11] + (size_t)l * S5W + 16 * g + 4 * kg);
#pragma unroll
            for (int mt = 0; mt < 8; ++mt) uu[mt] = LDU(u32x2, zb + 32 * mt, lzo);
            { bf16x8 kf[2][4], ff[2][4];
#pragma unroll
              for (int ks = 0; ks < 4; ++ks) { if (2 * ks <= 0) kf[0][ks] = LDU(bf16x8, tb + S5T_K + (0 * 4 + ks) * 1024, ltab); ff[0][ks] = LDU(bf16x8, tb + S5T_F + (0 * 4 + ks) * 1024, ltab); }
#pragma unroll
              for (int mt = 0; mt < 8; ++mt) {
                  if (mt + 1 < 8) {
#pragma unroll
                      for (int ks = 0; ks < 4; ++ks) { if (2 * ks <= mt + 1) kf[(mt + 1) & 1][ks] = LDU(bf16x8, tb + S5T_K + ((mt + 1) * 4 + ks) * 1024, ltab);
                          ff[(mt + 1) & 1][ks] = LDU(bf16x8, tb + S5T_F + ((mt + 1) * 4 + ks) * 1024, ltab); } }
                  SB();
                  f32x4 acc = {0.f, 0.f, 0.f, 0.f};
#pragma unroll
                  for (int ks = 0; ks < 4; ++ks) { if (2 * ks <= mt) acc = __builtin_amdgcn_mfma_f32_16x16x32_bf16(kf[mt & 1][ks], uf2[ks], acc, 0, 0, 0); }
#pragma unroll
                  for (int ks = 0; ks < 4; ++ks) acc = __builtin_amdgcn_mfma_f32_16x16x32_bf16(ff[mt & 1][ks], xf[ks], acc, 0, 0, 0);
                  const float y0 = acc[0] + dv[0] * bflo(uu[mt].x), y1 = acc[1] + dv[1] * bfhi(uu[mt].x), y2 = acc[2] + dv[2] * bflo(uu[mt].y), y3 = acc[3] + dv[3] * bfhi(uu[mt].y);
                  u32x2 o; o.x = pk2(gelu_tanh(y0), gelu_tanh(y1)); o.y = pk2(gelu_tanh(y2), gelu_tanh(y3));
                  *(GAS u32x2*)((unsigned char*)(ypre + (size_t)(8 * (128 * ib + 16 * w) + mt) * S5W + 16 * g) + lyo) = o;
                  SB(); } }
        }
    }
}
constexpr int NPH = 12, NSTEPS = 1 + DEPTH * NPH + 1;
#ifndef MK_PER_STEP
#define MK_PER_STEP 0
#endif
__global__ void __launch_bounds__(512, 2) trunk_fwd(Args args_unused) {
    extern __shared__ __attribute__((aligned(16))) unsigned char lds_raw[];
    LAS unsigned char* const lds = (LAS unsigned char*)lds_raw;
    volatile LAS unsigned* MISC = (volatile LAS unsigned*)(lds + MISC_OFF);
    for (int u = threadIdx.x; u < 128; u += 512) MISC[u] = 0u;
    int wv = __builtin_amdgcn_readfirstlane(threadIdx.x >> 6); asm volatile("" : "+s"(wv));
    __syncthreads();
    const CAS Args* ap0 = (const CAS Args*)__builtin_amdgcn_kernarg_segment_ptr();
    const int lo = ap0->lo, hi = ap0->hi;
    XcdBarrier bar; bar.bar = (unsigned*)(ap0->ws + WS_CTL) + CW_BAR; bar.x = 0; bar.st = MISC + 8; bar.w0 = (wv == 0);
    if ((hi - lo) > 1) bar = xcd_barrier_post(bar.bar, MISC + 8, wv == 0);
#ifndef ONLY_PH
#define ONLY_PH 0xFFFF
#endif
#define PHEN(ph) ((ONLY_PH >> (ph)) & 1)
#define IN(k) (lo <= (k) && (k) < hi)
#define SEAM(k) do { if (IN((k) + 1) && IN(k)) xcd_barrier(bar); } while (0)
#define FRAME() const CAS Args* ap; const Frame F = make_frame(lds, ap, wv); const CAS Args& A = *ap; (void)A
#ifndef REPEAT_MASK
#define REPEAT_MASK 0
#endif
#define REP(ph) ((REPEAT_MASK >> (ph)) & 1)
#ifndef REP2_MASK
#define REP2_MASK 0
#endif
#define REP2(k) ((REP2_MASK >> (k)) & 1)

    if (PHEN(12) && IN(0)) { { FRAME(); float* prm = (float*)(F.ws + WS_PRM);
            for (int e = F.bid * 512 + F.tid; e < DEPTH * RH * 576; e += F.G * 512) { const int i = e & 63, pi = (e >> 6) % 9, lh = e / 576, hh = lh % RH, ll = lh / RH; float val;
                if (pi < 3) val = A.in[14][(size_t)ll * RWCOLS + (pi == 0 ? ZC_R : (pi == 1 ? ZC_K : ZC_V)) - ZC_R + hh * 64 + i];
                else if (pi == 3) val = A.in[16][(size_t)ll * RW + hh * 64 + i]; else if (pi == 4) val = A.in[18][(size_t)ll * RW + hh * 64 + i]; else if (pi == 5) val = A.in[20][(size_t)ll * RW + hh * 64 + i];
                else if (pi == 6) val = A.in[21][(size_t)ll * RW + hh * 64 + i]; else if (pi == 7) val = A.in[22][(size_t)ll * RW + hh * 64 + i];
                else val = (ll > 0) ? A.in[28][(size_t)(ll - 1) * RW + hh * 64 + i] : 0.f;
                prm[e] = val; } }
        { FRAME(); p0_prologue(F, A); __syncthreads(); } { FRAME(); for (int it = F.bid; it < DEPTH * S5G; it += F.G) s5_tables(F, A, it / S5G, it % S5G); } SEAM(0); }

    for (int l = 0; l < DEPTH; ++l) {
        const int s0 = 1 + l * NPH;
        if (REP(0) && PHEN(0) && IN(s0 + 0)) { if (l == 0) { FRAME(); x0_phase(F, A.in[0], (bf16*)F.out, (float*)(F.ws + WS_SSQ)); xcd_barrier(bar); } }
        if (PHEN(0) && IN(s0 + 0)) { if (l == 0) { FRAME(); x0_phase(F, A.in[0], (bf16*)F.out, (float*)(F.ws + WS_SSQ)); SEAM(s0 + 0); } }
        if (REP(1) && PHEN(1) && IN(s0 + 1)) { FRAME();
            const int nN = (l == 0) ? 44 : 45;
            const LAS float* rs = rstd_table(F);
            SchedPlain S; S.init((const bf16*)F.out, XP, (const bf16*)lw(F, l, LW_WIN), D, M / BM, nN, D, F.G, F.bid);
            EpiInproj E{(bf16*)(F.ws + WS_R2), A.in[3] + (size_t)l * 6144, (bf16*)(F.ws + WS_ZS5), rs};
            gemm_phase<EpiInproj, SchedPlain>(F.lds, F.wave, XP, D, S, E);
            xcd_barrier(bar);
        }
        if (PHEN(1) && IN(s0 + 1)) { FRAME();
            const int nN = (l == 0) ? 44 : 45;
            const LAS float* rs = rstd_table(F);
            SchedPlain S; S.init((const bf16*)F.out, XP, (const bf16*)lw(F, l, LW_WIN), D, M / BM, nN, D, F.G, F.bid);
            EpiInproj E{(bf16*)(F.ws + WS_R2), A.in[3] + (size_t)l * 6144, (bf16*)(F.ws + WS_ZS5), rs};
            gemm_phase<EpiInproj, SchedPlain>(F.lds, F.wave, XP, D, S, E);
            SEAM(s0 + 1);
        }
        if (REP(2) && PHEN(2) && IN(s0 + 2)) { FRAME(); rwkv_fused_phase(F, A, l); gla_pre_phase(F, A, l); s5_phase<false>(F, A, l, F.bid, F.G); xcd_barrier(bar); }
        if (PHEN(2) && IN(s0 + 2)) { FRAME(); if (REP2(0)) rwkv_fused_phase(F, A, l); rwkv_fused_phase(F, A, l); if (REP2(1)) gla_pre_phase(F, A, l); gla_pre_phase(F, A, l); if (REP2(2)) s5_phase<false>(F, A, l, F.bid, F.G); s5_phase<false>(F, A, l, F.bid, F.G); SEAM(s0 + 2); }
        if (REP(4) && PHEN(4) && IN(s0 + 4)) { FRAME();
            if (F.bid < 40) rwkv_scan_phase(F, F.bid >> 2, F.bid & 3);
            else if (F.bid < 60) gla_scan_wave(F, (F.bid - 40) * 8 + F.wave);
            else s5_phase<true>(F, A, l, F.bid - 60, F.G - 60);
            xcd_barrier(bar);
        }
        if (PHEN(4) && IN(s0 + 4)) { FRAME();
            if (F.bid < 40) { if (REP2(3)) rwkv_scan_phase(F, F.bid >> 2, F.bid & 3); rwkv_scan_phase(F, F.bid >> 2, F.bid & 3); }
            else if (F.bid < 60) { if (REP2(4)) gla_scan_wave(F, (F.bid - 40) * 8 + F.wave); gla_scan_wave(F, (F.bid - 40) * 8 + F.wave); }
            else { if (REP2(5)) s5_phase<true>(F, A, l, F.bid - 60, F.G - 60); s5_phase<true>(F, A, l, F.bid - 60, F.G - 60); }
            SEAM(s0 + 4);
        }
        if (REP(5) && PHEN(5) && IN(s0 + 5)) { FRAME(); gla_post_phase(F, A, l); rwkv_post_phase(F, A, l); xcd_barrier(bar); }
        if (PHEN(5) && IN(s0 + 5)) { FRAME(); if (REP2(7)) gla_post_phase(F, A, l); gla_post_phase(F, A, l); if (REP2(6)) rwkv_post_phase(F, A, l); rwkv_post_phase(F, A, l); SEAM(s0 + 5); }
        if (REP(6) && PHEN(6) && IN(s0 + 6)) { FRAME();
            const bf16* ypre = (const bf16*)(F.ws + WS_R1 + (size_t)M * RW * 4);
            SchedPlain S; S.init(ypre, S5W, (const bf16*)lw(F, l, LW_GLU), S5W, M / BM, 3, S5W, F.G, F.bid);
            EpiGlu E{ypre, (bf16*)(F.ws + WS_R3), A.in[13] + (size_t)l * S5W};
            gemm_phase<EpiGlu, SchedPlain>(F.lds, F.wave, S5W, S5W, S, E);
            xcd_barrier(bar);
        }
        if (PHEN(6) && IN(s0 + 6)) { FRAME();
            const bf16* ypre = (const bf16*)(F.ws + WS_R1 + (size_t)M * RW * 4);
            SchedPlain S; S.init(ypre, S5W, (const bf16*)lw(F, l, LW_GLU), S5W, M / BM, 3, S5W, F.G, F.bid);
            EpiGlu E{ypre, (bf16*)(F.ws + WS_R3), A.in[13] + (size_t)l * S5W};
            gemm_phase<EpiGlu, SchedPlain>(F.lds, F.wave, S5W, S5W, S, E);
            SEAM(s0 + 6);
        }
        if (REP(7) && PHEN(7) && IN(s0 + 7)) { FRAME();
            SchedSeg3 S; S.init((const bf16*)(F.ws + WS_R3), D, (const bf16*)lw(F, l, LW_WUP), D, M / BM, D / BM, F.G, F.bid);
            EpiMerged E{(const bf16*)(F.ws + WS_R2), (bf16*)(F.ws + WS_R1)};
            gemm_phase<EpiMerged, SchedSeg3>(F.lds, F.wave, D, D, S, E);
            xcd_barrier(bar);
        }
        if (PHEN(7) && IN(s0 + 7)) { FRAME();
            SchedSeg3 S; S.init((const bf16*)(F.ws + WS_R3), D, (const bf16*)lw(F, l, LW_WUP), D, M / BM, D / BM, F.G, F.bid);
            EpiMerged E{(const bf16*)(F.ws + WS_R2), (bf16*)(F.ws + WS_R1)};
            gemm_phase<EpiMerged, SchedSeg3>(F.lds, F.wave, D, D, S, E);
            SEAM(s0 + 7);
        }
        if (REP(8) && PHEN(8) && IN(s0 + 8)) { FRAME();
            SchedPlain S; S.init((const bf16*)(F.ws + WS_R1), D, (const bf16*)lw(F, l, LW_WOUT), D, M / BM, D / BM, D, F.G, F.bid);
            EpiResid E{(const bf16*)F.out, (bf16*)F.out, (float*)(F.ws + WS_SSQ)};
            gemm_phase<EpiResid, SchedPlain>(F.lds, F.wave, D, D, S, E);
            xcd_barrier(bar);
        }
        if (PHEN(8) && IN(s0 + 8)) { FRAME();
            SchedPlain S; S.init((const bf16*)(F.ws + WS_R1), D, (const bf16*)lw(F, l, LW_WOUT), D, M / BM, D / BM, D, F.G, F.bid);
            EpiResid E{(const bf16*)F.out, (bf16*)F.out, (float*)(F.ws + WS_SSQ)};
            gemm_phase<EpiResid, SchedPlain>(F.lds, F.wave, D, D, S, E);
            SEAM(s0 + 8);
        }
        if (REP(10) && PHEN(10) && IN(s0 + 10)) { FRAME();
            const LAS float* rs = rstd_table(F);
            SchedPlain S; S.init((const bf16*)F.out, XP, (const bf16*)lw(F, l, LW_W1), D, M / BM, DFF / BM, D, F.G, F.bid);
            EpiRelu2 E{(bf16*)(F.ws + WS_R2), rs};
            gemm_phase<EpiRelu2, SchedPlain>(F.lds, F.wave, XP, D, S, E);
            xcd_barrier(bar);
        }
        if (PHEN(10) && IN(s0 + 10)) { FRAME();
            const LAS float* rs = rstd_table(F);
            SchedPlain S; S.init((const bf16*)F.out, XP, (const bf16*)lw(F, l, LW_W1), D, M / BM, DFF / BM, D, F.G, F.bid);
            EpiRelu2 E{(bf16*)(F.ws + WS_R2), rs};
            gemm_phase<EpiRelu2, SchedPlain>(F.lds, F.wave, XP, D, S, E);
            SEAM(s0 + 10);
        }
        if (REP(11) && PHEN(11) && IN(s0 + 11)) { FRAME();
            SchedPlain S; S.init((const bf16*)(F.ws + WS_R2), DFF, (const bf16*)lw(F, l, LW_W2), DFF, M / BM, D / BM, DFF, F.G, F.bid);
            EpiResid E{(const bf16*)F.out, (l == DEPTH - 1) ? (bf16*)(F.ws + WS_R1) : (bf16*)F.out, (float*)(F.ws + WS_SSQ)};
            gemm_phase<EpiResid, SchedPlain>(F.lds, F.wave, DFF, DFF, S, E);
            xcd_barrier(bar);
        }
        if (PHEN(11) && IN(s0 + 11)) { FRAME();
            SchedPlain S; S.init((const bf16*)(F.ws + WS_R2), DFF, (const bf16*)lw(F, l, LW_W2), DFF, M / BM, D / BM, DFF, F.G, F.bid);
            EpiResid E{(const bf16*)F.out, (l == DEPTH - 1) ? (bf16*)(F.ws + WS_R1) : (bf16*)F.out, (float*)(F.ws + WS_SSQ)};
            gemm_phase<EpiResid, SchedPlain>(F.lds, F.wave, DFF, DFF, S, E);
            SEAM(s0 + 11);
        }
    }
    if (PHEN(13) && IN(NSTEPS - 1)) { FRAME(); rmsnorm_phase<true, true>(F, F.ws + WS_R1, A.in[37], F.out); }
#undef IN
#undef SEAM
}

extern "C" void kernel_launch(void* const* d_in, const int* in_sizes, int n_in, void* d_out, int out_size, void* d_ws, size_t ws_size, hipStream_t stream) {
    static int grid = 0;
    if (grid == 0) {
        if (n_in != 38 || out_size != M * D || ws_size < WS_END) { fprintf(stderr, "kernel_launch: unexpected shapes (n_in %d, out %d, ws %zu < %zu)\n", n_in, out_size, ws_size, (size_t)WS_END); grid = -1; return; }
        int dev = 0, cus = 0, per_cu = 0;
        if (hipGetDevice(&dev) != hipSuccess || hipDeviceGetAttribute(&cus, hipDeviceAttributeMultiprocessorCount, dev) != hipSuccess) { grid = -1; return; }
        if (hipFuncSetAttribute((const void*)trunk_fwd, hipFuncAttributeMaxDynamicSharedMemorySize, LDS_BYTES) != hipSuccess) { fprintf(stderr, "kernel_launch: hipFuncSetAttribute failed\n"); grid = -1; return; }
        if (hipOccupancyMaxActiveBlocksPerMultiprocessor(&per_cu, (const void*)trunk_fwd, 512, LDS_BYTES) != hipSuccess || per_cu < 1) { fprintf(stderr, "kernel_launch: occupancy query says %d\n", per_cu); }
        (void)hipGetLastError();
        grid = (cus / 8) * 8;
        if (grid < 64) { fprintf(stderr, "kernel_launch: %d CUs\n", cus); grid = -1; return; }
    }
    if (grid < 0) return;
    if (hipMemsetAsync((char*)d_ws + WS_CTL, 0, CTL_ZERO_BYTES, stream) != hipSuccess) return;
    Args a{};
    for (int i = 0; i < 38; ++i) a.in[i] = (const float*)d_in[i];
    a.out = (float*)d_out; a.ws = (unsigned char*)d_ws;
#if MK_PER_STEP
    for (int s = 0; s < NSTEPS; ++s) { a.lo = s; a.hi = s + 1; hipLaunchKernelGGL(trunk_fwd, dim3(grid), dim3(512), LDS_BYTES, stream, a); }
#else
    a.lo = 0; a.hi = NSTEPS;
    hipLaunchKernelGGL(trunk_fwd, dim3(grid), dim3(512), LDS_BYTES, stream, a);
#endif
}
```

```cpp
#include <hip/hip_runtime.h>
#include <cstdio>
#include <cstdint>

#define GAS __attribute__((address_space(1)))
#define LAS __attribute__((address_space(3)))
typedef unsigned short bf16;
typedef short bf16x8 __attribute__((ext_vector_type(8)));
typedef float f32x4 __attribute__((ext_vector_type(4)));
typedef float f32x2 __attribute__((ext_vector_type(2)));
typedef unsigned u32x4 __attribute__((ext_vector_type(4)));
typedef unsigned u32x2 __attribute__((ext_vector_type(2)));
typedef __bf16 bf16x2_t __attribute__((ext_vector_type(2)));
#define DI __device__ __forceinline__

constexpr int M = 16384, D = 2048, DEPTH = 4, DFF = 8192;
constexpr int S5W = 768, S5G = 48, S5P = 64;
constexpr int RW = 640, RH = 10, RN = 64, RWCOLS = 2400;
constexpr int GV = 640, GH = 5, GK = 320, GDK = 64, GDV = 128;
constexpr int INCOLS = 11248, ZP = 11520;
constexpr int ZC_R = 768, ZC_K = 1408, ZC_V = 2048, ZC_WIN = 2688, ZC_AIN = 2784, ZC_GIN = 2912;
constexpr int ZC_GQ = 3168, ZC_GKK = 3488, ZC_GV = 3808, ZC_GG = 4448, ZC_GA = 5088, ZC_GATE = 5104, ZC_VRES = 11248;
constexpr float NORM_EPS = 1e-6f;

DI unsigned pk2(float lo, float hi) { f32x2 v = {lo, hi}; bf16x2_t r = __builtin_convertvector(v, bf16x2_t); return __builtin_bit_cast(unsigned, r); }
DI float bflo(unsigned u) { return __builtin_bit_cast(float, u << 16); }
DI float bfhi(unsigned u) { return __builtin_bit_cast(float, u & 0xffff0000u); }
DI float bf2f(bf16 b) { return __builtin_bit_cast(float, ((unsigned)b) << 16); }
DI void unpack8(const u32x4 v, float (&f)[8]) { f[0] = bflo(v.x); f[1] = bfhi(v.x); f[2] = bflo(v.y); f[3] = bfhi(v.y); f[4] = bflo(v.z); f[5] = bfhi(v.z); f[6] = bflo(v.w); f[7] = bfhi(v.w); }
DI u32x4 pack8(const float (&f)[8]) { u32x4 o; o.x = pk2(f[0], f[1]); o.y = pk2(f[2], f[3]); o.z = pk2(f[4], f[5]); o.w = pk2(f[6], f[7]); return o; }
DI float sigmoidf_(float x) { return __builtin_amdgcn_rcpf(1.f + __expf(-x)); }
DI float softplusf_(float x) { return fmaxf(x, 0.f) + __logf(1.f + __expf(-fabsf(x))); }
DI float wave_sum(float v) {
    v += __builtin_bit_cast(float, __builtin_amdgcn_update_dpp(0, __builtin_bit_cast(int, v), 0xB1, 0xF, 0xF, true));
    v += __builtin_bit_cast(float, __builtin_amdgcn_update_dpp(0, __builtin_bit_cast(int, v), 0x4E, 0xF, 0xF, true));
    v += __builtin_bit_cast(float, __builtin_amdgcn_update_dpp(0, __builtin_bit_cast(int, v), 0x141, 0xF, 0xF, true));
    v += __builtin_bit_cast(float, __builtin_amdgcn_update_dpp(0, __builtin_bit_cast(int, v), 0x140, 0xF, 0xF, true));
    const int iv = __builtin_bit_cast(int, v);
    const float a0 = __builtin_bit_cast(float, __builtin_amdgcn_readlane(iv, 0)), a1 = __builtin_bit_cast(float, __builtin_amdgcn_readlane(iv, 16)),
                a2 = __builtin_bit_cast(float, __builtin_amdgcn_readlane(iv, 32)), a3 = __builtin_bit_cast(float, __builtin_amdgcn_readlane(iv, 48));
    return (a0 + a1) + (a2 + a3);
}
DI float sum8(float v) { v += __builtin_bit_cast(float, __builtin_amdgcn_update_dpp(0, __builtin_bit_cast(int, v), 0xB1, 0xF, 0xF, true));
                         v += __builtin_bit_cast(float, __builtin_amdgcn_update_dpp(0, __builtin_bit_cast(int, v), 0x4E, 0xF, 0xF, true));
                         v += __builtin_bit_cast(float, __builtin_amdgcn_update_dpp(0, __builtin_bit_cast(int, v), 0x141, 0xF, 0xF, true)); return v; }
#define LDS_WAIT() asm volatile("s_waitcnt lgkmcnt(0)" ::: "memory")
#define VM_WAIT() asm volatile("s_waitcnt vmcnt(0)" ::: "memory")

DI int lane_id_fresh() { int l; asm volatile("v_mbcnt_lo_u32_b32 %0, -1, 0\n\tv_mbcnt_hi_u32_b32 %0, -1, %0" : "=v"(l)); return l; }
#define XB_TMO      128
#define XB_XCNT(j)  (256  + 64 * (j))
#define XB_XSUB(j)  (1280 + 64 * (j))
#define XB_XGEN(j)  (2304 + 64 * (j))
#define XB_TOP      3328
#define XB_TOPGEN   3392
#define XCD_BAR_WORDS 3456
#define XB_SPIN_CAP (1u << 20)
__device__ __forceinline__ unsigned xb_ld(unsigned* p)              { return __hip_atomic_load(p, __ATOMIC_RELAXED, __HIP_MEMORY_SCOPE_AGENT); }
__device__ __forceinline__ unsigned xb_add(unsigned* p, unsigned v) { return __hip_atomic_fetch_add(p, v, __ATOMIC_RELAXED, __HIP_MEMORY_SCOPE_AGENT); }
__device__ __forceinline__ unsigned xb_xcc_id() { return (unsigned)__builtin_amdgcn_s_getreg((3 << 11) | 20) & 0xFu; }
#define XB_SPIN(cond, bar) do { unsigned _sp = 0; while (cond) { __builtin_amdgcn_s_sleep(1); \
    if ((++_sp & 255u) == 0u) { if (xb_ld(&(bar)[XB_TMO])) break; if (_sp > XB_SPIN_CAP) { atomicAdd(&(bar)[XB_TMO], 1u); break; } } } } while (0)
struct XcdBarrier { unsigned* bar; unsigned x; volatile LAS unsigned* st; unsigned w0; };
__device__ __forceinline__ XcdBarrier xcd_barrier_post(unsigned* bar, volatile LAS unsigned* st, unsigned w0) {
    XcdBarrier b; b.bar = bar; b.x = xb_xcc_id(); b.st = st; b.w0 = w0;
    if (w0 && lane_id_fresh() == 0) (void)xb_add(&bar[XB_XCNT(b.x)], 1u);
    return b;
}
__device__ __forceinline__ void xcd_barrier_complete(unsigned* bar, unsigned x, unsigned& nloc, unsigned& nx) {
    const unsigned G = gridDim.x * gridDim.y * gridDim.z;
    unsigned sum, cnt, mine, sp = 0u;
    for (;;) {
        sum = 0u; cnt = 0u; mine = 0u;
#pragma unroll
        for (unsigned j = 0; j < 16; ++j) { const unsigned c = xb_ld(&bar[XB_XCNT(j)]); sum += c; cnt += (c > 0u) ? 1u : 0u; mine = (j == x) ? c : mine; }
        if (sum == G) break;
        __builtin_amdgcn_s_sleep(1);
        if ((++sp & 255u) == 0u) { if (xb_ld(&bar[XB_TMO])) break; if (sp > XB_SPIN_CAP) { atomicAdd(&bar[XB_TMO], 1u); break; } }
    }
    nloc = mine > 0u ? mine : 1u; nx = cnt > 0u ? cnt : 1u;
}
__device__ __forceinline__ void xcd_barrier(const XcdBarrier& b) {
    asm volatile("s_waitcnt vmcnt(0)" ::: "memory");
    __syncthreads();
    if (b.w0 && lane_id_fresh() == 0) {
        unsigned* bar = b.bar;
        __builtin_amdgcn_s_waitcnt(0);
        unsigned nloc = b.st[0], nx = b.st[1];
        if (nloc == 0u) { xcd_barrier_complete(bar, b.x, nloc, nx); b.st[0] = nloc; b.st[1] = nx; }
        const unsigned old = xb_add(&bar[XB_XSUB(b.x)], 1u);
        const unsigned gen = old / nloc;
        if (old + 1u == (gen + 1u) * nloc) {
            __builtin_amdgcn_fence(__ATOMIC_RELEASE, "agent");
            asm volatile("s_waitcnt vmcnt(0)" ::: "memory");
            const unsigned og = xb_add(&bar[XB_TOP], 1u);
            const unsigned tg = og / nx;
            if (og + 1u == (tg + 1u) * nx) xb_add(&bar[XB_TOPGEN], 1u);
            else XB_SPIN(xb_ld(&bar[XB_TOPGEN]) == tg, bar);
            __builtin_amdgcn_fence(__ATOMIC_ACQUIRE, "agent");
            xb_add(&bar[XB_XGEN(b.x)], 1u);
            asm volatile("s_waitcnt vmcnt(0)" ::: "memory");
        } else {
            XB_SPIN(xb_ld(&bar[XB_XGEN(b.x)]) == gen, bar);
            __builtin_amdgcn_fence(__ATOMIC_ACQUIRE, "agent");
            asm volatile("s_waitcnt vmcnt(0)" ::: "memory");
        }
    }
    __syncthreads();
}
constexpr int BM = 256, BK = 64, HALF = 128, HTB = HALF * BK * 2, STAGE_BYTES = 8 * HTB;
DI int lds_byte(int r, int c) { const int st = (r >> 4) * 2 + (c >> 5), rr = r & 15, cc = c & 31, ob = rr * 64 + cc * 2; return st * 1024 + (ob ^ (((ob >> 9) & 1) << 5)); }
DI void stage_rc(int b, int& R, int& C) { const int st = b / 1024, sb = b % 1024, swz = sb ^ (((sb >> 9) & 1) << 5); R = (st >> 1) * 16 + swz / 64; C = (st & 1) * 32 + (swz % 64) / 2; }
DI int perm32(int rho) { const int n = rho >> 4, i = rho & 15; return 8 * (i >> 2) + 4 * n + (i & 3); }
struct Unit { int pm, pn, seg; };
struct TileOrder {
    int nM, nN, nwg;
    DI void init(int nM_, int nN_) { nM = nM_; nN = nN_; nwg = nM_ * nN_; }
    DI void map(int L, int& pm, int& pn) const {
        int wgid = L; { const int q = nwg / 8, r = nwg % 8, xcd = wgid % 8, off = wgid / 8; wgid = (xcd < r ? xcd * (q + 1) : r * (q + 1) + (xcd - r) * q) + off; }
        const int nig = 8 * nN, gid = wgid / nig, fm = gid * 8, gsz = (nM - fm) < 8 ? (nM - fm) : 8;
        pm = fm + ((wgid % nig) % gsz); pn = (wgid % nig) / gsz;
    }
};
struct SchedPlain {
    TileOrder T; int G, c, nt; const char* A; const char* B; size_t ta, tb;
    DI void init(const bf16* A_, int lda, const bf16* B_, int ldb, int nM, int nN, int K, int G_, int c_) { T.init(nM, nN); G = G_; c = c_; nt = K / BK; A = (const char*)A_; B = (const char*)B_; ta = (size_t)BM * lda * 2; tb = (size_t)BM * ldb * 2; }
    DI bool next(int i, Unit& u) const { const long L = (long)i * G + c; if (L >= T.nwg) return false; T.map((int)L, u.pm, u.pn); u.seg = 0; return true; }
    DI const char* aptr(const Unit& u) const { return A + (size_t)u.pm * ta; }
    DI const char* bptr(const Unit& u) const { return B + (size_t)u.pn * tb; }
    DI int ntiles(const Unit&) const { return nt; }
};
struct SchedSeg3 {
    TileOrder T; int G, c; const char* A; const char* B; size_t ta, tb;
    DI void init(const bf16* A_, int lda, const bf16* B_, int ldb, int nM, int nN, int G_, int c_) { T.init(nM, nN); G = G_; c = c_; A = (const char*)A_; B = (const char*)B_; ta = (size_t)BM * lda * 2; tb = (size_t)BM * ldb * 2; }
    DI bool next(int i, Unit& u) const { const int ti = i / 3; const long L = (long)ti * G + c; if (L >= T.nwg) return false; T.map((int)L, u.pm, u.pn); u.seg = i - 3 * ti; return true; }
    DI int kofs(int seg) const { return seg == 0 ? 0 : (seg == 1 ? 768 : 1408); }
    DI const char* aptr(const Unit& u) const { return A + (size_t)u.pm * ta + (size_t)kofs(u.seg) * 2; }
    DI const char* bptr(const Unit& u) const { return B + (size_t)u.pn * tb + (size_t)kofs(u.seg) * 2; }
    DI int ntiles(const Unit& u) const { return u.seg == 0 ? 12 : 10; }
};

template <class Epi, class Sched>
DI void gemm_phase(LAS unsigned char* lds, const int wv, const int lda, const int ldb, const Sched& S, const Epi& E) {
    int tid_ = wv * 64 + lane_id_fresh(); asm volatile("" : "+v"(tid_));
    const int tid = tid_, wid = __builtin_amdgcn_readfirstlane(tid >> 6), lane = tid & 63, wr = wid >> 2, wc = wid & 3, fr = lane & 15, fq = lane >> 4;
    unsigned voffA[2], voffB[2];
#pragma unroll
    for (int i = 0; i < 2; ++i) { int R, C; stage_rc(tid * 16 + i * 8192, R, C); const int Rb = Epi::PERM ? ((R & ~31) + perm32(R & 31)) : R;
        voffA[i] = (unsigned)(R * lda + C) * 2u; voffB[i] = (unsigned)(Rb * ldb + C) * 2u; }
    const size_t kstep = (size_t)(BK * 2);
    const size_t hstepA = (size_t)HALF * lda * 2, hstepB = (size_t)HALF * ldb * 2;
    const unsigned ldsw = (unsigned)wid * 1024u;
    const int aoff = lds_byte(wr * 64 + fr, fq * 8), boff = lds_byte(wc * 32 + fr, fq * 8);
#define PG8_SA(b, h) (((b) * 2 + (h)) * HTB)
#define PG8_SB(b, h) ((4 + (b) * 2 + (h)) * HTB)
#define PG8_STAGE(bufoff, gbase, voff) do { _Pragma("unroll") for (int _i = 0; _i < 2; ++_i) \
        __builtin_amdgcn_global_load_lds((const unsigned*)((const char*)(gbase) + (voff)[_i]), (LAS unsigned*)(lds + (bufoff) + ldsw + _i * 8192), 16, 0, 0); } while (0)
#define PG8_LDA(dst, b, h) do { _Pragma("unroll") for (int m = 0; m < 4; ++m) _Pragma("unroll") for (int k = 0; k < 2; ++k) dst[m][k] = *(const LAS bf16x8*)(lds + PG8_SA(b, h) + aoff + m * 2048 + k * 1024); } while (0)
#define PG8_LDB(dst, b, h) do { _Pragma("unroll") for (int n = 0; n < 2; ++n) _Pragma("unroll") for (int k = 0; k < 2; ++k) dst[n][k] = *(const LAS bf16x8*)(lds + PG8_SB(b, h) + boff + n * 2048 + k * 1024); } while (0)
#define PG8_MMA(ai, bj, At, Bt) do { __builtin_amdgcn_s_setprio(1); _Pragma("unroll") for (int m = 0; m < 4; ++m) _Pragma("unroll") for (int n = 0; n < 2; ++n) _Pragma("unroll") for (int k = 0; k < 2; ++k) \
        acc[ai][bj][m][n] = __builtin_amdgcn_mfma_f32_16x16x32_bf16(Bt[n][k], At[m][k], acc[ai][bj][m][n], 0, 0, 0); __builtin_amdgcn_s_setprio(0); } while (0)
#define PG8_WAIT_V(n) asm volatile("s_waitcnt vmcnt(" #n ")" ::: "memory")
#define PG8_WAIT_L(n) asm volatile("s_waitcnt lgkmcnt(" #n ")" ::: "memory")
#define PG8_BAR __builtin_amdgcn_s_barrier()
#define PG8_SCHED __builtin_amdgcn_sched_barrier(0)
    Unit cur, nxt; int ui = 0;
    if (!S.next(0, cur)) return;
    f32x4 acc[2][2][4][2];
#pragma unroll
    for (int a = 0; a < 2; ++a)
#pragma unroll
        for (int b = 0; b < 2; ++b)
#pragma unroll
            for (int m = 0; m < 4; ++m)
#pragma unroll
                for (int n = 0; n < 2; ++n) acc[a][b][m][n] = (f32x4){0.f, 0.f, 0.f, 0.f};
    bf16x8 At[4][2], B0[2][2], B1[2][2];
    const char* cA = S.aptr(cur); const char* cB = S.bptr(cur); int nt = S.ntiles(cur);
    PG8_STAGE(PG8_SB(0, 0), cB, voffB); PG8_STAGE(PG8_SB(0, 1), cB + hstepB, voffB); PG8_STAGE(PG8_SA(0, 0), cA, voffA); PG8_STAGE(PG8_SA(0, 1), cA + hstepA, voffA);
    if (wr == 1) PG8_BAR;
    PG8_WAIT_V(2); PG8_BAR;
    PG8_STAGE(PG8_SB(1, 0), cB + kstep, voffB); PG8_STAGE(PG8_SA(1, 0), cA + kstep, voffA); PG8_STAGE(PG8_SB(1, 1), cB + hstepB + kstep, voffB);
    PG8_WAIT_V(6); PG8_BAR;
    for (;;) {
        const bool has_next = S.next(ui + 1, nxt);
        const char* nA = has_next ? S.aptr(nxt) : cA; const char* nB = has_next ? S.bptr(nxt) : cB;
        for (int t = 0; t < nt; t += 2) {
            const bool last = (t == nt - 2);
            const char* a1 = cA + (size_t)(t + 1) * kstep;
            const char* a2 = last ? nA : cA + (size_t)(t + 2) * kstep; const char* b2 = last ? nB : cB + (size_t)(t + 2) * kstep;
            const char* a3 = a2 + kstep; const char* b3 = b2 + kstep;
            PG8_LDB(B0, 0, 0); PG8_LDB(B1, 0, 1); PG8_SCHED; PG8_LDA(At, 0, 0); PG8_STAGE(PG8_SA(1, 1), a1 + hstepA, voffA);
            PG8_WAIT_V(8); PG8_WAIT_L(0); PG8_BAR; PG8_MMA(0, 0, At, B0); PG8_MMA(0, 1, At, B1); PG8_BAR; PG8_SCHED;
            PG8_LDA(At, 0, 1); PG8_STAGE(PG8_SB(0, 0), b2, voffB); PG8_STAGE(PG8_SB(0, 1), b2 + hstepB, voffB); PG8_STAGE(PG8_SA(0, 0), a2, voffA);
            PG8_WAIT_V(8); PG8_WAIT_L(0); PG8_BAR; PG8_MMA(1, 0, At, B0); PG8_MMA(1, 1, At, B1); PG8_BAR; PG8_SCHED;
            PG8_LDB(B0, 1, 0); PG8_LDB(B1, 1, 1); PG8_SCHED; PG8_LDA(At, 1, 0); PG8_STAGE(PG8_SA(0, 1), a2 + hstepA, voffA);
            PG8_WAIT_V(8); PG8_WAIT_L(0); PG8_BAR; PG8_MMA(0, 0, At, B0); PG8_MMA(0, 1, At, B1); PG8_BAR; PG8_SCHED;
            PG8_LDA(At, 1, 1); PG8_STAGE(PG8_SB(1, 0), b3, voffB); PG8_STAGE(PG8_SB(1, 1), b3 + hstepB, voffB); PG8_STAGE(PG8_SA(1, 0), a3, voffA);
            PG8_WAIT_V(8); PG8_WAIT_L(0); PG8_BAR; PG8_MMA(1, 0, At, B0); PG8_MMA(1, 1, At, B1); PG8_BAR; PG8_SCHED;
        }
        if (wr == 0) PG8_BAR;
        const bool clr = E(acc, cur, wr, wc, fr, fq);
        if (!has_next) break;
        if (clr) {
#pragma unroll
            for (int a = 0; a < 2; ++a)
#pragma unroll
                for (int b = 0; b < 2; ++b)
#pragma unroll
                    for (int m = 0; m < 4; ++m)
#pragma unroll
                        for (int n = 0; n < 2; ++n) acc[a][b][m][n] = (f32x4){0.f, 0.f, 0.f, 0.f};
        }
        cur = nxt; cA = nA; cB = nB; nt = S.ntiles(cur); ++ui;
        if (wr == 1) PG8_BAR;
    }
    PG8_WAIT_V(0);
    PG8_BAR;
#undef PG8_SA
#undef PG8_SB
#undef PG8_STAGE
#undef PG8_LDA
#undef PG8_LDB
#undef PG8_MMA
#undef PG8_WAIT_V
#undef PG8_WAIT_L
#undef PG8_BAR
#undef PG8_SCHED
}

typedef f32x4 AccT[2][2][4][2];
struct EpiInproj {
    static constexpr bool PERM = true;
    bf16* Z; const float* gbias; bf16* ZS5; const LAS float* rs;
    DI bool operator()(AccT& acc, const Unit& u, int wr, int wc, int fr, int fq) const {
        const int row0 = u.pm * BM + wr * 64 + fr, col0 = u.pn * BM + wc * 32 + 8 * fq;
        float rsv[2][4];
#pragma unroll
        for (int ai = 0; ai < 2; ++ai)
#pragma unroll
            for (int m = 0; m < 4; ++m) rsv[ai][m] = rs[row0 + ai * HALF + m * 16];
#pragma unroll
        for (int bj = 0; bj < 2; ++bj) {
            const int col = col0 + bj * HALF; const bool gate = (col >= ZC_GATE) && (col < ZC_VRES); const bool s5c = col < S5W;
            f32x4 b0 = {0.f, 0.f, 0.f, 0.f}, b1 = b0;
            if (gate) { b0 = *(const GAS f32x4*)(gbias + (col - ZC_GATE)); b1 = *(const GAS f32x4*)(gbias + (col - ZC_GATE) + 4); }
#pragma unroll
            for (int ai = 0; ai < 2; ++ai)
#pragma unroll
                for (int m = 0; m < 4; ++m) {
                    f32x4 v0 = acc[ai][bj][m][0] * rsv[ai][m], v1 = acc[ai][bj][m][1] * rsv[ai][m];
                    if (gate) { v0 += b0; v1 += b1;
#pragma unroll
                        for (int e = 0; e < 4; ++e) { v0[e] = sigmoidf_(v0[e]); v1[e] = sigmoidf_(v1[e]); } }
                    u32x4 w; w.x = pk2(v0[0], v0[1]); w.y = pk2(v0[2], v0[3]); w.z = pk2(v1[0], v1[1]); w.w = pk2(v1[2], v1[3]);
                    if (s5c) *(GAS u32x4*)(ZS5 + ((size_t)(col >> 4) * M + (row0 + ai * HALF + m * 16)) * 16 + (col & 8)) = w;
                    else *(GAS u32x4*)(Z + (size_t)(row0 + ai * HALF + m * 16) * ZP + col) = w;
                }
        }
        return true;
    }
};
struct EpiGlu {
    static constexpr bool PERM = true;
    const bf16* ypre; bf16* ycat; const float* gb;
    DI bool operator()(AccT& acc, const Unit& u, int wr, int wc, int fr, int fq) const {
        const int row0 = u.pm * BM + wr * 64 + fr, col0 = u.pn * BM + wc * 32 + 8 * fq;
        f32x4 b0[2], b1[2];
#pragma unroll
        for (int bj = 0; bj < 2; ++bj) { b0[bj] = *(const GAS f32x4*)(gb + col0 + bj * HALF); b1[bj] = *(const GAS f32x4*)(gb + col0 + bj * HALF + 4); }
#pragma unroll
        for (int ai = 0; ai < 2; ++ai) {
            u32x4 yv[2][4];
#pragma unroll
            for (int bj = 0; bj < 2; ++bj)
#pragma unroll
                for (int m = 0; m < 4; ++m) yv[bj][m] = *(const GAS u32x4*)(ypre + (size_t)(row0 + ai * HALF + m * 16) * S5W + col0 + bj * HALF);
            __builtin_amdgcn_sched_barrier(0);
#pragma unroll
            for (int bj = 0; bj < 2; ++bj)
#pragma unroll
                for (int m = 0; m < 4; ++m) { float y[8]; unpack8(yv[bj][m], y);
                    const f32x4 v0 = acc[ai][bj][m][0] + b0[bj], v1 = acc[ai][bj][m][1] + b1[bj];
                    float o[8];
#pragma unroll
                    for (int e = 0; e < 4; ++e) { o[e] = y[e] * sigmoidf_(v0[e]); o[4 + e] = y[4 + e] * sigmoidf_(v1[e]); }
                    *(GAS u32x4*)(ycat + (size_t)(row0 + ai * HALF + m * 16) * D + col0 + bj * HALF) = pack8(o); }
            __builtin_amdgcn_sched_barrier(0);
        }
        return true;
    }
};
struct EpiMerged {
    static constexpr bool PERM = true;
    const bf16* Z; bf16* out;
    DI bool operator()(AccT& acc, const Unit& u, int wr, int wc, int fr, int fq) const {
        const int row0 = u.pm * BM + wr * 64 + fr, col0 = u.pn * BM + wc * 32 + 8 * fq;
        const int seg = u.seg;
#pragma unroll
        for (int ai = 0; ai < 2; ++ai) {
            u32x4 ga[2][4], gb[2][4];
#pragma unroll
            for (int bj = 0; bj < 2; ++bj)
#pragma unroll
                for (int m = 0; m < 4; ++m) { const bf16* zr = Z + (size_t)(row0 + ai * HALF + m * 16) * ZP + ZC_GATE + col0 + bj * HALF;
                    ga[bj][m] = *(const GAS u32x4*)(zr + seg * D); if (seg < 2) gb[bj][m] = *(const GAS u32x4*)(zr + (seg + 1) * D); else gb[bj][m] = ga[bj][m]; }
            __builtin_amdgcn_sched_barrier(0);
#pragma unroll
            for (int bj = 0; bj < 2; ++bj)
#pragma unroll
                for (int m = 0; m < 4; ++m) {
                    float g0[8], g1[8], s[8]; unpack8(ga[bj][m], g0); unpack8(gb[bj][m], g1);
#pragma unroll
                    for (int e = 0; e < 8; ++e) { const float a = fmaxf(g0[e], 1e-20f); s[e] = (seg < 2) ? a * __builtin_amdgcn_rcpf(fmaxf(g1[e], 1e-20f)) : a; }
                    f32x4 v0 = acc[ai][bj][m][0], v1 = acc[ai][bj][m][1];
#pragma unroll
                    for (int e = 0; e < 4; ++e) { v0[e] *= s[e]; v1[e] *= s[4 + e]; }
                    acc[ai][bj][m][0] = v0; acc[ai][bj][m][1] = v1;
                    if (seg == 2) { u32x4 w; w.x = pk2(v0[0], v0[1]); w.y = pk2(v0[2], v0[3]); w.z = pk2(v1[0], v1[1]); w.w = pk2(v1[2], v1[3]);
                        *(GAS u32x4*)(out + (size_t)(row0 + ai * HALF + m * 16) * D + col0 + bj * HALF) = w; } }
            __builtin_amdgcn_sched_barrier(0);
        }
        return seg == 2;
    }
};
constexpr int XP = D;
struct EpiResid {
    static constexpr bool PERM = true;
    const bf16* xb; bf16* xo; float* ssq;
    DI bool operator()(AccT& acc, const Unit& u, int wr, int wc, int fr, int fq) const {
        const int row0 = u.pm * BM + wr * 64 + fr, col0 = u.pn * BM + wc * 32 + 8 * fq;
        float ps[2][4];
#pragma unroll
        for (int ai = 0; ai < 2; ++ai) {
            u32x4 xv[4][2];
#pragma unroll
            for (int m = 0; m < 4; ++m) { const bf16* rowp = xb + (size_t)(row0 + ai * HALF + m * 16) * XP + col0;
#pragma unroll
                for (int bj = 0; bj < 2; ++bj) xv[m][bj] = *(const GAS u32x4*)(rowp + bj * HALF); }
            __builtin_amdgcn_sched_barrier(0);
#pragma unroll
            for (int m = 0; m < 4; ++m) { bf16* rowp = xo + (size_t)(row0 + ai * HALF + m * 16) * XP + col0; float s = 0.f;
#pragma unroll
                for (int bj = 0; bj < 2; ++bj) { const u32x4 x = xv[m][bj]; const f32x4 a0 = acc[ai][bj][m][0], a1 = acc[ai][bj][m][1];
                    const float y0 = bflo(x.x) + a0[0], y1 = bfhi(x.x) + a0[1], y2 = bflo(x.y) + a0[2], y3 = bfhi(x.y) + a0[3], y4 = bflo(x.z) + a1[0], y5 = bfhi(x.z) + a1[1], y6 = bflo(x.w) + a1[2], y7 = bfhi(x.w) + a1[3];
                    s += (y0 * y0 + y1 * y1) + (y2 * y2 + y3 * y3) + (y4 * y4 + y5 * y5) + (y6 * y6 + y7 * y7);
                    u32x4 w; w.x = pk2(y0, y1); w.y = pk2(y2, y3); w.z = pk2(y4, y5); w.w = pk2(y6, y7);
                    *(GAS u32x4*)(rowp + bj * HALF) = w; }
                ps[ai][m] = s; }
            __builtin_amdgcn_sched_barrier(0);
        }
        { int a16 = ((fr + 16 * fq) ^ 16) << 2, a32 = ((fr + 16 * fq) ^ 32) << 2;
#pragma unroll
          for (int ai = 0; ai < 2; ++ai)
#pragma unroll
              for (int m = 0; m < 4; ++m) { float s = ps[ai][m];
                  s += __builtin_bit_cast(float, __builtin_amdgcn_ds_bpermute(a16, __builtin_bit_cast(int, s)));
                  s += __builtin_bit_cast(float, __builtin_amdgcn_ds_bpermute(a32, __builtin_bit_cast(int, s)));
                  if (fq == 0) ssq[(size_t)(row0 + ai * HALF + m * 16) * 32 + u.pn * 4 + wc] = s; } }
        return true;
    }
};
struct EpiRelu2 {
    static constexpr bool PERM = true;
    bf16* out; const LAS float* rs;
    DI bool operator()(AccT& acc, const Unit& u, int wr, int wc, int fr, int fq) const {
        const int row0 = u.pm * BM + wr * 64 + fr, col0 = u.pn * BM + wc * 32 + 8 * fq;
#pragma unroll
        for (int ai = 0; ai < 2; ++ai)
#pragma unroll
            for (int m = 0; m < 4; ++m) { bf16* rowp = out + (size_t)(row0 + ai * HALF + m * 16) * DFF + col0; const float rsv = rs[row0 + ai * HALF + m * 16];
#pragma unroll
                for (int bj = 0; bj < 2; ++bj) { f32x4 v0 = acc[ai][bj][m][0] * rsv, v1 = acc[ai][bj][m][1] * rsv;
#pragma unroll
                    for (int e = 0; e < 4; ++e) { const float a = fmaxf(v0[e], 0.f), b = fmaxf(v1[e], 0.f); v0[e] = a * a; v1[e] = b * b; }
                    u32x4 w; w.x = pk2(v0[0], v0[1]); w.y = pk2(v0[2], v0[3]); w.z = pk2(v1[0], v1[1]); w.w = pk2(v1[2], v1[3]);
                    *(GAS u32x4*)(rowp + bj * HALF) = w; } }
        return true;
    }
};
constexpr size_t MiB = 1u << 20;
constexpr size_t WS_CTL = 0, CTL_ZERO_BYTES = 1 * MiB;
constexpr size_t SZ_WIN = (size_t)ZP * D * 2, SZ_WSQ = (size_t)D * D * 2, SZ_W1 = (size_t)DFF * D * 2, SZ_GLU = (size_t)S5W * S5W * 2;
constexpr size_t SZ_WL = (size_t)RW * 96 * 2, SZ_AL = (size_t)RW * 128 * 2, SZ_GL = (size_t)RW * 256 * 2, SZ_VB = (size_t)RW * 64 * 2;
constexpr size_t LW_WIN = 0, LW_WUP = LW_WIN + SZ_WIN, LW_WOUT = LW_WUP + SZ_WSQ, LW_W1 = LW_WOUT + SZ_WSQ, LW_W2 = LW_W1 + SZ_W1, LW_GLU = LW_W2 + SZ_W1,
                 LW_WL = LW_GLU + SZ_GLU, LW_AL = LW_WL + SZ_WL, LW_GL = LW_AL + SZ_AL, LW_VB = LW_GL + SZ_GL, LW_SIZE = LW_VB + SZ_VB;
constexpr size_t WS_W = 1 * MiB;
constexpr size_t WS_R1 = WS_W + DEPTH * LW_SIZE;
constexpr size_t SZ_R1 = (size_t)M * D * 2;
constexpr size_t WS_R2 = WS_R1 + SZ_R1;
constexpr size_t SZ_R2 = (size_t)M * ZP * 2;
constexpr size_t WS_R3 = WS_R2 + SZ_R2;
constexpr size_t WS_R5 = WS_R3 + SZ_R1;
constexpr size_t SZ_HT = (size_t)RH * M * 64 * 4;
constexpr size_t SZ_HB = (size_t)RH * M * 64 * 2;
constexpr size_t WS_R4 = WS_R5 + SZ_HT;
constexpr size_t WS_LW = WS_R4 + 6 * SZ_HB, WS_BC = WS_LW + SZ_HT;
constexpr size_t WS_ALG = WS_R4;
constexpr size_t WS_S5TA = WS_R4 + 3 * SZ_HB;
constexpr size_t WS_S5XA = WS_LW;
constexpr int NCH = M / 64;
constexpr size_t CK_PL = 0, CK_RP = 8192, CK_Q = 16384, CK_O0 = 24576, CK_H = 40960, CK_GC = 49152, CK_SIZE = 49408;
constexpr size_t WS_CK = WS_BC + (size_t)RH * M * 4;
constexpr size_t WS_GK = WS_CK + (size_t)NCH * RH * CK_SIZE;
constexpr size_t WS_ZS5 = WS_GK + (size_t)NCH * GH * 49408;
constexpr size_t WS_END = WS_ZS5 + (size_t)M * S5W * 2;
constexpr size_t WS_GQK = WS_R4 + SZ_HB;
constexpr size_t WS_GVP = WS_LW + 4 * MiB;
static_assert((size_t)NCH * GH * 16384 <= SZ_HB && 4 * MiB + (size_t)NCH * GH * 16384 <= SZ_HT && (size_t)48 * 16 * 128 * 4 * 2 <= 4 * MiB, "gla images");
constexpr size_t WS_SSQ = WS_GVP + (size_t)NCH * GH * 16384;
static_assert(WS_SSQ + (size_t)M * 32 * 4 <= WS_LW + SZ_HT, "ssq");
static_assert(WS_END <= 1474297856ull, "workspace map exceeds 4 x largest input");
static_assert((size_t)M * RW * 4 + (size_t)M * S5W * 2 <= SZ_R1 && (size_t)M * DFF * 2 <= SZ_R2, "overlays");
constexpr int CW_BAR = 4096;
constexpr size_t WS_PRM = WS_CTL + 131072;
static_assert(131072 + (size_t)DEPTH * RH * 576 * 4 <= CTL_ZERO_BYTES, "prm");

constexpr int LDS_BYTES = 155648;
constexpr int MISC_OFF = LDS_BYTES - 512;

struct Args { const float* in[38]; float* out; unsigned char* ws; int lo, hi; };

#define CAS __attribute__((address_space(4)))
struct Frame {
    LAS unsigned char* lds; int tid, lane, wave, G, bid;
    unsigned char* ws; float* out;
};
DI Frame make_frame(LAS unsigned char* lds, const CAS Args*& ap, const int wv) {
    Frame F; F.lds = lds;
    int tid = wv * 64 + lane_id_fresh(); asm volatile("" : "+v"(tid));
    int bid = blockIdx.x, G = gridDim.x; asm volatile("" : "+s"(bid), "+s"(G));
    const CAS Args* p = (const CAS Args*)__builtin_amdgcn_kernarg_segment_ptr(); asm volatile("" : "+s"(p));
    F.tid = tid; F.lane = tid & 63; F.wave = wv; F.G = G; F.bid = bid;
    F.ws = p->ws; F.out = p->out; ap = p; return F;
}
DI unsigned char* lw(const Frame& F, int l, size_t off) { return F.ws + WS_W + (size_t)l * LW_SIZE + off; }

DI void transpose_item(const float* W, int K, int N, bf16* WT, int ldt, int row_off, LAS float* scr, int item, int lane, const float* kscale = nullptr, int frag_nk = 0) {
    const int nblk = (N + 31) / 32, kb = item / nblk, nb = item % nblk, k0 = 64 * kb, n0 = 32 * nb;
    const int lr = lane >> 3, c4 = (lane & 7) * 4; const bool nok = (n0 + c4) < N;
    f32x4 v[8];
#pragma unroll
    for (int i = 0; i < 8; ++i) { const int row = lr + 8 * i; const bool ok = nok && (k0 + row) < K; v[i] = ok ? *(const GAS f32x4*)(W + (size_t)(k0 + row) * N + n0 + c4) : (f32x4){0.f, 0.f, 0.f, 0.f}; }
    if (kscale) { float ks[8];
#pragma unroll
        for (int i = 0; i < 8; ++i) ks[i] = kscale[(k0 + lr + 8 * i) < K ? (k0 + lr + 8 * i) : 0];
#pragma unroll
        for (int i = 0; i < 8; ++i) v[i] = v[i] * ks[i]; }
    __builtin_amdgcn_sched_barrier(0);
#pragma unroll
    for (int i = 0; i < 8; ++i) { LAS float* d = scr + (lr + 8 * i) * 33 + c4; d[0] = v[i][0]; d[1] = v[i][1]; d[2] = v[i][2]; d[3] = v[i][3]; }
    LDS_WAIT(); asm volatile("" ::: "memory");
    const int c = lane & 7;
    u32x4 o[4];
#pragma unroll
    for (int j = 0; j < 4; ++j) { const int n = (lane >> 3) + 8 * j; const LAS float* s = scr + (8 * c) * 33 + n;
        o[j].x = pk2(s[0 * 33], s[1 * 33]); o[j].y = pk2(s[2 * 33], s[3 * 33]); o[j].z = pk2(s[4 * 33], s[5 * 33]); o[j].w = pk2(s[6 * 33], s[7 * 33]); }
#pragma unroll
    for (int j = 0; j < 4; ++j) { const int n = (lane >> 3) + 8 * j; if ((n0 + n) < N && (k0 + 8 * c) < K) {
            if (frag_nk) { const int nn = n0 + n, kk = k0 + 8 * c; *(GAS u32x4*)(WT + ((size_t)((nn >> 4) * frag_nk + (kk >> 5)) * 64 + (nn & 15) + 16 * ((kk & 31) >> 3)) * 8) = o[j]; }
            else *(GAS u32x4*)(WT + (size_t)(row_off + n0 + n) * ldt + k0 + 8 * c) = o[j]; } }
    LDS_WAIT(); asm volatile("" ::: "memory");
}
DI int titems(int K, int N) { return ((K + 63) / 64) * ((N + 31) / 32); }
DI void p0_prologue(const Frame& F, const CAS Args& a) {
    LAS float* scr = (LAS float*)(F.lds + F.wave * 16384);
    const int gw = F.bid * 8 + F.wave, NGW = F.G * 8;
    constexpr int I_IN = (D / 64) * ((INCOLS + 31) / 32), I_VA = (D / 64) * 2, I_SQ = (D / 64) * (D / 32), I_1 = (D / 64) * (DFF / 32), I_2 = (DFF / 64) * (D / 32),
                  I_GLU = (S5W / 64) * (S5W / 32), I_WL = 2 * 20, I_AL = 2 * 20, I_GL = 4 * 20, I_VB = 1 * 20;
    constexpr int PER_LAYER = I_IN + I_VA + 2 * I_SQ + I_1 + I_2 + I_GLU + I_WL + I_AL + I_GL + I_VB;
    for (int it = gw; it < DEPTH * PER_LAYER; it += NGW) {
        const int l = it / PER_LAYER; int r = it - l * PER_LAYER;
        if (r < I_IN) { transpose_item(a.in[2] + (size_t)l * D * INCOLS, D, INCOLS, (bf16*)lw(F, l, LW_WIN), D, 0, scr, r, F.lane, a.in[1] + (size_t)l * D); continue; } r -= I_IN;
        if (r < I_VA) { if (l > 0) transpose_item(a.in[25] + (size_t)(l - 1) * D * 64, D, 64, (bf16*)lw(F, l, LW_WIN), D, ZC_VRES, scr, r, F.lane, a.in[1] + (size_t)l * D); continue; } r -= I_VA;
        if (r < I_SQ) { transpose_item(a.in[32] + (size_t)l * D * D, D, D, (bf16*)lw(F, l, LW_WUP), D, 0, scr, r, F.lane); continue; } r -= I_SQ;
        if (r < I_SQ) { transpose_item(a.in[33] + (size_t)l * D * D, D, D, (bf16*)lw(F, l, LW_WOUT), D, 0, scr, r, F.lane); continue; } r -= I_SQ;
        if (r < I_1) { transpose_item(a.in[35] + (size_t)l * D * DFF, D, DFF, (bf16*)lw(F, l, LW_W1), D, 0, scr, r, F.lane, a.in[34] + (size_t)l * D); continue; } r -= I_1;
        if (r < I_2) { transpose_item(a.in[36] + (size_t)l * DFF * D, DFF, D, (bf16*)lw(F, l, LW_W2), DFF, 0, scr, r, F.lane); continue; } r -= I_2;
        if (r < I_GLU) { transpose_item(a.in[12] + (size_t)l * S5W * S5W, S5W, S5W, (bf16*)lw(F, l, LW_GLU), S5W, 0, scr, r, F.lane); continue; } r -= I_GLU;
        if (r < I_WL) { transpose_item(a.in[15] + (size_t)l * 96 * RW, 96, RW, (bf16*)lw(F, l, LW_WL), 96, 0, scr, r, F.lane, nullptr, 3); continue; } r -= I_WL;
        if (r < I_AL) { transpose_item(a.in[17] + (size_t)l * 128 * RW, 128, RW, (bf16*)lw(F, l, LW_AL), 128, 0, scr, r, F.lane, nullptr, 4); continue; } r -= I_AL;
        if (r < I_GL) { transpose_item(a.in[19] + (size_t)l * 256 * RW, 256, RW, (bf16*)lw(F, l, LW_GL), 256, 0, scr, r, F.lane, nullptr, 8); continue; } r -= I_GL;
        if (l > 0) transpose_item(a.in[27] + (size_t)(l - 1) * 64 * RW, 64, RW, (bf16*)lw(F, l, LW_VB), 64, 0, scr, r, F.lane, nullptr, 2);
    }
}

template <bool IN_BF16, bool OUT_F32>
DI void rmsnorm_phase(const Frame& F, const void* xp, const float* g, void* outp) {
    const int gw = F.bid * 8 + F.wave, NGW = F.G * 8;
    f32x4 gv[8];
    if (IN_BF16) {
#pragma unroll
        for (int j = 0; j < 4; ++j) { gv[2 * j] = ((const GAS f32x4*)g)[2 * (64 * j + F.lane)]; gv[2 * j + 1] = ((const GAS f32x4*)g)[2 * (64 * j + F.lane) + 1]; }
    } else {
#pragma unroll
        for (int j = 0; j < 8; ++j) gv[j] = ((const GAS f32x4*)g)[64 * j + F.lane];
    }
    for (int m = gw; m < M; m += NGW) {
        f32x4 v[8]; float s = 0.f;
        if (IN_BF16) { const GAS u32x4* xr = (const GAS u32x4*)((const bf16*)xp + (size_t)m * XP) + F.lane;
            u32x4 r[4];
#pragma unroll
            for (int j = 0; j < 4; ++j) r[j] = xr[64 * j];
#pragma unroll
            for (int j = 0; j < 4; ++j) { v[2 * j] = (f32x4){bflo(r[j].x), bfhi(r[j].x), bflo(r[j].y), bfhi(r[j].y)}; v[2 * j + 1] = (f32x4){bflo(r[j].z), bfhi(r[j].z), bflo(r[j].w), bfhi(r[j].w)}; }
#pragma unroll
            for (int j = 0; j < 8; ++j) s += (v[j].x * v[j].x + v[j].y * v[j].y) + (v[j].z * v[j].z + v[j].w * v[j].w);
        } else { const GAS f32x4* xr = (const GAS f32x4*)((const float*)xp + (size_t)m * D) + F.lane;
#pragma unroll
            for (int j = 0; j < 8; ++j) { v[j] = xr[64 * j]; s += (v[j].x * v[j].x + v[j].y * v[j].y) + (v[j].z * v[j].z + v[j].w * v[j].w); } }
        const float rstd = 1.f / sqrtf(wave_sum(s) * (1.f / D) + NORM_EPS);
        if (OUT_F32) {
            if (IN_BF16) { GAS f32x4* o = (GAS f32x4*)((float*)outp + (size_t)m * D);
#pragma unroll
                for (int j = 0; j < 4; ++j) { o[2 * (64 * j + F.lane)] = v[2 * j] * rstd * gv[2 * j]; o[2 * (64 * j + F.lane) + 1] = v[2 * j + 1] * rstd * gv[2 * j + 1]; }
            } else { GAS f32x4* o = (GAS f32x4*)((float*)outp + (size_t)m * D) + F.lane;
#pragma unroll
                for (int j = 0; j < 8; ++j) o[64 * j] = v[j] * rstd * gv[j]; }
        } else {
            if (IN_BF16) { GAS u32x4* o = (GAS u32x4*)((bf16*)outp + (size_t)m * D) + F.lane;
#pragma unroll
                for (int j = 0; j < 4; ++j) { const f32x4 y0 = v[2 * j] * rstd * gv[2 * j], y1 = v[2 * j + 1] * rstd * gv[2 * j + 1]; u32x4 w; w.x = pk2(y0.x, y0.y); w.y = pk2(y0.z, y0.w); w.z = pk2(y1.x, y1.y); w.w = pk2(y1.z, y1.w); o[64 * j] = w; }
            } else { GAS u32x2* o = (GAS u32x2*)((bf16*)outp + (size_t)m * D) + F.lane;
#pragma unroll
                for (int j = 0; j < 8; ++j) { const f32x4 y = v[j] * rstd * gv[j]; u32x2 w; w.x = pk2(y.x, y.y); w.y = pk2(y.z, y.w); o[64 * j] = w; } }
        }
    }
}

constexpr int AL_PITCH = 552;
constexpr int PO_PITCH = 68;
struct RwPrep { bf16 *R, *K2, *V, *KK, *BB, *G; float *LW, *BC, *VF; };
DI RwPrep rwprep_ptrs(const Frame& F) { RwPrep p; bf16* b = (bf16*)(F.ws + WS_R4); const size_t n = (size_t)RH * M * 64;
    p.R = b; p.K2 = b + n; p.V = b + 2 * n; p.KK = b + 3 * n; p.BB = b + 4 * n; p.G = b + 5 * n; p.LW = (float*)(F.ws + WS_LW); p.BC = (float*)(F.ws + WS_BC); p.VF = (float*)(F.ws + WS_R5); return p; }
#define SB() __builtin_amdgcn_sched_barrier(0)
#ifndef REP3_MASK
#define REP3_MASK 0
#endif
#define REP3(k) ((REP3_MASK >> (k)) & 1)
template <int K, int KOFF, int L>
DI void lora_tile(const LAS bf16* AL, const bf16* Bt, LAS float* PO, int h, int mt, int np, int fr, int fq) {
    constexpr int NK = K / 32;
    bf16x8 bv[2][NK], av[NK];
#pragma unroll
    for (int ks = 0; ks < NK; ++ks) { av[ks] = *(const LAS bf16x8*)(AL + (16 * mt + fr) * AL_PITCH + KOFF + 32 * ks + 8 * fq);
#pragma unroll
        for (int nn = 0; nn < 2; ++nn) bv[nn][ks] = *(const GAS bf16x8*)(Bt + (size_t)(h * 64 + 16 * (2 * np + nn) + fr) * K + 8 * fq + 32 * ks); }
    SB();
#pragma unroll
    for (int nn = 0; nn < 2; ++nn) { const int nt = 2 * np + nn; f32x4 acc = {0.f, 0.f, 0.f, 0.f};
#pragma unroll
        for (int ks = 0; ks < NK; ++ks) acc = __builtin_amdgcn_mfma_f32_16x16x32_bf16(av[ks], bv[nn][ks], acc, 0, 0, 0);
#pragma unroll
        for (int i = 0; i < 4; ++i) PO[(L * 64 + 16 * mt + 4 * fq + i) * PO_PITCH + 16 * nt + fr] = acc[i]; }
    SB();
}
DI void lora2_tile(const LAS bf16* AL, const bf16* WLt, const bf16* VBt, LAS float* PO, int h, int mt, int np, int fr, int fq, bool has_v) {
    bf16x8 b0[2][3], a0[3], b3[2][2], a3[2];
    const LAS bf16* arow = AL + (16 * mt + fr) * AL_PITCH + 8 * fq;
#pragma unroll
    for (int ks = 0; ks < 3; ++ks) { a0[ks] = *(const LAS bf16x8*)(arow + 32 * ks);
#pragma unroll
        for (int nn = 0; nn < 2; ++nn) b0[nn][ks] = *(const GAS bf16x8*)(WLt + (size_t)(h * 64 + 16 * (2 * np + nn) + fr) * 96 + 8 * fq + 32 * ks); }
#pragma unroll
    for (int ks = 0; ks < 2; ++ks) { a3[ks] = *(const LAS bf16x8*)(arow + 480 + 32 * ks);
#pragma unroll
        for (int nn = 0; nn < 2; ++nn) b3[nn][ks] = has_v ? *(const GAS bf16x8*)(VBt + (size_t)(h * 64 + 16 * (2 * np + nn) + fr) * 64 + 8 * fq + 32 * ks) : (bf16x8){0, 0, 0, 0, 0, 0, 0, 0}; }
    SB();
#pragma unroll
    for (int nn = 0; nn < 2; ++nn) { const int nt = 2 * np + nn; f32x4 c0 = {0.f, 0.f, 0.f, 0.f}, c3 = c0;
#pragma unroll
        for (int ks = 0; ks < 3; ++ks) c0 = __builtin_amdgcn_mfma_f32_16x16x32_bf16(a0[ks], b0[nn][ks], c0, 0, 0, 0);
#pragma unroll
        for (int ks = 0; ks < 2; ++ks) c3 = __builtin_amdgcn_mfma_f32_16x16x32_bf16(a3[ks], b3[nn][ks], c3, 0, 0, 0);
#pragma unroll
        for (int i = 0; i < 4; ++i) { PO[(0 * 64 + 16 * mt + 4 * fq + i) * PO_PITCH + 16 * nt + fr] = c0[i]; PO[(3 * 64 + 16 * mt + 4 * fq + i) * PO_PITCH + 16 * nt + fr] = c3[i]; } }
    SB();
}
DI void rwkv_prep_phase(const Frame& F, const CAS Args& a, int l) {
    const bf16* Z = (const bf16*)(F.ws + WS_R2);
    LAS bf16* AL = (LAS bf16*)F.lds;
    LAS float* PO = (LAS float*)(F.lds + 64 * AL_PITCH * 2);
    const float* mu = a.in[14] + (size_t)l * RWCOLS;
    const float* vmu = a.in[26] + (size_t)(l > 0 ? l - 1 : 0) * 64;
    const RwPrep P = rwprep_ptrs(F);
    const bf16* WLt = (const bf16*)lw(F, l, LW_WL); const bf16* ALt = (const bf16*)lw(F, l, LW_AL); const bf16* GLt = (const bf16*)lw(F, l, LW_GL); const bf16* VBt = (const bf16*)lw(F, l, LW_VB);
    for (int c = F.bid; c < M / 64; c += F.G) {
        for (int rep_ = 0; rep_ < 1 + REP3(0); ++rep_) {
        if (F.tid < 476) { const int cc = F.tid % 68, r0 = F.tid / 68, j = cc * 8;
            const int zc = (j < 480) ? ZC_WIN + j : ZC_VRES + (j - 480); const float* mp = (j < 480) ? mu + (ZC_WIN - ZC_R) + j : vmu + (j - 480);
            const int kind = (j < 96) ? 0 : ((j >= 224 && j < 480) ? 2 : ((j >= 480 && l == 0) ? 3 : 1));
            const f32x4 m0 = *(const GAS f32x4*)mp, m1 = *(const GAS f32x4*)(mp + 4);
            for (int ib = 0; ib < 2; ++ib) {
                u32x4 cu[5], pr[5];
#pragma unroll
                for (int u = 0; u < 5; ++u) { const int r = r0 + 7 * (5 * ib + u), rr = r < 64 ? r : 63, gr = 64 * c + rr;
                    cu[u] = *(const GAS u32x4*)(Z + (size_t)gr * ZP + zc); pr[u] = *(const GAS u32x4*)(Z + (size_t)(gr > 0 ? gr - 1 : 0) * ZP + zc); }
                SB();
#pragma unroll
                for (int u = 0; u < 5; ++u) { const int r = r0 + 7 * (5 * ib + u); if (r < 64) { const int gr = 64 * c + r;
                    float cur[8], prv[8], o[8]; unpack8(cu[u], cur); unpack8(pr[u], prv);
#pragma unroll
                    for (int e = 0; e < 8; ++e) { const float pv = gr > 0 ? prv[e] : 0.f; const float mm = e < 4 ? m0[e] : m1[e - 4]; o[e] = cur[e] + (pv - cur[e]) * mm; }
                    if (kind == 0) {
#pragma unroll
                        for (int e = 0; e < 8; ++e) o[e] = 1.f - 2.f * __builtin_amdgcn_rcpf(__expf(2.f * o[e]) + 1.f);
                    } else if (kind == 2) {
#pragma unroll
                        for (int e = 0; e < 8; ++e) o[e] = sigmoidf_(o[e]);
                    } else if (kind == 3) {
#pragma unroll
                        for (int e = 0; e < 8; ++e) o[e] = 0.f; }
                    *(LAS u32x4*)(AL + r * AL_PITCH + j) = pack8(o); } }
                SB();
            } }
        }
        __syncthreads();
        for (int h = 0; h < RH; ++h) {
            const int t = F.tid >> 3, cg = F.tid & 7, gr = 64 * c + t, ch = h * 64 + 8 * cg;
            const size_t po = ((size_t)h * M + gr) * 64 + 8 * cg;
            u32x4 zc_[3], zp_[3]; f32x4 zm0[3], zm1[3];
#pragma unroll
            for (int which = 0; which < 3; ++which) { const int zc = (which == 0 ? ZC_R : (which == 1 ? ZC_K : ZC_V)) + ch;
                zc_[which] = *(const GAS u32x4*)(Z + (size_t)gr * ZP + zc); zp_[which] = *(const GAS u32x4*)(Z + (size_t)(gr > 0 ? gr - 1 : 0) * ZP + zc);
                zm0[which] = *(const GAS f32x4*)(mu + (zc - ZC_R)); zm1[which] = *(const GAS f32x4*)(mu + (zc - ZC_R) + 4); }
            SB();
            for (int rep_ = 0; rep_ < 1 + REP3(1); ++rep_)
            { const int mt = F.wave & 3, np = F.wave >> 2, fr = F.lane & 15, fq = F.lane >> 4;
              lora2_tile(AL, WLt, VBt, PO, h, mt, np, fr, fq, l > 0);
              lora_tile<128, 96, 1>(AL, ALt, PO, h, mt, np, fr, fq);
              lora_tile<256, 224, 2>(AL, GLt, PO, h, mt, np, fr, fq);
            }
            f32x4 pw0[2], pa0[2], pkk[2], pka[2], prk[2], pvb[2], pvf[2];
#pragma unroll
            for (int q = 0; q < 2; ++q) { pw0[q] = *(const GAS f32x4*)(a.in[16] + (size_t)l * RW + ch + 4 * q); pa0[q] = *(const GAS f32x4*)(a.in[18] + (size_t)l * RW + ch + 4 * q); pkk[q] = *(const GAS f32x4*)(a.in[20] + (size_t)l * RW + ch + 4 * q);
                pka[q] = *(const GAS f32x4*)(a.in[21] + (size_t)l * RW + ch + 4 * q); prk[q] = *(const GAS f32x4*)(a.in[22] + (size_t)l * RW + ch + 4 * q);
                pvb[q] = (l > 0) ? *(const GAS f32x4*)(a.in[28] + (size_t)(l - 1) * RW + ch + 4 * q) : (f32x4){0.f, 0.f, 0.f, 0.f}; pvf[q] = (l > 0) ? *(const GAS f32x4*)(P.VF + po + 4 * q) : (f32x4){0.f, 0.f, 0.f, 0.f}; }
            SB();
            __syncthreads();
            for (int rep_ = 0; rep_ < 1 + REP3(2); ++rep_)
            {
              float r[8], k[8], v[8];
#pragma unroll
              for (int which = 0; which < 3; ++which) { float cu[8], pr[8]; unpack8(zc_[which], cu); unpack8(zp_[which], pr);
#pragma unroll
                  for (int e = 0; e < 8; ++e) { const float pv = gr > 0 ? pr[e] : 0.f; const float mm = e < 4 ? zm0[which][e] : zm1[which][e - 4]; const float zs = cu[e] + (pv - cu[e]) * mm;
                      if (which == 0) r[e] = zs; else if (which == 1) k[e] = zs; else v[e] = zs; } }
              float wpre[8], apre[8], gpre[8], vpre[8];
#pragma unroll
              for (int q = 0; q < 2; ++q) { const f32x4 x0 = *(const LAS f32x4*)(PO + (0 * 64 + t) * PO_PITCH + 8 * cg + 4 * q), x1 = *(const LAS f32x4*)(PO + (1 * 64 + t) * PO_PITCH + 8 * cg + 4 * q), x2 = *(const LAS f32x4*)(PO + (2 * 64 + t) * PO_PITCH + 8 * cg + 4 * q);
                  const f32x4 x3 = (l > 0) ? *(const LAS f32x4*)(PO + (3 * 64 + t) * PO_PITCH + 8 * cg + 4 * q) : (f32x4){0.f, 0.f, 0.f, 0.f};
#pragma unroll
                  for (int e = 0; e < 4; ++e) { wpre[4 * q + e] = x0[e]; apre[4 * q + e] = x1[e]; gpre[4 * q + e] = x2[e]; vpre[4 * q + e] = x3[e]; } }
              float lwv[8], av[8], kk[8], k2[8], bb[8]; float ss = 0.f, bc = 0.f;
              if (l > 0) {
#pragma unroll
                  for (int e = 0; e < 8; ++e) { const float vg = sigmoidf_(pvb[e >> 2][e & 3] + vpre[e]); const float vf = pvf[e >> 2][e & 3]; v[e] = v[e] + (vf - v[e]) * vg; } }
#pragma unroll
              for (int e = 0; e < 8; ++e) {
                  const float w = -softplusf_(-(pw0[e >> 2][e & 3] + wpre[e])) - 0.5f; lwv[e] = -__expf(w);
                  av[e] = sigmoidf_(pa0[e >> 2][e & 3] + apre[e]);
                  kk[e] = k[e] * pkk[e >> 2][e & 3]; ss += kk[e] * kk[e];
                  k2[e] = k[e] * (1.f + (av[e] - 1.f) * pka[e >> 2][e & 3]); bc += r[e] * k2[e] * prk[e >> 2][e & 3]; }
              ss = sum8(ss); bc = sum8(bc); const float rn = 1.f / sqrtf(fmaxf(ss, 1e-24f));
#pragma unroll
              for (int e = 0; e < 8; ++e) { kk[e] *= rn; bb[e] = kk[e] * av[e]; }
#define ST8(dst, arr) do { *(GAS f32x4*)((dst) + po) = (f32x4){arr[0], arr[1], arr[2], arr[3]}; *(GAS f32x4*)((dst) + po + 4) = (f32x4){arr[4], arr[5], arr[6], arr[7]}; } while (0)
#define ST8B(dst, arr) do { *(GAS u32x4*)((dst) + po) = pack8(arr); } while (0)
              ST8B(P.R, r); ST8(P.LW, lwv); ST8B(P.K2, k2); ST8B(P.V, v); ST8B(P.KK, kk); ST8B(P.BB, bb); ST8B(P.G, gpre);
              if (cg == 0) P.BC[(size_t)h * M + gr] = bc;
              if (l == 0) ST8(P.VF, v);
#undef ST8B
#undef ST8
            }
            __syncthreads();
        }
    }
}
DI float gelu_tanh(float y) { const float u = 0.7978845608028654f * (y + 0.044715f * y * y * y); const float e = __expf(2.f * u); const float th = 1.f - 2.f * __builtin_amdgcn_rcpf(e + 1.f); return 0.5f * y * (1.f + th); }

typedef short s16x4 __attribute__((ext_vector_type(4)));
DI bf16x8 ld_pi(const LAS bf16* row, int ks, int kg) {
    const u32x2 a = *(const LAS u32x2*)(row + 32 * ks + 4 * kg), b = *(const LAS u32x2*)(row + 32 * ks + 16 + 4 * kg);
    u32x4 v; v.x = a.x; v.y = a.y; v.z = b.x; v.w = b.y; return __builtin_bit_cast(bf16x8, v);
}
DI bf16x8 pack_pi(const f32x4 lo, const f32x4 hi) { u32x4 v; v.x = pk2(lo[0], lo[1]); v.y = pk2(lo[2], lo[3]); v.z = pk2(hi[0], hi[1]); v.w = pk2(hi[2], hi[3]); return __builtin_bit_cast(bf16x8, v); }
DI unsigned char* ck_ptr(const Frame& F, int c, int h) { return F.ws + WS_CK + ((size_t)c * RH + h) * CK_SIZE; }

constexpr int RPP = 72;
constexpr int RP_AT = 0, RP_BT = 9216, RP_KT = 18432, RP_RT = 27648, RP_BDT = 36864, RP_KDT = 46080, RP_VT = 55296, RP_LAK = 64512, RP_MRB = 73728, RP_MRK = 82944;
constexpr int RP_L = 92160, RP_CUM = RP_L + 17408, RP_TBB = RP_CUM + 17408, RP_SEG = RP_TBB + 5120, RP_END = RP_SEG + 2048;
static_assert(RP_END + 9 * 64 * 4 <= MISC_OFF, "rwkv_pre LDS");

DI void rwkv_chunk_tail(const Frame& F, unsigned char* const ck, LAS bf16* const At, LAS bf16* const Bt, LAS bf16* const Kt, LAS bf16* const Rt, LAS bf16* const BdT, LAS bf16* const KdT, LAS bf16* const VT,
                        LAS bf16* const Lak, LAS bf16* const Mrb, LAS bf16* const Mrk, LAS float* const Lm, LAS float* const Tbb) {
    const int lane = F.lane, w = F.wave, n = lane & 15, g4 = lane >> 4;
    {
        { const int p = w >> 1;
          const LAS bf16* Xs = (p & 1) ? Kt : Bt; const LAS bf16* Xt = (p & 2) ? Rt : At;
          bf16x8 bfrag[2][2], afrag[4][2];
#pragma unroll
          for (int nn = 0; nn < 2; ++nn)
#pragma unroll
              for (int ks = 0; ks < 2; ++ks) bfrag[nn][ks] = *(const LAS bf16x8*)(Xt + (16 * (2 * (w & 1) + nn) + n) * RPP + 32 * ks + 8 * g4);
#pragma unroll
          for (int ms = 0; ms < 4; ++ms)
#pragma unroll
              for (int ks = 0; ks < 2; ++ks) afrag[ms][ks] = *(const LAS bf16x8*)(Xs + (16 * ms + n) * RPP + 32 * ks + 8 * g4);
          SB();
#pragma unroll
          for (int nn = 0; nn < 2; ++nn) { const int nt = 2 * (w & 1) + nn; const int t = 16 * nt + n;
#pragma unroll
              for (int ms = 0; ms < 4; ++ms) {
                  if (ms <= nt) { f32x4 acc = {0.f, 0.f, 0.f, 0.f};
#pragma unroll
                      for (int ks = 0; ks < 2; ++ks) acc = __builtin_amdgcn_mfma_f32_16x16x32_bf16(afrag[ms][ks], bfrag[nn][ks], acc, 0, 0, 0);
#pragma unroll
                      for (int r = 0; r < 4; ++r) { const int s = 16 * ms + 4 * g4 + r; const bool keep = (p & 2) ? (s <= t) : (s < t); acc[r] = keep ? acc[r] : 0.f; }
                      if (p == 0) *(LAS f32x4*)(Lm + t * 68 + 16 * ms + 4 * g4) = acc;
                      else { LAS bf16* dst = (p == 1) ? Lak : (p == 2 ? Mrb : Mrk); u32x2 o; o.x = pk2(acc[0], acc[1]); o.y = pk2(acc[2], acc[3]); *(LAS u32x2*)(dst + t * RPP + 16 * ms + 4 * g4) = o; } } } } }
        __syncthreads();
        if (F.tid < 64) { const int b = F.tid >> 4, cc = F.tid & 15; float x[16];
#pragma unroll
            for (int t0 = 0; t0 < 16; t0 += 4) { f32x4 lr[4][4];
#pragma unroll
                for (int tt = 0; tt < 4; ++tt)
#pragma unroll
                    for (int q = 0; q < 4; ++q) if (4 * q < t0 + tt) lr[tt][q] = *(const LAS f32x4*)(Lm + (16 * b + t0 + tt) * 68 + 16 * b + 4 * q);
                SB();
#pragma unroll
                for (int tt = 0; tt < 4; ++tt) { const int t = t0 + tt; float s = (t == cc) ? 1.f : 0.f;
#pragma unroll
                    for (int s2 = 0; s2 < t; ++s2) s += lr[tt][s2 >> 2][s2 & 3] * x[s2];
                    x[t] = s; Tbb[(b * 16 + t) * 20 + cc] = s; }
                SB(); } }
        __syncthreads();
        { f32x4 rhs[4];
          if (w < 4) {
#pragma unroll
              for (int b = 0; b < 4; ++b)
#pragma unroll
                  for (int r = 0; r < 4; ++r) rhs[b][r] = bf2f(At[(16 * b + 4 * g4 + r) * RPP + 16 * w + n]);
          } else { const int vs = w - 4;
              bf16x8 vf[2];
#pragma unroll
              for (int ks = 0; ks < 2; ++ks) vf[ks] = *(const LAS bf16x8*)(VT + (16 * vs + n) * RPP + 32 * ks + 8 * g4);
#pragma unroll
              for (int b = 0; b < 4; ++b) { f32x4 acc = {0.f, 0.f, 0.f, 0.f};
#pragma unroll
                  for (int ks = 0; ks < 2; ++ks) { const bf16x8 af = *(const LAS bf16x8*)(Lak + (16 * b + n) * RPP + 32 * ks + 8 * g4); acc = __builtin_amdgcn_mfma_f32_16x16x32_bf16(af, vf[ks], acc, 0, 0, 0); }
                  rhs[b] = acc; } }
          SB();
          f32x4 X[4];
#pragma unroll
          for (int b = 0; b < 4; ++b) { f32x4 lf[3], tf;
              tf = *(const LAS f32x4*)(Tbb + (b * 16 + n) * 20 + 4 * g4);
#pragma unroll
              for (int b2 = 0; b2 < 3; ++b2) if (b2 < b) lf[b2] = *(const LAS f32x4*)(Lm + (16 * b + n) * 68 + 16 * b2 + 4 * g4);
              SB();
              f32x4 acc = rhs[b];
#pragma unroll
              for (int b2 = 0; b2 < b; ++b2) {
#pragma unroll
                  for (int q = 0; q < 4; ++q) acc = __builtin_amdgcn_mfma_f32_16x16x4f32(lf[b2][q], X[b2][q], acc, 0, 0, 0); }
              f32x4 o = {0.f, 0.f, 0.f, 0.f};
#pragma unroll
              for (int q = 0; q < 4; ++q) o = __builtin_amdgcn_mfma_f32_16x16x4f32(tf[q], acc[q], o, 0, 0, 0);
              X[b] = o;
              SB(); }
          bf16x8 xf[2]; xf[0] = pack_pi(X[0], X[1]); xf[1] = pack_pi(X[2], X[3]);
          SB();
          if (w < 4) { const int ws_ = w;
#pragma unroll
              for (int n0 = 0; n0 < 4; n0 += 2) { bf16x8 fb[2][2], fm[2][2]; u32x2 rr[2];
#pragma unroll
                  for (int nn = 0; nn < 2; ++nn) { const int nt = n0 + nn; rr[nn] = *(const LAS u32x2*)(Rt + (16 * nt + n) * RPP + 16 * ws_ + 4 * g4);
#pragma unroll
                      for (int ks = 0; ks < 2; ++ks) { fb[nn][ks] = ld_pi(BdT + (16 * nt + n) * RPP, ks, g4); fm[nn][ks] = ld_pi(Mrb + (16 * nt + n) * RPP, ks, g4); } }
                  SB();
#pragma unroll
                  for (int nn = 0; nn < 2; ++nn) { const int nt = n0 + nn;
                      f32x4 acc = {0.f, 0.f, 0.f, 0.f}, ac2 = {0.f, 0.f, 0.f, 0.f};
#pragma unroll
                      for (int ks = 0; ks < 2; ++ks) { acc = __builtin_amdgcn_mfma_f32_16x16x32_bf16(xf[ks], fb[nn][ks], acc, 0, 0, 0); ac2 = __builtin_amdgcn_mfma_f32_16x16x32_bf16(xf[ks], fm[nn][ks], ac2, 0, 0, 0); }
                      u32x2 o; o.x = pk2(acc[0], acc[1]); o.y = pk2(acc[2], acc[3]);
                      *(GAS u32x2*)(ck + CK_PL + ((size_t)((nt * 2 + (ws_ >> 1)) * 64 + lane)) * 16 + (ws_ & 1) * 8) = o;
                      ac2[0] += bflo(rr[nn].x); ac2[1] += bfhi(rr[nn].x); ac2[2] += bflo(rr[nn].y); ac2[3] += bfhi(rr[nn].y);
                      u32x2 o2; o2.x = pk2(ac2[0], ac2[1]); o2.y = pk2(ac2[2], ac2[3]);
                      *(GAS u32x2*)(ck + CK_RP + ((size_t)((nt * 2 + (ws_ >> 1)) * 64 + lane)) * 16 + (ws_ & 1) * 8) = o2; }
                  SB(); }
          } else { const int vs = w - 4;
              bf16x8 vf[2];
#pragma unroll
              for (int ks = 0; ks < 2; ++ks) vf[ks] = *(const LAS bf16x8*)(VT + (16 * vs + n) * RPP + 32 * ks + 8 * g4);
#pragma unroll
              for (int mt = 0; mt < 4; ++mt) { bf16x8 fb[2], fm[2], fk[2], fr[2];
#pragma unroll
                  for (int ks = 0; ks < 2; ++ks) { fb[ks] = ld_pi(BdT + (16 * mt + n) * RPP, ks, g4); fm[ks] = ld_pi(Mrb + (16 * mt + n) * RPP, ks, g4);
                      fk[ks] = *(const LAS bf16x8*)(KdT + (16 * mt + n) * RPP + 32 * ks + 8 * g4); fr[ks] = *(const LAS bf16x8*)(Mrk + (16 * mt + n) * RPP + 32 * ks + 8 * g4); }
                  SB();
                  f32x4 q = {0.f, 0.f, 0.f, 0.f}, o0 = {0.f, 0.f, 0.f, 0.f};
#pragma unroll
                  for (int ks = 0; ks < 2; ++ks) { q = __builtin_amdgcn_mfma_f32_16x16x32_bf16(fb[ks], xf[ks], q, 0, 0, 0); o0 = __builtin_amdgcn_mfma_f32_16x16x32_bf16(xf[ks], fm[ks], o0, 0, 0, 0);
                      q = __builtin_amdgcn_mfma_f32_16x16x32_bf16(fk[ks], vf[ks], q, 0, 0, 0); o0 = __builtin_amdgcn_mfma_f32_16x16x32_bf16(vf[ks], fr[ks], o0, 0, 0, 0); }
                  u32x2 qo; qo.x = pk2(q[0], q[1]); qo.y = pk2(q[2], q[3]);
                  *(GAS u32x2*)(ck + CK_Q + ((size_t)((vs * 4 + mt) * 64 + lane)) * 8) = qo;
                  { u32x2 oo; oo.x = pk2(o0[0], o0[1]); oo.y = pk2(o0[2], o0[3]); *(GAS u32x2*)(ck + CK_O0 + ((size_t)((vs * 4 + mt) * 64 + lane)) * 8) = oo; }
                  SB(); } } }
        __syncthreads();
    }
}

DI void x0_phase(const Frame& F, const float* x, bf16* xb, float* ssq) {
    const int gw = F.bid * 8 + F.wave, NGW = F.G * 8;
    for (int m = gw; m < M; m += NGW) {
        const GAS f32x4* xr = (const GAS f32x4*)(x + (size_t)m * D) + F.lane;
        f32x4 v[8]; float s = 0.f;
#pragma unroll
        for (int j = 0; j < 8; ++j) { v[j] = xr[64 * j]; s += (v[j].x * v[j].x + v[j].y * v[j].y) + (v[j].z * v[j].z + v[j].w * v[j].w); }
        s = wave_sum(s);
        GAS u32x2* o = (GAS u32x2*)(xb + (size_t)m * XP) + F.lane;
#pragma unroll
        for (int j = 0; j < 8; ++j) { u32x2 w; w.x = pk2(v[j].x, v[j].y); w.y = pk2(v[j].z, v[j].w); o[64 * j] = w; }
        if (F.lane < 32) ssq[(size_t)m * 32 + F.lane] = (F.lane == 0) ? s : 0.f;
    }
}
constexpr int RS_OFF = STAGE_BYTES;
static_assert(RS_OFF + 2048 * 4 <= MISC_OFF, "rstd table");
DI const LAS float* rstd_table(const Frame& F) {
    LAS float* const tab = (LAS float*)(F.lds + RS_OFF);
    const int base = (F.bid & 7) * 2048;
    const float* P = (const float*)(F.ws + WS_SSQ) + (size_t)base * 32;
    for (int r = F.tid; r < 2048; r += 512) { f32x4 p[8];
#pragma unroll
        for (int q = 0; q < 8; ++q) p[q] = ((const GAS f32x4*)(P + (size_t)r * 32))[q];
        SB();
        f32x4 t = (p[0] + p[1]) + (p[2] + p[3]) + ((p[4] + p[5]) + (p[6] + p[7]));
        tab[r] = 1.f / sqrtf(((t[0] + t[1]) + (t[2] + t[3])) * (1.f / D) + NORM_EPS);
        SB(); }
    __syncthreads();
    return tab - base;
}
constexpr size_t ALG_BYTES = (size_t)64 * AL_PITCH * 2;
template <int K, int KOFF, int L>
DI void lora_tile_g(const bf16* ALG, const bf16* Bt, LAS float* PO, int h, int mt, int np, int fr, int fq) {
    constexpr int NK = K / 32;
    bf16x8 bv[2][NK], av[NK];
    unsigned lo = (unsigned)(fr + 16 * fq) * 16u; asm volatile("" : "+v"(lo));
    const unsigned char* const ab = (const unsigned char*)ALG + (size_t)(mt * 17 + KOFF / 32) * 1024;
    const unsigned char* const bb = (const unsigned char*)Bt + (size_t)((4 * h + 2 * np) * NK) * 1024;
#pragma unroll
    for (int ks = 0; ks < NK; ++ks) { av[ks] = *(const GAS bf16x8*)(ab + ks * 1024 + lo);
#pragma unroll
        for (int nn = 0; nn < 2; ++nn) bv[nn][ks] = *(const GAS bf16x8*)(bb + (nn * NK + ks) * 1024 + lo); }
    SB();
#pragma unroll
    for (int nn = 0; nn < 2; ++nn) { const int nt = 2 * np + nn; f32x4 acc = {0.f, 0.f, 0.f, 0.f};
#pragma unroll
        for (int ks = 0; ks < NK; ++ks) acc = __builtin_amdgcn_mfma_f32_16x16x32_bf16(av[ks], bv[nn][ks], acc, 0, 0, 0);
#pragma unroll
        for (int i = 0; i < 4; ++i) PO[(L * 64 + 16 * mt + 4 * fq + i) * PO_PITCH + 16 * nt + fr] = acc[i]; }
    SB();
}
static_assert(3 * 64 * PO_PITCH * 4 <= RP_LAK && RP_END + 64 * PO_PITCH * 4 + 9 * 64 * 4 <= MISC_OFF, "the LoRA output tiles overlay only images that are rewritten for every item");

DI void rwkv_fused_phase(const Frame& F, const CAS Args& a, int l) {
    const bf16* Z = (const bf16*)(F.ws + WS_R2);
    const RwPrep P = rwprep_ptrs(F);
    LAS unsigned char* const lds = F.lds;
    LAS float* const PO = (LAS float*)lds;
    LAS float* const PO3 = (LAS float*)(lds + RP_END) - 3 * 64 * PO_PITCH;
    LAS bf16* const At = (LAS bf16*)(lds + RP_AT); LAS bf16* const Bt = (LAS bf16*)(lds + RP_BT); LAS bf16* const Kt = (LAS bf16*)(lds + RP_KT); LAS bf16* const Rt = (LAS bf16*)(lds + RP_RT);
    LAS bf16* const BdT = (LAS bf16*)(lds + RP_BDT); LAS bf16* const KdT = (LAS bf16*)(lds + RP_KDT); LAS bf16* const VT = (LAS bf16*)(lds + RP_VT);
    LAS bf16* const Lak = (LAS bf16*)(lds + RP_LAK); LAS bf16* const Mrb = (LAS bf16*)(lds + RP_MRB); LAS bf16* const Mrk = (LAS bf16*)(lds + RP_MRK);
    LAS float* const Lm = (LAS float*)(lds + RP_L); LAS float* const cum = (LAS float*)(lds + RP_CUM); LAS float* const Tbb = (LAS float*)(lds + RP_TBB); LAS float* const seg = (LAS float*)(lds + RP_SEG);
    const float* mu = a.in[14] + (size_t)l * RWCOLS;
    const float* vmu = a.in[26] + (size_t)__builtin_amdgcn_readfirstlane(l > 0 ? l - 1 : 0) * 64;
    const bf16* WLt = (const bf16*)lw(F, l, LW_WL); const bf16* ALt = (const bf16*)lw(F, l, LW_AL); const bf16* GLt = (const bf16*)lw(F, l, LW_GL); const bf16* VBt = (const bf16*)lw(F, l, LW_VB);
    bf16* const ALG = (bf16*)(F.ws + WS_ALG + (size_t)F.bid * ALG_BYTES);
    const int lane = F.lane, w = F.wave, n = lane & 15, g4 = lane >> 4;
    { unsigned zz = 0u; asm volatile("" : "+v"(zz));
      for (int q = F.tid; q < (RP_CUM - RP_LAK) / 16; q += 512) *(LAS u32x4*)(lds + RP_LAK + q * 16) = (u32x4){zz, zz, zz, zz}; }
    __syncthreads();
    for (int c = F.bid; c < NCH; c += F.G) {
        if (F.tid < 476) { int cc = F.tid % 68; asm volatile("" : "+v"(cc)); const int j = cc * 8; int r0 = F.tid / 68;
            const int zc = (j < 480) ? ZC_WIN + j : ZC_VRES + (j - 480); const float* mp = (j < 480) ? mu + (ZC_WIN - ZC_R) + j : vmu + (j - 480);
            const int kind = (j < 96) ? 0 : ((j >= 224 && j < 480) ? 2 : ((j >= 480 && l == 0) ? 3 : 1));
            const f32x4 m0 = *(const GAS f32x4*)mp, m1 = *(const GAS f32x4*)(mp + 4);
            unsigned jfo = (unsigned)((j >> 5) * 1024 + ((j & 31) >> 3) * 256); asm volatile("" : "+v"(jfo));
#define SA_LOAD(cu, pr, ib) do { _Pragma("unroll") for (int u = 0; u < 3; ++u) { const int r = r0 + 7 * (3 * (ib) + u), rr = r < 64 ? r : 63, gr = 64 * c + rr; \
                    cu[u] = *(const GAS u32x4*)(Z + (size_t)gr * ZP + zc); pr[u] = *(const GAS u32x4*)(Z + (size_t)(gr > 0 ? gr - 1 : 0) * ZP + zc); } } while (0)
#define SA_COMP(cu, pr, ib) do { _Pragma("unroll") for (int u = 0; u < 3; ++u) { const int r = r0 + 7 * (3 * (ib) + u); if (r < 64) { const int gr = 64 * c + r; \
                    float cur[8], prv[8], o[8]; unpack8(cu[u], cur); unpack8(pr[u], prv); \
                    _Pragma("unroll") for (int e = 0; e < 8; ++e) { const float pv = gr > 0 ? prv[e] : 0.f; const float mm = e < 4 ? m0[e] : m1[e - 4]; o[e] = cur[e] + (pv - cur[e]) * mm; } \
                    if (kind == 0) { _Pragma("unroll") for (int e = 0; e < 8; ++e) o[e] = 1.f - 2.f * __builtin_amdgcn_rcpf(__expf(2.f * o[e]) + 1.f); } \
                    else if (kind == 2) { _Pragma("unroll") for (int e = 0; e < 8; ++e) o[e] = sigmoidf_(o[e]); } \
                    else if (kind == 3) { _Pragma("unroll") for (int e = 0; e < 8; ++e) o[e] = 0.f; } \
                    *(GAS u32x4*)((GAS unsigned char*)ALG + (unsigned)((r >> 4) * (17 * 1024) + (r & 15) * 16) + jfo) = pack8(o); } } } while (0)
            u32x4 cuA[3], prA[3];
            for (int ib = 0; ib < 4; ++ib) {
                asm volatile("" : "+v"(r0));
                SA_LOAD(cuA, prA, ib);
                SB();
                SA_COMP(cuA, prA, ib);
                SB();
            }
#undef SA_LOAD
#undef SA_COMP
            }
        __builtin_amdgcn_fence(__ATOMIC_RELEASE, "workgroup");
        __syncthreads();
        __builtin_amdgcn_fence(__ATOMIC_ACQUIRE, "workgroup");
        float* const LWp = (float*)(F.ws + WS_R3) + (size_t)F.bid * (RH * 4096);
        bf16* const LAp = (bf16*)(F.ws + WS_R1) + (size_t)F.bid * (RH * 2 * 4096);
        { const int mt = w & 3, np = w >> 2;
          unsigned lo = (unsigned)lane * 16u; asm volatile("" : "+v"(lo));
          bf16x8 af[17];
#pragma unroll
          for (int i = 0; i < 17; ++i) af[i] = *(const GAS bf16x8*)((const unsigned char*)ALG + (size_t)(mt * 17 + i) * 1024 + lo);
          const int nch = (l > 0) ? 68 : 60;
#define LP_DMA(hh) do { LAS unsigned char* const bufd = lds + ((hh) & 1) * 69632; \
            for (int cix = w; cix < nch; cix += 8) { const unsigned char* srcp = (cix < 12) ? (const unsigned char*)WLt + (size_t)(4 * (hh) * 3 + cix) * 1024 : (cix < 28) ? (const unsigned char*)ALt + (size_t)(4 * (hh) * 4 + cix - 12) * 1024 \
                    : (cix < 60) ? (const unsigned char*)GLt + (size_t)(4 * (hh) * 8 + cix - 28) * 1024 : (const unsigned char*)VBt + (size_t)(4 * (hh) * 2 + cix - 60) * 1024; \
                __builtin_amdgcn_global_load_lds((const unsigned*)(srcp + lo), (LAS unsigned*)(bufd + cix * 1024), 16, 0, 0); } } while (0)
#define LP_TILE(NK, KO, OFF, STORE) do { \
            _Pragma("unroll") for (int nn = 0; nn < 2; ++nn) { bf16x8 bfr[NK]; \
                _Pragma("unroll") for (int ks = 0; ks < NK; ++ks) bfr[ks] = *(const LAS bf16x8*)(bufc + ((OFF) + (2 * np + nn) * (NK) + ks) * 1024 + lane * 16); \
                SB(); \
                f32x4 acc = {0.f, 0.f, 0.f, 0.f}; \
                _Pragma("unroll") for (int ks = 0; ks < NK; ++ks) acc = __builtin_amdgcn_mfma_f32_16x16x32_bf16(bfr[ks], af[(KO) + ks], acc, 0, 0, 0); \
                const int chu = 16 * (2 * np + nn); STORE; \
                SB(); } } while (0)
          LP_DMA(0);
          for (int h = 0; h < RH; ++h) {
              asm volatile("s_waitcnt vmcnt(0)" ::: "memory");
              __syncthreads();
              if (h + 1 < RH) LP_DMA(h + 1);
              const LAS unsigned char* const bufc = lds + (h & 1) * 69632;
              unsigned lof = (unsigned)(((16 * mt + n) * 64 + 4 * g4) * 2); asm volatile("" : "+v"(lof));
              LP_TILE(3, 0, 0, *(GAS f32x4*)((unsigned char*)(LWp + (size_t)h * 4096 + chu) + 2 * lof) = acc);
              LP_TILE(4, 3, 12, { u32x2 o; o.x = pk2(acc[0], acc[1]); o.y = pk2(acc[2], acc[3]); *(GAS u32x2*)((unsigned char*)(LAp + (size_t)(h * 2 + 0) * 4096 + chu) + lof) = o; });
              LP_TILE(8, 7, 28, { u32x2 o; o.x = pk2(acc[0], acc[1]); o.y = pk2(acc[2], acc[3]); *(GAS u32x2*)((unsigned char*)(P.G + ((size_t)h * M + 64 * c) * 64 + chu) + lof) = o; });
              if (l > 0) LP_TILE(2, 15, 60, { u32x2 o; o.x = pk2(acc[0], acc[1]); o.y = pk2(acc[2], acc[3]); *(GAS u32x2*)((unsigned char*)(LAp + (size_t)(h * 2 + 1) * 4096 + chu) + lof) = o; });
          }
#undef LP_DMA
#undef LP_TILE
        }
        asm volatile("s_waitcnt vmcnt(0)" ::: "memory");
        __builtin_amdgcn_fence(__ATOMIC_RELEASE, "workgroup");
        __syncthreads();
        __builtin_amdgcn_fence(__ATOMIC_ACQUIRE, "workgroup");
        { unsigned zz = 0u; asm volatile("" : "+v"(zz));
          for (int q = F.tid; q < (RP_CUM - RP_LAK) / 16; q += 512) *(LAS u32x4*)(lds + RP_LAK + q * 16) = (u32x4){zz, zz, zz, zz}; }
        __syncthreads();
        for (int h = 0; h < RH; ++h) {
            const int t = F.tid >> 3, cg = F.tid & 7, gr = 64 * c + t; int ch = h * 64 + 8 * cg;
            asm volatile("" : "+v"(ch));
            unsigned pol = (unsigned)(((size_t)h * M + gr) * 64 + 8 * cg); asm volatile("" : "+v"(pol)); const size_t po = pol;
            int hrow = h * 64 + n; asm volatile("" : "+v"(hrow));
            unsigned char* const ck = ck_ptr(F, c, h);
            u32x4 zc_[3], zp_[3];
            LAS float* const PRM = (LAS float*)(lds + RP_END + 64 * PO_PITCH * 4);
            f32x4 prmv = {0.f, 0.f, 0.f, 0.f};
            { unsigned pq = (unsigned)(F.tid < 144 ? F.tid : 0) * 16u; asm volatile("" : "+v"(pq));
              prmv = *(const GAS f32x4*)((const unsigned char*)(F.ws + WS_PRM) + (size_t)((l * RH + h) * 576) * 4 + pq); }
            f32x4 wl_[2]; u32x4 al_, vl_ = {0u, 0u, 0u, 0u}, pvfb = {0u, 0u, 0u, 0u};
            { unsigned lro = (unsigned)((h * 64 + t) * 64 + 8 * cg); asm volatile("" : "+v"(lro));
              wl_[0] = *(const GAS f32x4*)(LWp + lro); wl_[1] = *(const GAS f32x4*)(LWp + lro + 4);
              unsigned lao = (unsigned)(((h * 2) * 64 + t) * 64 + 8 * cg); asm volatile("" : "+v"(lao));
              al_ = *(const GAS u32x4*)(LAp + lao); if (l > 0) vl_ = *(const GAS u32x4*)(LAp + lao + 4096); }
            if (l > 0) pvfb = *(const GAS u32x4*)((const bf16*)P.VF + po);
#pragma unroll
            for (int which = 0; which < 3; ++which) { const int zc = (which == 0 ? ZC_R : (which == 1 ? ZC_K : ZC_V)) + ch;
                zc_[which] = *(const GAS u32x4*)(Z + (size_t)gr * ZP + zc); zp_[which] = *(const GAS u32x4*)(Z + (size_t)(gr > 0 ? gr - 1 : 0) * ZP + zc); }
            SB();
            if (F.tid < 144) *(LAS f32x4*)(PRM + 4 * F.tid) = prmv;
            asm volatile("s_waitcnt lgkmcnt(0)" ::: "memory");
            __builtin_amdgcn_s_barrier();
            SB();
            float r[8], k2[8], kk[8], bb[8], v[8], lwv[8];
            { float k[8];
#pragma unroll
              for (int which = 0; which < 3; ++which) { float cu[8], pr[8]; unpack8(zc_[which], cu); unpack8(zp_[which], pr);
#pragma unroll
                  for (int e = 0; e < 8; ++e) { const float pv = gr > 0 ? pr[e] : 0.f; const float mm = PRM[which * 64 + 8 * cg + e]; const float zs = cu[e] + (pv - cu[e]) * mm;
                      if (which == 0) r[e] = zs; else if (which == 1) k[e] = zs; else v[e] = zs; } }
              SB();
              if (l > 0) { float vpre[8], vfv[8]; unpack8(vl_, vpre); unpack8(pvfb, vfv);
#pragma unroll
                  for (int e = 0; e < 8; ++e) { const float vg = sigmoidf_(PRM[8 * 64 + 8 * cg + e] + vpre[e]); v[e] = v[e] + (vfv[e] - v[e]) * vg; } }
              *(GAS u32x4*)(P.V + po) = pack8(v);
              if (l == 0) *(GAS u32x4*)((bf16*)P.VF + po) = pack8(v);
              SB();
              { float wpre[8];
#pragma unroll
                for (int q = 0; q < 2; ++q) { wpre[4 * q] = wl_[q][0]; wpre[4 * q + 1] = wl_[q][1]; wpre[4 * q + 2] = wl_[q][2]; wpre[4 * q + 3] = wl_[q][3]; }
#pragma unroll
                for (int e = 0; e < 8; ++e) { const float wv = -softplusf_(-(PRM[3 * 64 + 8 * cg + e] + wpre[e])) - 0.5f; lwv[e] = -__expf(wv); } }
              *(LAS f32x4*)(cum + t * 68 + 8 * cg) = (f32x4){lwv[0], lwv[1], lwv[2], lwv[3]}; *(LAS f32x4*)(cum + t * 68 + 8 * cg + 4) = (f32x4){lwv[4], lwv[5], lwv[6], lwv[7]};
              SB();
              float av[8], apre[8]; float ss = 0.f, bc = 0.f;
              unpack8(al_, apre);
#pragma unroll
              for (int e = 0; e < 8; ++e) {
                  av[e] = sigmoidf_(PRM[4 * 64 + 8 * cg + e] + apre[e]);
                  kk[e] = k[e] * PRM[5 * 64 + 8 * cg + e]; ss += kk[e] * kk[e];
                  k2[e] = k[e] * (1.f + (av[e] - 1.f) * PRM[6 * 64 + 8 * cg + e]); bc += r[e] * k2[e] * PRM[7 * 64 + 8 * cg + e]; }
              ss = sum8(ss); bc = sum8(bc); const float rn = 1.f / sqrtf(fmaxf(ss, 1e-24f));
#pragma unroll
              for (int e = 0; e < 8; ++e) { kk[e] *= rn; bb[e] = kk[e] * av[e]; }
              if (cg == 0) P.BC[(size_t)h * M + gr] = bc; }
            __syncthreads();
            { const int pk_ = F.tid & 63, ptq = F.tid >> 6; float run = 0.f;
#pragma unroll
              for (int i = 0; i < 8; ++i) { run += cum[(8 * ptq + i) * 68 + pk_]; cum[(8 * ptq + i) * 68 + pk_] = run; }
              seg[ptq * 64 + pk_] = run;
              __syncthreads();
              float off = 0.f;
              for (int q = 0; q < ptq; ++q) off += seg[q * 64 + pk_];
#pragma unroll
              for (int i = 0; i < 8; ++i) cum[(8 * ptq + i) * 68 + pk_] += off; }
            __syncthreads();
            { float cmv[8], ccv[8];
              { const f32x4 c0 = *(const LAS f32x4*)(cum + t * 68 + 8 * cg), c1 = *(const LAS f32x4*)(cum + t * 68 + 8 * cg + 4), d0 = *(const LAS f32x4*)(cum + 63 * 68 + 8 * cg), d1 = *(const LAS f32x4*)(cum + 63 * 68 + 8 * cg + 4);
#pragma unroll
                for (int e = 0; e < 4; ++e) { cmv[e] = c0[e]; cmv[4 + e] = c1[e]; ccv[e] = d0[e]; ccv[4 + e] = d1[e]; } }
              float at[8], bt[8], kt[8], rt[8];
#pragma unroll
              for (int e = 0; e < 8; ++e) { const float cm = cmv[e], cC = ccv[e];
                  const float ein = __expf(cm), einv = __expf(-cm), eex = __expf(cm - lwv[e]), ed = __expf(cC - cm);
                  at[e] = -kk[e] * eex; bt[e] = bb[e] * einv; kt[e] = k2[e] * einv; rt[e] = r[e] * ein;
                  const unsigned pbd = pk2(bb[e] * ed, k2[e] * ed);
                  BdT[(8 * cg + e) * RPP + t] = (bf16)(pbd & 0xffffu); KdT[(8 * cg + e) * RPP + t] = (bf16)(pbd >> 16);
                  VT[(8 * cg + e) * RPP + t] = (bf16)(pk2(v[e], 0.f) & 0xffffu); }
              *(LAS u32x4*)(At + t * RPP + 8 * cg) = pack8(at); *(LAS u32x4*)(Bt + t * RPP + 8 * cg) = pack8(bt); *(LAS u32x4*)(Kt + t * RPP + 8 * cg) = pack8(kt); *(LAS u32x4*)(Rt + t * RPP + 8 * cg) = pack8(rt);
              if (F.tid < 64) ((GAS float*)(ck + CK_GC))[F.tid] = __expf(cum[63 * 68 + F.tid]); }
            __syncthreads();
            rwkv_chunk_tail(F, ck, At, Bt, Kt, Rt, BdT, KdT, VT, Lak, Mrb, Mrk, Lm, Tbb);
        }
    }
}

constexpr int SC_SLOT = 8192 + 2048 + 512, SC_NS = 14;
static_assert(SC_NS * SC_SLOT <= MISC_OFF, "scan ring");
DI void rwkv_scan_phase(const Frame& F, int h, int vs) {
    LAS unsigned char* const lds = F.lds;
    const int lane = F.lane, w = F.wave, g4 = lane >> 4;
    if (w >= 4) {
        const int lw_ = w - 4;
#define SC_DMA(cc) do { const int cq_ = (cc) < NCH ? (cc) : NCH - 1; const unsigned char* ck_ = ck_ptr(F, cq_, h); LAS unsigned char* sl_ = lds + ((cc) % SC_NS) * SC_SLOT; \
            _Pragma("unroll") for (int i_ = 0; i_ < 2; ++i_) __builtin_amdgcn_global_load_lds((const unsigned*)(ck_ + CK_PL + (size_t)((lw_ * 2 + i_) * 64 + lane) * 16), (LAS unsigned*)(sl_ + (lw_ * 2 + i_) * 1024), 16, 0, 0); \
            if (lw_ < 2) __builtin_amdgcn_global_load_lds((const unsigned*)(ck_ + CK_Q + (size_t)vs * 2048 + (size_t)(lw_ * 64 + lane) * 16), (LAS unsigned*)(sl_ + 8192 + lw_ * 1024), 16, 0, 0); \
            else __builtin_amdgcn_global_load_lds((const unsigned*)(ck_ + CK_GC + (size_t)lane * 4), (LAS unsigned*)(sl_ + 10240 + (lw_ - 2) * 256), 4, 0, 0); } while (0)
        for (int cc = 0; cc < SC_NS - 1; ++cc) SC_DMA(cc);
        asm volatile("s_waitcnt vmcnt(33)" ::: "memory");
        __builtin_amdgcn_s_barrier();
        for (int c = 0; c < NCH; ++c) {
            SC_DMA(c + SC_NS - 1);
            asm volatile("s_waitcnt vmcnt(33)" ::: "memory");
            __builtin_amdgcn_s_barrier();
        }
#undef SC_DMA
    } else if (w == 0) {
        f32x4 Hf[4];
#pragma unroll
        for (int mt = 0; mt < 4; ++mt) Hf[mt] = (f32x4){0.f, 0.f, 0.f, 0.f};
        __builtin_amdgcn_s_barrier();
        f32x4 gqA[4], gqB[4]; u32x2 qqA[4], qqB[4]; bf16x8 pfA[4][2], pfB[4][2];
#define SC_LDS(cc, gq, qq, pf) do { const LAS unsigned char* sl = lds + ((cc) % SC_NS) * SC_SLOT; \
            _Pragma("unroll") for (int mt = 0; mt < 4; ++mt) { gq[mt] = *(const LAS f32x4*)(sl + 10240 + (16 * mt + 4 * g4) * 4); qq[mt] = *(const LAS u32x2*)(sl + 8192 + (size_t)(mt * 64 + lane) * 8); \
                _Pragma("unroll") for (int ks = 0; ks < 2; ++ks) pf[mt][ks] = *(const LAS bf16x8*)(sl + (size_t)((mt * 2 + ks) * 64 + lane) * 16); } } while (0)
#define SC_STEP(c, gq, qq, pf, gqn, qqn, pfn) do { \
            SC_LDS((c) + 1, gqn, qqn, pfn); SB(); \
            f32x4 acc[4]; \
            bf16x8 hb[2]; hb[0] = pack_pi(Hf[0], Hf[1]); hb[1] = pack_pi(Hf[2], Hf[3]); \
            unsigned char* ck = ck_ptr(F, (c), h); \
            _Pragma("unroll") for (int ks = 0; ks < 2; ++ks) *(GAS bf16x8*)(ck + CK_H + (size_t)((vs * 2 + ks) * 64 + lane) * 16) = hb[ks]; \
            _Pragma("unroll") for (int mt = 0; mt < 4; ++mt) { const f32x4 qf = {bflo(qq[mt].x), bfhi(qq[mt].x), bflo(qq[mt].y), bfhi(qq[mt].y)}; acc[mt] = gq[mt] * Hf[mt] + qf; } \
            _Pragma("unroll") for (int ks = 0; ks < 2; ++ks) \
                _Pragma("unroll") for (int mt = 0; mt < 4; ++mt) acc[mt] = __builtin_amdgcn_mfma_f32_16x16x32_bf16(pf[mt][ks], hb[ks], acc[mt], 0, 0, 0); \
            _Pragma("unroll") for (int mt = 0; mt < 4; ++mt) Hf[mt] = acc[mt]; \
            SB(); \
            asm volatile("s_waitcnt lgkmcnt(0)" ::: "memory"); \
            __builtin_amdgcn_s_barrier(); } while (0)
        SC_LDS(0, gqA, qqA, pfA);
        for (int c = 0; c < NCH; c += 2) {
            SC_STEP(c, gqA, qqA, pfA, gqB, qqB, pfB);
            SC_STEP(c + 1, gqB, qqB, pfB, gqA, qqA, pfA);
        }
#undef SC_STEP
#undef SC_LDS
    } else {
        for (int c = 0; c <= NCH; ++c) __builtin_amdgcn_s_barrier();
    }
}

DI float sum16(float v) { v += __builtin_bit_cast(float, __builtin_amdgcn_update_dpp(0, __builtin_bit_cast(int, v), 0xB1, 0xF, 0xF, true));
                          v += __builtin_bit_cast(float, __builtin_amdgcn_update_dpp(0, __builtin_bit_cast(int, v), 0x4E, 0xF, 0xF, true));
                          v += __builtin_bit_cast(float, __builtin_amdgcn_update_dpp(0, __builtin_bit_cast(int, v), 0x141, 0xF, 0xF, true));
                          v += __builtin_bit_cast(float, __builtin_amdgcn_update_dpp(0, __builtin_bit_cast(int, v), 0x140, 0xF, 0xF, true)); return v; }
DI void rwkv_post_phase(const Frame& F, const CAS Args& a, int l) {
    const RwPrep P = rwprep_ptrs(F);
    bf16* ycat = (bf16*)(F.ws + WS_R3);
    const int lane = F.lane, n = lane & 15, g4 = lane >> 4;
    const int gw = F.bid * 8 + F.wave, NGW = F.G * 8;
#define XSUM(v) do { v += __builtin_bit_cast(float, __builtin_amdgcn_ds_bpermute(a16, __builtin_bit_cast(int, v))); v += __builtin_bit_cast(float, __builtin_amdgcn_ds_bpermute(a32, __builtin_bit_cast(int, v))); } while (0)
    for (int it = gw; it < NCH * RH * 4; it += NGW) {
        const int mt = it & 3, ch_ = it >> 2, c = ch_ / RH, h = ch_ - c * RH;
        const unsigned char* ck = ck_ptr(F, c, h);
        bf16x8 af[2], hf[4][2]; f32x4 acc[4], lw4[4], lb4[4]; u32x2 vv[4], gg[4];
        const int t = 64 * c + 16 * mt + n; const size_t po = ((size_t)h * M + t) * 64 + 4 * g4;
        int a16 = (lane ^ 16) << 2, a32 = (lane ^ 32) << 2; asm volatile("" : "+v"(a16), "+v"(a32));
#pragma unroll
        for (int ks = 0; ks < 2; ++ks) af[ks] = *(const GAS bf16x8*)(ck + CK_RP + (size_t)((mt * 2 + ks) * 64 + lane) * 16);
#pragma unroll
        for (int nt = 0; nt < 4; ++nt) { { const u32x2 oo = *(const GAS u32x2*)(ck + CK_O0 + (size_t)((nt * 4 + mt) * 64 + lane) * 8); acc[nt] = (f32x4){bflo(oo.x), bfhi(oo.x), bflo(oo.y), bfhi(oo.y)}; }
#pragma unroll
            for (int ks = 0; ks < 2; ++ks) hf[nt][ks] = *(const GAS bf16x8*)(ck + CK_H + (size_t)((nt * 2 + ks) * 64 + lane) * 16);
            vv[nt] = *(const GAS u32x2*)(P.V + po + 16 * nt); gg[nt] = *(const GAS u32x2*)(P.G + po + 16 * nt); }
        const float bcv = P.BC[(size_t)h * M + t];
#pragma unroll
        for (int nt = 0; nt < 4; ++nt) { lw4[nt] = *(const GAS f32x4*)(a.in[23] + (size_t)l * RW + h * 64 + 16 * nt + 4 * g4); lb4[nt] = *(const GAS f32x4*)(a.in[24] + (size_t)l * RW + h * 64 + 16 * nt + 4 * g4); }
        SB();
#pragma unroll
        for (int nt = 0; nt < 4; ++nt)
#pragma unroll
            for (int ks = 0; ks < 2; ++ks) acc[nt] = __builtin_amdgcn_mfma_f32_16x16x32_bf16(hf[nt][ks], af[ks], acc[nt], 0, 0, 0);
        float s = 0.f;
#pragma unroll
        for (int nt = 0; nt < 4; ++nt) s += (acc[nt][0] + acc[nt][1]) + (acc[nt][2] + acc[nt][3]);
        XSUM(s); const float mean = s * (1.f / 64.f);
        float vs = 0.f;
#pragma unroll
        for (int nt = 0; nt < 4; ++nt)
#pragma unroll
            for (int r = 0; r < 4; ++r) { const float d = acc[nt][r] - mean; vs += d * d; }
        XSUM(vs); const float rstd = 1.f / sqrtf(vs * (1.f / 64.f) + 64e-5f);
#pragma unroll
        for (int nt = 0; nt < 4; ++nt) { const float v0 = bflo(vv[nt].x), v1 = bfhi(vv[nt].x), v2 = bflo(vv[nt].y), v3 = bfhi(vv[nt].y), g0 = bflo(gg[nt].x), g1 = bfhi(gg[nt].x), g2 = bflo(gg[nt].y), g3 = bfhi(gg[nt].y);
            const float y0 = ((acc[nt][0] - mean) * rstd * lw4[nt][0] + lb4[nt][0] + bcv * v0) * g0, y1 = ((acc[nt][1] - mean) * rstd * lw4[nt][1] + lb4[nt][1] + bcv * v1) * g1;
            const float y2 = ((acc[nt][2] - mean) * rstd * lw4[nt][2] + lb4[nt][2] + bcv * v2) * g2, y3 = ((acc[nt][3] - mean) * rstd * lw4[nt][3] + lb4[nt][3] + bcv * v3) * g3;
            u32x2 o; o.x = pk2(y0, y1); o.y = pk2(y2, y3);
            *(GAS u32x2*)(ycat + (size_t)t * D + S5W + h * 64 + 16 * nt + 4 * g4) = o; }
    }
#undef XSUM
}
constexpr size_t GK_E = 0, GK_H = 32768, GK_GC = 49152, GK_SIZE = 49408;
DI unsigned char* gk_ptr(const Frame& F, int c, int h) { return F.ws + WS_GK + ((size_t)c * GH + h) * GK_SIZE; }
constexpr int GP_CUM = 0, GP_SEG = 17408, GP_KDT = GP_SEG + 2048, GP_VT = GP_KDT + 9216, GP_QT = GP_VT + 18432, GP_KT = GP_QT + 9216, GP_ATT = GP_KT + 9216, GP_PART = GP_ATT + 9216, GP_END = GP_PART + 2048;
static_assert(GP_END <= MISC_OFF, "gla LDS");

DI void gla_store_vt(const Frame& F, const u32x4 (&rv)[2], LAS bf16* VT) {
#pragma unroll
    for (int half = 0; half < 2; ++half) { const int t = F.tid >> 3, v0 = 64 * half + 8 * (F.tid & 7); float f[8]; unpack8(rv[half], f);
#pragma unroll
        for (int e = 0; e < 8; ++e) VT[(v0 + e) * RPP + t] = (bf16)(pk2(f[e], 0.f) & 0xffffu); }
}
DI void gla_pre_phase(const Frame& F, const CAS Args& a, int l) {
    const bf16* Z = (const bf16*)(F.ws + WS_R2);
    LAS float* const cum = (LAS float*)(F.lds + GP_CUM); LAS float* const seg = (LAS float*)(F.lds + GP_SEG);
    LAS bf16* const KdT = (LAS bf16*)(F.lds + GP_KDT); LAS bf16* const VT = (LAS bf16*)(F.lds + GP_VT);
    const int lane = F.lane, w = F.wave, n = lane & 15, g4 = lane >> 4;
    const int t = F.tid >> 3, cg = F.tid & 7;
    u32x4 rv[2], rk, rq, ra0, ra1;
#define GP_LOADZ(itx) do { const int c_ = (itx) / GH, h_ = (itx) - c_ * GH; const bf16* zr_ = Z + (size_t)(64 * c_ + t) * ZP; \
        rv[0] = *(const GAS u32x4*)(zr_ + ZC_GV + h_ * 128 + 8 * cg); rv[1] = *(const GAS u32x4*)(zr_ + ZC_GV + h_ * 128 + 64 + 8 * cg); \
        rk = *(const GAS u32x4*)(zr_ + ZC_GKK + h_ * 64 + 8 * cg); rq = *(const GAS u32x4*)(zr_ + ZC_GQ + h_ * 64 + 8 * cg); \
        ra0 = *(const GAS u32x4*)(zr_ + ZC_GA); ra1 = *(const GAS u32x4*)(zr_ + ZC_GA + 8); } while (0)
    if (F.bid < NCH * GH) GP_LOADZ(F.bid);
    for (int it = F.bid; it < NCH * GH; it += F.G) {
        const int c = it / GH, h = it - c * GH;
        unsigned char* const gk = gk_ptr(F, c, h);
        unsigned char* const qkimg = F.ws + WS_GQK + (size_t)it * 16384; unsigned char* const vimg = F.ws + WS_GVP + (size_t)it * 16384;
        { const float* alora = a.in[29] + (size_t)l * 16 * GK + h * 64 + 8 * cg; const float* abias = a.in[30] + (size_t)l * GK + h * 64 + 8 * cg;
          const f32x4 b0 = *(const GAS f32x4*)abias, b1 = *(const GAS f32x4*)(abias + 4);
          f32x4 w0[16], w1[16];
#pragma unroll
          for (int j = 0; j < 16; ++j) { w0[j] = *(const GAS f32x4*)(alora + (size_t)j * GK); w1[j] = *(const GAS f32x4*)(alora + (size_t)j * GK + 4); }
          SB();
          float ain[16]; { float f0[8], f1[8]; unpack8(ra0, f0); unpack8(ra1, f1);
#pragma unroll
              for (int e = 0; e < 8; ++e) { ain[e] = f0[e]; ain[8 + e] = f1[e]; } }
          float x[8]; x[0] = b0[0]; x[1] = b0[1]; x[2] = b0[2]; x[3] = b0[3]; x[4] = b1[0]; x[5] = b1[1]; x[6] = b1[2]; x[7] = b1[3];
#pragma unroll
          for (int j = 0; j < 16; ++j) {
#pragma unroll
              for (int e = 0; e < 4; ++e) { x[e] += ain[j] * w0[j][e]; x[4 + e] += ain[j] * w1[j][e]; } }
          f32x4 o0, o1;
#pragma unroll
          for (int e = 0; e < 4; ++e) { o0[e] = -softplusf_(-x[e]) * (1.f / 16.f); o1[e] = -softplusf_(-x[4 + e]) * (1.f / 16.f); }
          *(LAS f32x4*)(cum + t * 68 + 8 * cg) = o0; *(LAS f32x4*)(cum + t * 68 + 8 * cg + 4) = o1; }
        __syncthreads();
        { const int k = F.tid & 63, tq = F.tid >> 6; float run = 0.f;
#pragma unroll
          for (int i = 0; i < 8; ++i) { run += cum[(8 * tq + i) * 68 + k]; cum[(8 * tq + i) * 68 + k] = run; }
          seg[tq * 64 + k] = run;
          __syncthreads();
          float off = 0.f;
          for (int q = 0; q < tq; ++q) off += seg[q * 64 + k];
#pragma unroll
          for (int i = 0; i < 8; ++i) cum[(8 * tq + i) * 68 + k] += off; }
        __syncthreads();
        { float kf[8], qf[8]; unpack8(rk, kf); unpack8(rq, qf);
          const f32x4 c0 = *(const LAS f32x4*)(cum + t * 68 + 8 * cg), c1 = *(const LAS f32x4*)(cum + t * 68 + 8 * cg + 4), d0 = *(const LAS f32x4*)(cum + 63 * 68 + 8 * cg), d1 = *(const LAS f32x4*)(cum + 63 * 68 + 8 * cg + 4);
          float qt[8], kt[8];
#pragma unroll
          for (int e = 0; e < 8; ++e) { const float cm = (e < 4 ? c0[e] : c1[e - 4]); const float ed = __expf((e < 4 ? d0[e] : d1[e - 4]) - cm); KdT[(8 * cg + e) * RPP + t] = (bf16)(pk2(kf[e] * ed, 0.f) & 0xffffu);
              qt[e] = qf[e] * 0.125f * __expf(cm); kt[e] = kf[e] * __expf(-cm); }
          { const int q3 = cg & 3; unsigned char* const qd = qkimg + (size_t)((((t >> 4) * 2 + (cg >> 2)) * 64 + (2 * (q3 & 1)) * 16 + (t & 15)) * 16 + (q3 >> 1) * 8);
            u32x2 o; o.x = pk2(qt[0], qt[1]); o.y = pk2(qt[2], qt[3]); *(GAS u32x2*)qd = o; o.x = pk2(qt[4], qt[5]); o.y = pk2(qt[6], qt[7]); *(GAS u32x2*)(qd + 256) = o;
            o.x = pk2(kt[0], kt[1]); o.y = pk2(kt[2], kt[3]); *(GAS u32x2*)(qd + 8192) = o; o.x = pk2(kt[4], kt[5]); o.y = pk2(kt[6], kt[7]); *(GAS u32x2*)(qd + 8192 + 256) = o; }
          if (F.tid < 64) ((GAS float*)(gk + GK_GC))[F.tid] = __expf(cum[63 * 68 + F.tid]); }
        gla_store_vt(F, rv, VT);
        SB();
        { const int itn = it + F.G; if (itn < NCH * GH) GP_LOADZ(itn); }
        SB();
        asm volatile("s_waitcnt lgkmcnt(0)" ::: "memory"); __builtin_amdgcn_s_barrier(); SB();
        { bf16x8 vf[2], kf_[4][2];
#pragma unroll
          for (int ks = 0; ks < 2; ++ks) { *(GAS bf16x8*)(vimg + (size_t)((w * 2 + ks) * 64 + lane) * 16) = ld_pi(VT + (16 * w + n) * RPP, ks, g4);
              vf[ks] = *(const LAS bf16x8*)(VT + (16 * w + n) * RPP + 32 * ks + 8 * g4);
#pragma unroll
              for (int mt = 0; mt < 4; ++mt) kf_[mt][ks] = *(const LAS bf16x8*)(KdT + (16 * mt + n) * RPP + 32 * ks + 8 * g4); }
          SB();
#pragma unroll
          for (int mt = 0; mt < 4; ++mt) { f32x4 acc = {0.f, 0.f, 0.f, 0.f};
#pragma unroll
              for (int ks = 0; ks < 2; ++ks) acc = __builtin_amdgcn_mfma_f32_16x16x32_bf16(kf_[mt][ks], vf[ks], acc, 0, 0, 0);
              *(GAS f32x4*)(gk + GK_E + (size_t)((w * 4 + mt) * 64 + lane) * 16) = acc; } }
        asm volatile("s_waitcnt lgkmcnt(0)" ::: "memory"); __builtin_amdgcn_s_barrier(); SB();
    }
#undef GP_LOADZ
}
DI void gla_scan_wave(const Frame& F, int item) {
    const int mt = item & 3, vs = (item >> 2) & 7, h = item >> 5;
    const int lane = F.lane, g4 = lane >> 4;
    f32x4 H = {0.f, 0.f, 0.f, 0.f};
    constexpr int U = 16;
    for (int c0 = 0; c0 < NCH; c0 += U) {
        f32x4 e[U], g[U];
#pragma unroll
        for (int u = 0; u < U; ++u) { const unsigned char* gk = gk_ptr(F, c0 + u, h); e[u] = *(const GAS f32x4*)(gk + GK_E + (size_t)((vs * 4 + mt) * 64 + lane) * 16); g[u] = *(const GAS f32x4*)(gk + GK_GC + (16 * mt + 4 * g4) * 4); }
        SB();
#pragma unroll
        for (int u = 0; u < U; ++u) { unsigned char* gk = gk_ptr(F, c0 + u, h);
            u32x2 o; o.x = pk2(H[0], H[1]); o.y = pk2(H[2], H[3]);
            *(GAS u32x2*)(gk + GK_H + (size_t)((vs * 2 + (mt >> 1)) * 64 + lane) * 16 + (mt & 1) * 8) = o;
            H = g[u] * H + e[u]; }
    }
}
#define GLDU(T, ubase, loff) (*(const GAS T*)((const unsigned char*)(ubase) + (loff)))
DI void gla_post_item(const Frame& F, const CAS Args& a, int l, int item) {
    const bf16* Z = (const bf16*)(F.ws + WS_R2);
    bf16* ycat = (bf16*)(F.ws + WS_R3);
    const int lane = F.lane, n = lane & 15, g4 = lane >> 4;
    const int mt = item & 3, ch_ = item >> 2, c = ch_ / GH, h = ch_ - c * GH;
    const unsigned char* const gk = gk_ptr(F, c, h) + GK_H;
    const unsigned char* const qk = F.ws + WS_GQK + (size_t)ch_ * 16384;
    const unsigned char* const vp = F.ws + WS_GVP + (size_t)ch_ * 16384;
    unsigned lo16 = (unsigned)lane * 16u; asm volatile("" : "+v"(lo16));
    bf16x8 qf[2], kf[4][2], hA[4][2], vA[4][2];
#pragma unroll
    for (int ks = 0; ks < 2; ++ks) qf[ks] = GLDU(bf16x8, qk + (mt * 2 + ks) * 1024, lo16);
#pragma unroll
    for (int ms = 0; ms < 4; ++ms)
#pragma unroll
        for (int ks = 0; ks < 2; ++ks) kf[ms][ks] = GLDU(bf16x8, qk + 8192 + (ms * 2 + ks) * 1024, lo16);
#pragma unroll
    for (int vt = 0; vt < 4; ++vt)
#pragma unroll
        for (int ks = 0; ks < 2; ++ks) { hA[vt][ks] = GLDU(bf16x8, gk + (vt * 2 + ks) * 1024, lo16); vA[vt][ks] = GLDU(bf16x8, vp + (vt * 2 + ks) * 1024, lo16); }
    SB();
    bf16x8 Pb[2];
    { f32x4 att[4];
#pragma unroll
      for (int ms = 0; ms < 4; ++ms) { att[ms] = (f32x4){0.f, 0.f, 0.f, 0.f};
          if (ms <= mt) {
#pragma unroll
              for (int ks = 0; ks < 2; ++ks) att[ms] = __builtin_amdgcn_mfma_f32_16x16x32_bf16(kf[ms][ks], qf[ks], att[ms], 0, 0, 0);
              if (ms == mt) {
#pragma unroll
                  for (int r = 0; r < 4; ++r) att[ms][r] = ((4 * g4 + r) <= n) ? att[ms][r] : 0.f; } } }
      Pb[0] = pack_pi(att[0], att[1]); Pb[1] = pack_pi(att[2], att[3]); }
    SB();
    bf16x8 hB[4][2], vB[4][2]; u32x2 gzr[8];
    const int tl = 64 * c + 16 * mt + n;
#pragma unroll
    for (int vt = 0; vt < 4; ++vt)
#pragma unroll
        for (int ks = 0; ks < 2; ++ks) { hB[vt][ks] = GLDU(bf16x8, gk + ((vt + 4) * 2 + ks) * 1024, lo16); vB[vt][ks] = GLDU(bf16x8, vp + ((vt + 4) * 2 + ks) * 1024, lo16); }
#pragma unroll
    for (int vt = 0; vt < 8; ++vt) gzr[vt] = *(const GAS u32x2*)(Z + (size_t)tl * ZP + ZC_GG + h * 128 + 16 * vt + 4 * g4);
    SB();
    f32x4 acc[8];
#pragma unroll
    for (int vt = 0; vt < 4; ++vt) { acc[vt] = (f32x4){0.f, 0.f, 0.f, 0.f};
#pragma unroll
        for (int ks = 0; ks < 2; ++ks) acc[vt] = __builtin_amdgcn_mfma_f32_16x16x32_bf16(hA[vt][ks], qf[ks], acc[vt], 0, 0, 0);
        acc[vt] = __builtin_amdgcn_mfma_f32_16x16x32_bf16(vA[vt][0], Pb[0], acc[vt], 0, 0, 0);
        if (mt >= 2) acc[vt] = __builtin_amdgcn_mfma_f32_16x16x32_bf16(vA[vt][1], Pb[1], acc[vt], 0, 0, 0); }
    SB();
#pragma unroll
    for (int vt = 0; vt < 4; ++vt) { acc[4 + vt] = (f32x4){0.f, 0.f, 0.f, 0.f};
#pragma unroll
        for (int ks = 0; ks < 2; ++ks) acc[4 + vt] = __builtin_amdgcn_mfma_f32_16x16x32_bf16(hB[vt][ks], qf[ks], acc[4 + vt], 0, 0, 0);
        acc[4 + vt] = __builtin_amdgcn_mfma_f32_16x16x32_bf16(vB[vt][0], Pb[0], acc[4 + vt], 0, 0, 0);
        if (mt >= 2) acc[4 + vt] = __builtin_amdgcn_mfma_f32_16x16x32_bf16(vB[vt][1], Pb[1], acc[4 + vt], 0, 0, 0); }
    SB();
    f32x4 ngv[8];
    { const float* ngp = a.in[31] + (size_t)l * GV + h * 128 + 4 * g4;
#pragma unroll
      for (int vt = 0; vt < 8; ++vt) ngv[vt] = *(const GAS f32x4*)(ngp + 16 * vt); }
    float ss = 0.f;
#pragma unroll
    for (int vt = 0; vt < 8; ++vt)
#pragma unroll
        for (int r = 0; r < 4; ++r) ss += acc[vt][r] * acc[vt][r];
    { int a16 = (lane ^ 16) << 2, a32 = (lane ^ 32) << 2; asm volatile("" : "+v"(a16), "+v"(a32));
      ss += __builtin_bit_cast(float, __builtin_amdgcn_ds_bpermute(a16, __builtin_bit_cast(int, ss)));
      ss += __builtin_bit_cast(float, __builtin_amdgcn_ds_bpermute(a32, __builtin_bit_cast(int, ss))); }
    const float rn = 1.f / sqrtf(ss * (1.f / 128.f) + NORM_EPS);
    SB();
#pragma unroll
    for (int vt = 0; vt < 8; ++vt) { const float g0 = bflo(gzr[vt].x), g1 = bfhi(gzr[vt].x), g2 = bflo(gzr[vt].y), g3 = bfhi(gzr[vt].y);
        const float y0 = acc[vt][0] * rn * ngv[vt][0] * g0 * sigmoidf_(g0), y1 = acc[vt][1] * rn * ngv[vt][1] * g1 * sigmoidf_(g1);
        const float y2 = acc[vt][2] * rn * ngv[vt][2] * g2 * sigmoidf_(g2), y3 = acc[vt][3] * rn * ngv[vt][3] * g3 * sigmoidf_(g3);
        u32x2 o; o.x = pk2(y0, y1); o.y = pk2(y2, y3);
        *(GAS u32x2*)(ycat + (size_t)tl * D + S5W + RW + h * 128 + 16 * vt + 4 * g4) = o; }
}
DI void gla_post_phase(const Frame& F, const CAS Args& a, int l) {
    constexpr int NIT = NCH * GH * 4;
    const int NGW = F.G * 8, rounds = NIT / NGW, rem = NIT - rounds * NGW, per = rem / F.G, left = rem - per * F.G;
    const int wv = __builtin_amdgcn_readfirstlane(F.wave);
    for (int r = 0; r < rounds; ++r) gla_post_item(F, a, l, r * NGW + F.bid * 8 + wv);
    if (wv < per) gla_post_item(F, a, l, rounds * NGW + F.bid * per + wv);
    else if (wv == per && F.bid < left) gla_post_item(F, a, l, rounds * NGW + F.G * per + F.bid);
}
constexpr size_t ALG_BYTES_C = (size_t)64 * 552 * 2;
constexpr size_t S5T_G = 0, S5T_K = 32768, S5T_F = 65536, S5T_L8 = 98304, S5T_LN = 98816, S5T_PN = 99328, S5T_SIZE = 99328 + 8192;
constexpr size_t WS_S5X = WS_S5XA;
static_assert(256 * ALG_BYTES_C <= SZ_HB && (size_t)DEPTH * 48 * S5T_SIZE <= 2 * SZ_HB && WS_S5TA >= WS_R4 + 3 * SZ_HB, "scratch overlays");
constexpr int S5_TW = 0, S5_X0 = 2 * 8 * 128 * 4, S5_END = S5_X0 + 2 * 128 * 4;
static_assert(S5_END <= MISC_OFF, "s5 LDS");

DI void s5_tables(const Frame& F, const CAS Args& a, int l, int g) {
    LAS float* PWr = (LAS float*)F.lds;
    LAS float* PWi = PWr + 9 * 64;
    LAS float* Bbr = PWi + 9 * 64;
    LAS float* Bbi = Bbr + 1024;
    LAS float* Cr = Bbi + 1024;
    LAS float* Ci = Cr + 1024;
    LAS float* Kt = Ci + 1024;
    unsigned char* tb = F.ws + WS_S5TA + ((size_t)l * S5G + g) * S5T_SIZE;
    if (F.tid < 64) { const int p = F.tid; const size_t gp = ((size_t)l * S5G + g) * S5P + p;
        const float lre = fminf(a.in[4][gp], -1e-4f), lim = a.in[5][gp], dt = expf(a.in[6][(size_t)l * S5G + g]);
        const float er = expf(lre * dt); float sn, cs; sincosf(lim * dt, &sn, &cs);
        const float lbr = er * cs, lbi = er * sn;
        const float nr = lbr - 1.f, ni = lbi, den = 1.f / (lre * lre + lim * lim);
        const float fr_ = (nr * lre + ni * lim) * den, fi_ = (ni * lre - nr * lim) * den;
#pragma unroll
        for (int jj = 0; jj < 16; ++jj) { const float br = a.in[7][gp * 16 + jj], bi = a.in[8][gp * 16 + jj]; Bbr[p * 16 + jj] = fr_ * br - fi_ * bi; Bbi[p * 16 + jj] = fr_ * bi + fi_ * br; }
        float pr = 1.f, pi = 0.f;
#pragma unroll
        for (int nn = 0; nn < 9; ++nn) { PWr[nn * 64 + p] = pr; PWi[nn * 64 + p] = pi; const float t0 = pr * lbr - pi * lbi, t1 = pr * lbi + pi * lbr; pr = t0; pi = t1; }
        float qr = PWr[8 * 64 + p], qi = PWi[8 * 64 + p];
        ((GAS float*)(tb + S5T_L8))[p] = qr; ((GAS float*)(tb + S5T_L8))[64 + p] = qi;
        { float ur = 1.f, ui = 0.f;
#pragma unroll
          for (int nn = 0; nn < 16; ++nn) { ((GAS float*)(tb + S5T_PN))[nn * 128 + p] = ur; ((GAS float*)(tb + S5T_PN))[nn * 128 + 64 + p] = ui; const float t0 = ur * qr - ui * qi, t1 = ur * qi + ui * qr; ur = t0; ui = t1; } }
#pragma unroll
        for (int s = 0; s < 7; ++s) { const float t0 = qr * qr - qi * qi, t1 = 2.f * qr * qi; qr = t0; qi = t1; }
        ((GAS float*)(tb + S5T_LN))[p] = qr; ((GAS float*)(tb + S5T_LN))[64 + p] = qi; }
    for (int q = F.tid; q < 1024; q += 512) { const int i = q >> 6, pp = q & 63; const size_t ci = (((size_t)l * S5G + g) * 16 + i) * S5P + pp; Cr[q] = a.in[9][ci]; Ci[q] = a.in[10][ci]; }
    __syncthreads();
    { const int tau = F.tid >> 6, i = (F.tid >> 2) & 15, j0 = (F.tid & 3) * 4; float s[4] = {0.f, 0.f, 0.f, 0.f};
      for (int p = 0; p < 64; ++p) { const float cr = Cr[i * 64 + p], ci = Ci[i * 64 + p], wr = PWr[tau * 64 + p], wi = PWi[tau * 64 + p];
          const float mr = cr * wr - ci * wi, mi = cr * wi + ci * wr;
#pragma unroll
          for (int e = 0; e < 4; ++e) s[e] += mr * Bbr[p * 16 + j0 + e] - mi * Bbi[p * 16 + j0 + e]; }
#pragma unroll
      for (int e = 0; e < 4; ++e) Kt[(tau * 16 + i) * 16 + j0 + e] = s[e]; }
    __syncthreads();
    { const int row = F.tid >> 2, c0 = (F.tid & 3) * 32;
#pragma unroll
      for (int q8 = 0; q8 < 4; ++q8) { float gv[8], kv[8], fv[8];
#pragma unroll
          for (int e = 0; e < 8; ++e) { const int col = c0 + 8 * q8 + e;
              { const int p = row & 63, part = row >> 6, b = col >> 4, j = col & 15; const float wr = PWr[(7 - b) * 64 + p], wi = PWi[(7 - b) * 64 + p], br = Bbr[p * 16 + j], bi = Bbi[p * 16 + j];
                gv[e] = part == 0 ? (wr * br - wi * bi) : (wr * bi + wi * br); }
              { const int bt = row >> 4, i = row & 15, bs = col >> 4, j = col & 15; kv[e] = (bs <= bt) ? Kt[((bt - bs) * 16 + i) * 16 + j] : 0.f; }
              { const int b = row >> 4, i = row & 15; const int pks = col >> 5, pkg = (col >> 3) & 3, pj = col & 7, pp = 16 * (2 * pks + (pj >> 2)) + 4 * pkg + (pj & 3);
                const int p = pp & 63, part = pp >> 6; const float cr = Cr[i * 64 + p], ci = Ci[i * 64 + p], wr = PWr[(b + 1) * 64 + p], wi = PWi[(b + 1) * 64 + p];
                fv[e] = part == 0 ? (cr * wr - ci * wi) : -(cr * wi + ci * wr); } }
          const int colb = c0 + 8 * q8; const size_t fo = ((size_t)(((row >> 4) * 4 + (colb >> 5)) * 64 + ((colb >> 3) & 3) * 16 + (row & 15))) * 16;
          *(GAS u32x4*)(tb + S5T_G + fo) = pack8(gv); *(GAS u32x4*)(tb + S5T_K + fo) = pack8(kv); *(GAS u32x4*)(tb + S5T_F + fo) = pack8(fv); } }
    __syncthreads();
}

#define LDU(T, ubase, loff) (*(const GAS T*)((const unsigned char*)(ubase) + (loff)))
#define DPPF(v, ctrl) __builtin_bit_cast(float, __builtin_amdgcn_update_dpp(0, __builtin_bit_cast(int, (v)), (ctrl), 0xF, 0xF, true))
template <int CTRL> DI f32x4 dpp4(const f32x4 v) { const float a0 = v[0], a1 = v[1], a2 = v[2], a3 = v[3]; const float b0 = DPPF(a0, CTRL), b1 = DPPF(a1, CTRL), b2 = DPPF(a2, CTRL), b3 = DPPF(a3, CTRL); return (f32x4){b0, b1, b2, b3}; }
template <int D>
DI void s5_scan_step(f32x4 (&Yr)[4], f32x4 (&Yi)[4], f32x4 (&Ar)[4], f32x4 (&Ai)[4]) {
#pragma unroll
    for (int m = 0; m < 4; ++m) {
        const f32x4 sr = dpp4<0x110 + D>(Yr[m]), si = dpp4<0x110 + D>(Yi[m]);
        Yr[m] += Ar[m] * sr - Ai[m] * si; Yi[m] += Ar[m] * si + Ai[m] * sr;
        const f32x4 a2r = Ar[m] * Ar[m] - Ai[m] * Ai[m], a2i = 2.f * Ar[m] * Ai[m]; Ar[m] = a2r; Ai[m] = a2i; }
}
template <bool POST>
DI void s5_phase(const Frame& F, const CAS Args& a, int l, int first, int stride) {
    const bf16* Z = (const bf16*)(F.ws + WS_R2);
    bf16* ypre = (bf16*)(F.ws + WS_R1 + (size_t)M * RW * 4);
    const int lane = F.lane, w = F.wave, n = lane & 15, kg = lane >> 4;
    int par = 0;
    for (int it = first; it < S5G * 16; it += stride, par ^= 1) {
        const int g = it >> 4, ib = it & 15;
        const unsigned char* tb = F.ws + WS_S5TA + ((size_t)l * S5G + g) * S5T_SIZE;
        float* TOT = (float*)(F.ws + WS_S5X) + (size_t)(g * 16) * 128;
        LAS float* const TW = (LAS float*)(F.lds + S5_TW) + par * 8 * 128;
        LAS float* const X0 = (LAS float*)(F.lds + S5_X0) + par * 128;
        const int sb = 128 * ib + 16 * w + n;
        const unsigned char* zb = F.ws + WS_ZS5 + ((size_t)g * M + 8 * (128 * ib + 16 * w)) * 32;
        unsigned lzu = (unsigned)((8 * n + (kg >> 1)) * 32 + (kg & 1) * 16);
        unsigned lzo = (unsigned)(8 * n * 32 + 8 * kg);
        unsigned ltab = (unsigned)lane * 16u;
        unsigned lyo = (unsigned)(8 * n * S5W + 4 * kg) * 2u;
        asm volatile("" : "+v"(lzu), "+v"(lzo), "+v"(ltab), "+v"(lyo));
        bf16x8 uf[4];
#pragma unroll
        for (int ks = 0; ks < 4; ++ks) uf[ks] = LDU(bf16x8, zb + 64 * ks, lzu);
        f32x4 Ar[4], Ai[4];
#pragma unroll
        for (int m = 0; m < 4; ++m) { Ar[m] = *(const GAS f32x4*)((const float*)(tb + S5T_L8) + 16 * m + 4 * kg); Ai[m] = *(const GAS f32x4*)((const float*)(tb + S5T_L8) + 64 + 16 * m + 4 * kg); }
        if (POST && w == 0) { const int p = lane; const float lnr = ((const GAS float*)(tb + S5T_LN))[p], lni = ((const GAS float*)(tb + S5T_LN))[64 + p];
            float xr = 0.f, xi = 0.f;
            for (int q0 = 0; q0 < ib; q0 += 4) { float tr[4], ti[4];
#pragma unroll
                for (int u = 0; u < 4; ++u) { const int q = (q0 + u < ib) ? q0 + u : q0; tr[u] = TOT[q * 128 + p]; ti[u] = TOT[q * 128 + 64 + p]; }
                SB();
#pragma unroll
                for (int u = 0; u < 4; ++u) if (q0 + u < ib) { const float t0 = lnr * xr - lni * xi + tr[u], t1 = lnr * xi + lni * xr + ti[u]; xr = t0; xi = t1; }
                SB(); }
            X0[p] = xr; X0[64 + p] = xi; }
        SB();
        f32x4 Yr[4], Yi[4];
        { bf16x8 gf[2][4];
#pragma unroll
          for (int ks = 0; ks < 4; ++ks) gf[0][ks] = LDU(bf16x8, tb + S5T_G + (0 * 4 + ks) * 1024, ltab);
#pragma unroll
          for (int mt = 0; mt < 8; ++mt) {
              if (mt + 1 < 8) {
#pragma unroll
                  for (int ks = 0; ks < 4; ++ks) gf[(mt + 1) & 1][ks] = LDU(bf16x8, tb + S5T_G + ((mt + 1) * 4 + ks) * 1024, ltab); }
              SB();
              f32x4 acc = {0.f, 0.f, 0.f, 0.f};
#pragma unroll
              for (int ks = 0; ks < 4; ++ks) acc = __builtin_amdgcn_mfma_f32_16x16x32_bf16(gf[mt & 1][ks], uf[ks], acc, 0, 0, 0);
              if (mt < 4) Yr[mt] = acc; else Yi[mt - 4] = acc;
              SB(); } }
        SB();
        s5_scan_step<1>(Yr, Yi, Ar, Ai); SB(); s5_scan_step<2>(Yr, Yi, Ar, Ai); SB(); s5_scan_step<4>(Yr, Yi, Ar, Ai); SB(); s5_scan_step<8>(Yr, Yi, Ar, Ai); SB();
        if (n == 15) {
#pragma unroll
            for (int m = 0; m < 4; ++m) { *(LAS f32x4*)(TW + w * 128 + 16 * m + 4 * kg) = Yr[m]; *(LAS f32x4*)(TW + w * 128 + 64 + 16 * m + 4 * kg) = Yi[m]; } }
        __syncthreads();
        f32x4 Sr[4], Si[4];
#pragma unroll
        for (int m = 0; m < 4; ++m) { Sr[m] = POST ? *(const LAS f32x4*)(X0 + 16 * m + 4 * kg) : (f32x4){0.f, 0.f, 0.f, 0.f}; Si[m] = POST ? *(const LAS f32x4*)(X0 + 64 + 16 * m + 4 * kg) : (f32x4){0.f, 0.f, 0.f, 0.f}; }
        const int nprev = POST ? w : 8;
        for (int q = 0; q < nprev; ++q) {
#pragma unroll
            for (int m = 0; m < 4; ++m) { const f32x4 tr = *(const LAS f32x4*)(TW + q * 128 + 16 * m + 4 * kg), ti = *(const LAS f32x4*)(TW + q * 128 + 64 + 16 * m + 4 * kg);
                const f32x4 nr = Ar[m] * Sr[m] - Ai[m] * Si[m] + tr, ni = Ar[m] * Si[m] + Ai[m] * Sr[m] + ti; Sr[m] = nr; Si[m] = ni; } }
        if (!POST) { if (w == 0 && n == 0) {
#pragma unroll
                for (int m = 0; m < 4; ++m) { *(GAS f32x4*)(TOT + ib * 128 + 16 * m + 4 * kg) = Sr[m]; *(GAS f32x4*)(TOT + ib * 128 + 64 + 16 * m + 4 * kg) = Si[m]; } } }
        if (POST) {
            f32x4 Xr[4], Xi[4], Pr[4], Pi[4];
#pragma unroll
            for (int m = 0; m < 4; ++m) { Pr[m] = *(const GAS f32x4*)((const float*)(tb + S5T_PN) + n * 128 + 16 * m + 4 * kg); Pi[m] = *(const GAS f32x4*)((const float*)(tb + S5T_PN) + n * 128 + 64 + 16 * m + 4 * kg); }
            SB();
#pragma unroll
            for (int m = 0; m < 4; ++m) { const f32x4 yr = dpp4<0x111>(Yr[m]), yi = dpp4<0x111>(Yi[m]); Xr[m] = Pr[m] * Sr[m] - Pi[m] * Si[m] + yr; Xi[m] = Pr[m] * Si[m] + Pi[m] * Sr[m] + yi; }
            bf16x8 xf[4]; xf[0] = pack_pi(Xr[0], Xr[1]); xf[1] = pack_pi(Xr[2], Xr[3]); xf[2] = pack_pi(Xi[0], Xi[1]); xf[3] = pack_pi(Xi[2], Xi[3]);
            SB();
            u32x2 uu[8]; bf16x8 uf2[4];
#pragma unroll
            for (int ks = 0; ks < 4; ++ks) uf2[ks] = LDU(bf16x8, zb + 64 * ks, lzu);
            const f32x4 dv = *(const GAS f32x4*)(a.in[11] + (size_t)l * S5W + 16 * g + 4 * kg);
#pragma unroll
            for (int mt = 0; mt < 8; ++mt) uu[mt] = LDU(u32x2, zb + 32 * mt, lzo);
            { bf16x8 kf[2][4], ff[2][4];
#pragma unroll
              for (int ks = 0; ks < 4; ++ks) { if (2 * ks <= 0) kf[0][ks] = LDU(bf16x8, tb + S5T_K + (0 * 4 + ks) * 1024, ltab); ff[0][ks] = LDU(bf16x8, tb + S5T_F + (0 * 4 + ks) * 1024, ltab); }
#pragma unroll
              for (int mt = 0; mt < 8; ++mt) {
                  if (mt + 1 < 8) {
#pragma unroll
                      for (int ks = 0; ks < 4; ++ks) { if (2 * ks <= mt + 1) kf[(mt + 1) & 1][ks] = LDU(bf16x8, tb + S5T_K + ((mt + 1) * 4 + ks) * 1024, ltab);
                          ff[(mt + 1) & 1][ks] = LDU(bf16x8, tb + S5T_F + ((mt + 1) * 4 + ks) * 1024, ltab); } }
                  SB();
                  f32x4 acc = {0.f, 0.f, 0.f, 0.f};
#pragma unroll
                  for (int ks = 0; ks < 4; ++ks) { if (2 * ks <= mt) acc = __builtin_amdgcn_mfma_f32_16x16x32_bf16(kf[mt & 1][ks], uf2[ks], acc, 0, 0, 0); }
#pragma unroll
                  for (int ks = 0; ks < 4; ++ks) acc = __builtin_amdgcn_mfma_f32_16x16x32_bf16(ff[mt & 1][ks], xf[ks], acc, 0, 0, 0);
                  const float y0 = acc[0] + dv[0] * bflo(uu[mt].x), y1 = acc[1] + dv[1] * bfhi(uu[mt].x), y2 = acc[2] + dv[2] * bflo(uu[mt].y), y3 = acc[3] + dv[3] * bfhi(uu[mt].y);
                  u32x2 o; o.x = pk2(gelu_tanh(y0), gelu_tanh(y1)); o.y = pk2(gelu_tanh(y2), gelu_tanh(y3));
                  *(GAS u32x2*)((unsigned char*)(ypre + (size_t)(8 * (128 * ib + 16 * w) + mt) * S5W + 16 * g) + lyo) = o;
                  SB(); } }
        }
    }
}
constexpr int NPH = 12, NSTEPS = 1 + DEPTH * NPH + 1;
#ifndef MK_PER_STEP
#define MK_PER_STEP 0
#endif
__global__ void __launch_bounds__(512, 2) trunk_fwd(Args args_unused) {
    extern __shared__ __attribute__((aligned(16))) unsigned char lds_raw[];
    LAS unsigned char* const lds = (LAS unsigned char*)lds_raw;
    volatile LAS unsigned* MISC = (volatile LAS unsigned*)(lds + MISC_OFF);
    for (int u = threadIdx.x; u < 128; u += 512) MISC[u] = 0u;
    int wv = __builtin_amdgcn_readfirstlane(threadIdx.x >> 6); asm volatile("" : "+s"(wv));
    __syncthreads();
    const CAS Args* ap0 = (const CAS Args*)__builtin_amdgcn_kernarg_segment_ptr();
    const int lo = ap0->lo, hi = ap0->hi;
    XcdBarrier bar; bar.bar = (unsigned*)(ap0->ws + WS_CTL) + CW_BAR; bar.x = 0; bar.st = MISC + 8; bar.w0 = (wv == 0);
    if ((hi - lo) > 1) bar = xcd_barrier_post(bar.bar, MISC + 8, wv == 0);
#ifndef ONLY_PH
#define ONLY_PH 0xFFFF
#endif
#define PHEN(ph) ((ONLY_PH >> (ph)) & 1)
#define IN(k) (lo <= (k) && (k) < hi)
#define SEAM(k) do { if (IN((k) + 1) && IN(k)) xcd_barrier(bar); } while (0)
#define FRAME() const CAS Args* ap; const Frame F = make_frame(lds, ap, wv); const CAS Args& A = *ap; (void)A
#ifndef REPEAT_MASK
#define REPEAT_MASK 0
#endif
#define REP(ph) ((REPEAT_MASK >> (ph)) & 1)
#ifndef REP2_MASK
#define REP2_MASK 0
#endif
#define REP2(k) ((REP2_MASK >> (k)) & 1)

    if (PHEN(12) && IN(0)) { { FRAME(); float* prm = (float*)(F.ws + WS_PRM);
            for (int e = F.bid * 512 + F.tid; e < DEPTH * RH * 576; e += F.G * 512) { const int i = e & 63, pi = (e >> 6) % 9, lh = e / 576, hh = lh % RH, ll = lh / RH; float val;
                if (pi < 3) val = A.in[14][(size_t)ll * RWCOLS + (pi == 0 ? ZC_R : (pi == 1 ? ZC_K : ZC_V)) - ZC_R + hh * 64 + i];
                else if (pi == 3) val = A.in[16][(size_t)ll * RW + hh * 64 + i]; else if (pi == 4) val = A.in[18][(size_t)ll * RW + hh * 64 + i]; else if (pi == 5) val = A.in[20][(size_t)ll * RW + hh * 64 + i];
                else if (pi == 6) val = A.in[21][(size_t)ll * RW + hh * 64 + i]; else if (pi == 7) val = A.in[22][(size_t)ll * RW + hh * 64 + i];
                else val = (ll > 0) ? A.in[28][(size_t)(ll - 1) * RW + hh * 64 + i] : 0.f;
                prm[e] = val; } }
        { FRAME(); p0_prologue(F, A); __syncthreads(); } { FRAME(); for (int it = F.bid; it < DEPTH * S5G; it += F.G) s5_tables(F, A, it / S5G, it % S5G); } SEAM(0); }

    for (int l = 0; l < DEPTH; ++l) {
        const int s0 = 1 + l * NPH;
        if (REP(0) && PHEN(0) && IN(s0 + 0)) { if (l == 0) { FRAME(); x0_phase(F, A.in[0], (bf16*)F.out, (float*)(F.ws + WS_SSQ)); xcd_barrier(bar); } }
        if (PHEN(0) && IN(s0 + 0)) { if (l == 0) { FRAME(); x0_phase(F, A.in[0], (bf16*)F.out, (float*)(F.ws + WS_SSQ)); SEAM(s0 + 0); } }
        if (REP(1) && PHEN(1) && IN(s0 + 1)) { FRAME();
            const int nN = (l == 0) ? 44 : 45;
            const LAS float* rs = rstd_table(F);
            SchedPlain S; S.init((const bf16*)F.out, XP, (const bf16*)lw(F, l, LW_WIN), D, M / BM, nN, D, F.G, F.bid);
            EpiInproj E{(bf16*)(F.ws + WS_R2), A.in[3] + (size_t)l * 6144, (bf16*)(F.ws + WS_ZS5), rs};
            gemm_phase<EpiInproj, SchedPlain>(F.lds, F.wave, XP, D, S, E);
            xcd_barrier(bar);
        }
        if (PHEN(1) && IN(s0 + 1)) { FRAME();
            const int nN = (l == 0) ? 44 : 45;
            const LAS float* rs = rstd_table(F);
            SchedPlain S; S.init((const bf16*)F.out, XP, (const bf16*)lw(F, l, LW_WIN), D, M / BM, nN, D, F.G, F.bid);
            EpiInproj E{(bf16*)(F.ws + WS_R2), A.in[3] + (size_t)l * 6144, (bf16*)(F.ws + WS_ZS5), rs};
            gemm_phase<EpiInproj, SchedPlain>(F.lds, F.wave, XP, D, S, E);
            SEAM(s0 + 1);
        }
        if (REP(2) && PHEN(2) && IN(s0 + 2)) { FRAME(); rwkv_fused_phase(F, A, l); gla_pre_phase(F, A, l); s5_phase<false>(F, A, l, F.bid, F.G); xcd_barrier(bar); }
        if (PHEN(2) && IN(s0 + 2)) { FRAME(); if (REP2(0)) rwkv_fused_phase(F, A, l); rwkv_fused_phase(F, A, l); if (REP2(1)) gla_pre_phase(F, A, l); gla_pre_phase(F, A, l); if (REP2(2)) s5_phase<false>(F, A, l, F.bid, F.G); s5_phase<false>(F, A, l, F.bid, F.G); SEAM(s0 + 2); }
        if (REP(4) && PHEN(4) && IN(s0 + 4)) { FRAME();
            if (F.bid < 40) rwkv_scan_phase(F, F.bid >> 2, F.bid & 3);
            else if (F.bid < 60) gla_scan_wave(F, (F.bid - 40) * 8 + F.wave);
            else s5_phase<true>(F, A, l, F.bid - 60, F.G - 60);
            xcd_barrier(bar);
        }
        if (PHEN(4) && IN(s0 + 4)) { FRAME();
            if (F.bid < 40) { if (REP2(3)) rwkv_scan_phase(F, F.bid >> 2, F.bid & 3); rwkv_scan_phase(F, F.bid >> 2, F.bid & 3); }
            else if (F.bid < 60) { if (REP2(4)) gla_scan_wave(F, (F.bid - 40) * 8 + F.wave); gla_scan_wave(F, (F.bid - 40) * 8 + F.wave); }
            else { if (REP2(5)) s5_phase<true>(F, A, l, F.bid - 60, F.G - 60); s5_phase<true>(F, A, l, F.bid - 60, F.G - 60); }
            SEAM(s0 + 4);
        }
        if (REP(5) && PHEN(5) && IN(s0 + 5)) { FRAME(); gla_post_phase(F, A, l); rwkv_post_phase(F, A, l); xcd_barrier(bar); }
        if (PHEN(5) && IN(s0 + 5)) { FRAME(); if (REP2(7)) gla_post_phase(F, A, l); gla_post_phase(F, A, l); if (REP2(6)) rwkv_post_phase(F, A, l); rwkv_post_phase(F, A, l); SEAM(s0 + 5); }
        if (REP(6) && PHEN(6) && IN(s0 + 6)) { FRAME();
            const bf16* ypre = (const bf16*)(F.ws + WS_R1 + (size_t)M * RW * 4);
            SchedPlain S; S.init(ypre, S5W, (const bf16*)lw(F, l, LW_GLU), S5W, M / BM, 3, S5W, F.G, F.bid);
            EpiGlu E{ypre, (bf16*)(F.ws + WS_R3), A.in[13] + (size_t)l * S5W};
            gemm_phase<EpiGlu, SchedPlain>(F.lds, F.wave, S5W, S5W, S, E);
            xcd_barrier(bar);
        }
        if (PHEN(6) && IN(s0 + 6)) { FRAME();
            const bf16* ypre = (const bf16*)(F.ws + WS_R1 + (size_t)M * RW * 4);
            SchedPlain S; S.init(ypre, S5W, (const bf16*)lw(F, l, LW_GLU), S5W, M / BM, 3, S5W, F.G, F.bid);
            EpiGlu E{ypre, (bf16*)(F.ws + WS_R3), A.in[13] + (size_t)l * S5W};
            gemm_phase<EpiGlu, SchedPlain>(F.lds, F.wave, S5W, S5W, S, E);
            SEAM(s0 + 6);
        }
        if (REP(7) && PHEN(7) && IN(s0 + 7)) { FRAME();
            SchedSeg3 S; S.init((const bf16*)(F.ws + WS_R3), D, (const bf16*)lw(F, l, LW_WUP), D, M / BM, D / BM, F.G, F.bid);
            EpiMerged E{(const bf16*)(F.ws + WS_R2), (bf16*)(F.ws + WS_R1)};
            gemm_phase<EpiMerged, SchedSeg3>(F.lds, F.wave, D, D, S, E);
            xcd_barrier(bar);
        }
        if (PHEN(7) && IN(s0 + 7)) { FRAME();
            SchedSeg3 S; S.init((const bf16*)(F.ws + WS_R3), D, (const bf16*)lw(F, l, LW_WUP), D, M / BM, D / BM, F.G, F.bid);
            EpiMerged E{(const bf16*)(F.ws + WS_R2), (bf16*)(F.ws + WS_R1)};
            gemm_phase<EpiMerged, SchedSeg3>(F.lds, F.wave, D, D, S, E);
            SEAM(s0 + 7);
        }
        if (REP(8) && PHEN(8) && IN(s0 + 8)) { FRAME();
            SchedPlain S; S.init((const bf16*)(F.ws + WS_R1), D, (const bf16*)lw(F, l, LW_WOUT), D, M / BM, D / BM, D, F.G, F.bid);
            EpiResid E{(const bf16*)F.out, (bf16*)F.out, (float*)(F.ws + WS_SSQ)};
            gemm_phase<EpiResid, SchedPlain>(F.lds, F.wave, D, D, S, E);
            xcd_barrier(bar);
        }
        if (PHEN(8) && IN(s0 + 8)) { FRAME();
            SchedPlain S; S.init((const bf16*)(F.ws + WS_R1), D, (const bf16*)lw(F, l, LW_WOUT), D, M / BM, D / BM, D, F.G, F.bid);
            EpiResid E{(const bf16*)F.out, (bf16*)F.out, (float*)(F.ws + WS_SSQ)};
            gemm_phase<EpiResid, SchedPlain>(F.lds, F.wave, D, D, S, E);
            SEAM(s0 + 8);
        }
        if (REP(10) && PHEN(10) && IN(s0 + 10)) { FRAME();
            const LAS float* rs = rstd_table(F);
            SchedPlain S; S.init((const bf16*)F.out, XP, (const bf16*)lw(F, l, LW_W1), D, M / BM, DFF / BM, D, F.G, F.bid);
            EpiRelu2 E{(bf16*)(F.ws + WS_R2), rs};
            gemm_phase<EpiRelu2, SchedPlain>(F.lds, F.wave, XP, D, S, E);
            xcd_barrier(bar);
        }
        if (PHEN(10) && IN(s0 + 10)) { FRAME();
            const LAS float* rs = rstd_table(F);
            SchedPlain S; S.init((const bf16*)F.out, XP, (const bf16*)lw(F, l, LW_W1), D, M / BM, DFF / BM, D, F.G, F.bid);
            EpiRelu2 E{(bf16*)(F.ws + WS_R2), rs};
            gemm_phase<EpiRelu2, SchedPlain>(F.lds, F.wave, XP, D, S, E);
            SEAM(s0 + 10);
        }
        if (REP(11) && PHEN(11) && IN(s0 + 11)) { FRAME();
            SchedPlain S; S.init((const bf16*)(F.ws + WS_R2), DFF, (const bf16*)lw(F, l, LW_W2), DFF, M / BM, D / BM, DFF, F.G, F.bid);
            EpiResid E{(const bf16*)F.out, (l == DEPTH - 1) ? (bf16*)(F.ws + WS_R1) : (bf16*)F.out, (float*)(F.ws + WS_SSQ)};
            gemm_phase<EpiResid, SchedPlain>(F.lds, F.wave, DFF, DFF, S, E);
            xcd_barrier(bar);
        }
        if (PHEN(11) && IN(s0 + 11)) { FRAME();
            SchedPlain S; S.init((const bf16*)(F.ws + WS_R2), DFF, (const bf16*)lw(F, l, LW_W2), DFF, M / BM, D / BM, DFF, F.G, F.bid);
            EpiResid E{(const bf16*)F.out, (l == DEPTH - 1) ? (bf16*)(F.ws + WS_R1) : (bf16*)F.out, (float*)(F.ws + WS_SSQ)};
            gemm_phase<EpiResid, SchedPlain>(F.lds, F.wave, DFF, DFF, S, E);
            SEAM(s0 + 11);
        }
    }
    if (PHEN(13) && IN(NSTEPS - 1)) { FRAME(); rmsnorm_phase<true, true>(F, F.ws + WS_R1, A.in[37], F.out); }
#undef IN
#undef SEAM
}

extern "C" void kernel_launch(void* const* d_in, const int* in_sizes, int n_in, void* d_out, int out_size, void* d_ws, size_t ws_size, hipStream_t stream) {
    static int grid = 0;
    if (grid == 0) {
        if (n_in != 38 || out_size != M * D || ws_size < WS_END) { fprintf(stderr, "kernel_launch: unexpected shapes (n_in %d, out %d, ws %zu < %zu)\n", n_in, out_size, ws_size, (size_t)WS_END); grid = -1; return; }
        int dev = 0, cus = 0, per_cu = 0;
        if (hipGetDevice(&dev) != hipSuccess || hipDeviceGetAttribute(&cus, hipDeviceAttributeMultiprocessorCount, dev) != hipSuccess) { grid = -1; return; }
        if (hipFuncSetAttribute((const void*)trunk_fwd, hipFuncAttributeMaxDynamicSharedMemorySize, LDS_BYTES) != hipSuccess) { fprintf(stderr, "kernel_launch: hipFuncSetAttribute failed\n"); grid = -1; return; }
        if (hipOccupancyMaxActiveBlocksPerMultiprocessor(&per_cu, (const void*)trunk_fwd, 512, LDS_BYTES) != hipSuccess || per_cu < 1) { fprintf(stderr, "kernel_launch: occupancy query says %d\n", per_cu); }
        (void)hipGetLastError();
        grid = (cus / 8) * 8;
        if (grid < 64) { fprintf(stderr, "kernel_launch: %d CUs\n", cus); grid = -1; return; }
    }
    if (grid < 0) return;
    if (hipMemsetAsync((char*)d_ws + WS_CTL, 0, CTL_ZERO_BYTES, stream) != hipSuccess) return;
    Args a{};
    for (int i = 0; i < 38; ++i) a.in[i] = (const float*)d_in[i];
    a.out = (float*)d_out; a.ws = (unsigned char*)d_ws;
#if MK_PER_STEP
    for (int s = 0; s < NSTEPS; ++s) { a.lo = s; a.hi = s + 1; hipLaunchKernelGGL(trunk_fwd, dim3(grid), dim3(512), LDS_BYTES, stream, a); }
#else
    a.lo = 0; a.hi = NSTEPS;
    hipLaunchKernelGGL(trunk_fwd, dim3(grid), dim3(512), LDS_BYTES, stream, a);
#endif
}
```
